# Optimizing an MI355X kernel written in HIP

```python
import math
import jax, jax.numpy as jnp
from jax import lax
import numpy as np

D_MODEL = 1024
BATCH = 8
SEQ = 4096
DEPTH = 4

N_A_LAYERS = DEPTH // 2
N_B_LAYERS = DEPTH - N_A_LAYERS
D_FF = 4 * D_MODEL
NORM_EPS = 1e-6
NEG = -1e30

DIFF_HEAD_DIM = 64
DIFF_HEADS = D_MODEL // (2 * DIFF_HEAD_DIM)
Q_BLOCK = 128

REL_BUCKETS = 32
REL_MAX_DIST = 128
REL_HEADS = 2 * DIFF_HEADS

NSA_HEAD_DIM = 64
NSA_HEADS = D_MODEL // NSA_HEAD_DIM
NSA_KV_HEADS = 4
NSA_GROUP = NSA_HEADS // NSA_KV_HEADS
CMP_LEN = 32
CMP_STRIDE = 16
CMP_HIDDEN = 256
SLC_LEN = 64
SLC_TOPK = 16
SLC_FORCED_LOCAL = 2
FORCE_BONUS = 1e4
WINDOW = 512
NSA_Q_BLOCK = 32
NSA_IN_COLS = NSA_HEADS * NSA_HEAD_DIM + 3 * NSA_HEADS
KV_COLS = 6 * NSA_KV_HEADS * NSA_HEAD_DIM

kernel_name = "yoco_diffattn_nsa_hybrid"


def rms_norm(x, g):
    xf = x.astype(jnp.float32)
    y = xf * lax.rsqrt(jnp.mean(xf * xf, axis=-1, keepdims=True) + NORM_EPS)
    return (y * g.astype(jnp.float32)).astype(x.dtype)


def modulate(h, shift, scale):
    return h * (1 + scale) + shift


def t5_bucket(dist):
    n = jnp.maximum(dist, 0)
    max_exact = REL_BUCKETS // 2
    nf = jnp.maximum(n, 1).astype(jnp.float32)
    large = max_exact + (jnp.log(nf / max_exact) / math.log(REL_MAX_DIST / max_exact)
                         * (REL_BUCKETS - max_exact)).astype(jnp.int32)
    large = jnp.minimum(large, REL_BUCKETS - 1)
    return jnp.where(n < max_exact, n, large)


def squared_relu_mlp(h, w1, w2):
    return jnp.square(jax.nn.relu(h @ w1)) @ w2


def diff_attention(h, w_in, w_out, lam, subln, rel_bias, layer_idx):
    B, T, _ = h.shape
    H, d = DIFF_HEADS, DIFF_HEAD_DIM
    q, k, v = jnp.split(h @ w_in, 3, axis=-1)
    q = q.reshape(B, T, H, 2, d)
    k = k.reshape(B, T, H, 2, d)
    v = v.reshape(B, T, H, 2 * d)
    lam_init = 0.8 - 0.6 * math.exp(-0.3 * layer_idx)
    lf = lam.astype(jnp.float32)
    lam_full = jnp.exp(jnp.sum(lf[0] * lf[1])) - jnp.exp(jnp.sum(lf[2] * lf[3])) + lam_init
    bias_tab = rel_bias.reshape(REL_BUCKETS, H, 2).astype(jnp.float32)
    k_pos = jnp.arange(T)
    scale = d ** -0.5
    nblk = T // Q_BLOCK
    qb = q.reshape(B, nblk, Q_BLOCK, H, 2, d).transpose(1, 0, 2, 3, 4, 5)

    def block(args):
        qi, blk = args
        q_pos = blk * Q_BLOCK + jnp.arange(Q_BLOCK)
        dist = q_pos[:, None] - k_pos[None, :]
        bias = bias_tab[t5_bucket(dist)].transpose(2, 3, 0, 1)
        s = jnp.einsum('bqhmd,bkhmd->bhmqk', qi, k,
                       preferred_element_type=jnp.float32) * scale + bias[None]
        s = jnp.where((dist >= 0)[None, None, None], s, NEG)
        p = jax.nn.softmax(s, axis=-1)
        a = p[:, :, 0] - lam_full * p[:, :, 1]
        return jnp.einsum('bhqk,bkhe->bqhe', a.astype(v.dtype), v)

    o = lax.map(block, (qb, jnp.arange(nblk)))
    o = o.transpose(1, 0, 2, 3, 4).reshape(B, T, H, 2 * d)
    o = rms_norm(o, subln) * (1 - lam_init)
    return o.reshape(B, T, H * 2 * d) @ w_out


def nsa_shared_kv(h, w_kv, cmp_pos, cmp_w1, cmp_w2):
    B, T, _ = h.shape
    G, d = NSA_KV_HEADS, NSA_HEAD_DIM
    kv = (h @ w_kv).reshape(B, T, 6, G, d).transpose(2, 0, 3, 1, 4)
    n_cmp = (T - CMP_LEN) // CMP_STRIDE + 1
    idx = jnp.arange(n_cmp)[:, None] * CMP_STRIDE + jnp.arange(CMP_LEN)[None, :]
    blocks = kv[0:2][:, :, :, idx] + cmp_pos[:, None, None, None]
    flat = blocks.reshape(2, B, G, n_cmp, CMP_LEN * d)
    hid = jax.nn.gelu(jnp.einsum('sbgnf,sfh->sbgnh', flat, cmp_w1))
    cmp = jnp.einsum('sbgnh,shd->sbgnd', hid, cmp_w2)
    return (cmp[0], cmp[1], kv[2], kv[3], kv[4], kv[5])


def nsa_attention(h, w_in, w_out, rel_bias, k_cmp, v_cmp, k_slc, v_slc, k_win, v_win):
    B, T, _ = h.shape
    H, G, R, d = NSA_HEADS, NSA_KV_HEADS, NSA_GROUP, NSA_HEAD_DIM
    proj = h @ w_in
    q = proj[..., :H * d].reshape(B, T, G, R, d)
    gates = jax.nn.sigmoid(proj[..., H * d:].astype(jnp.float32)).reshape(B, T, G, R, 3)
    scale = d ** -0.5
    bias_tab = rel_bias.reshape(REL_BUCKETS, G, R).astype(jnp.float32)
    bias_tab_g = bias_tab.transpose(1, 0, 2)
    n_cmp = k_cmp.shape[2]
    n_slc = T // SLC_LEN
    top_k = min(SLC_TOPK, n_slc)
    cmp_start = jnp.arange(n_cmp) * CMP_STRIDE
    cmp_end = cmp_start + CMP_LEN - 1
    slc_start = jnp.arange(n_slc) * SLC_LEN
    overlap = ((cmp_start[:, None] < slc_start[None, :] + SLC_LEN)
               & (cmp_end[:, None] >= slc_start[None, :])).astype(jnp.float32)
    k_slc_blk = k_slc.reshape(B, G, n_slc, SLC_LEN, d)
    v_slc_blk = v_slc.reshape(B, G, n_slc, SLC_LEN, d)
    k_win_pad = jnp.pad(k_win, ((0, 0), (0, 0), (WINDOW, 0), (0, 0)))
    v_win_pad = jnp.pad(v_win, ((0, 0), (0, 0), (WINDOW, 0), (0, 0)))
    b_idx = jnp.arange(B)[:, None, None, None]
    g_idx = jnp.arange(G)[None, :, None, None]
    j_idx = jnp.arange(n_slc)
    in_offs = jnp.arange(SLC_LEN)
    nblk = T // NSA_Q_BLOCK
    qb = q.reshape(B, nblk, NSA_Q_BLOCK, G, R, d).transpose(1, 0, 2, 3, 4, 5)
    gb = gates.reshape(B, nblk, NSA_Q_BLOCK, G, R, 3).transpose(1, 0, 2, 3, 4, 5)

    def block(args):
        qi, gi, blk = args
        q_pos = blk * NSA_Q_BLOCK + jnp.arange(NSA_Q_BLOCK)
        s_c = jnp.einsum('bqgrd,bgnd->bgrqn', qi, k_cmp,
                         preferred_element_type=jnp.float32) * scale
        valid_c = cmp_end[None, :] <= q_pos[:, None]
        p_c = jax.nn.softmax(jnp.where(valid_c, s_c, NEG), axis=-1) * valid_c
        o_c = jnp.einsum('bgrqn,bgnd->bqgrd', p_c.astype(v_cmp.dtype), v_cmp)
        imp = jnp.einsum('bgrqn,nj->bgqj', p_c, overlap)
        q_blk = q_pos // SLC_LEN
        forced = (j_idx[None, :] == 0) | ((j_idx[None, :] <= q_blk[:, None])
                                          & (j_idx[None, :] > q_blk[:, None] - SLC_FORCED_LOCAL))
        imp = jnp.where(forced[None, None], FORCE_BONUS, imp)
        imp = jnp.where((j_idx[None, :] <= q_blk[:, None])[None, None], imp, NEG)
        _, sel = lax.top_k(imp, top_k)
        ks = k_slc_blk[b_idx, g_idx, sel].reshape(B, G, NSA_Q_BLOCK, top_k * SLC_LEN, d)
        vs = v_slc_blk[b_idx, g_idx, sel].reshape(B, G, NSA_Q_BLOCK, top_k * SLC_LEN, d)
        pos_s = (sel[..., None] * SLC_LEN + in_offs).reshape(B, G, NSA_Q_BLOCK, top_k * SLC_LEN)
        dist_s = q_pos[None, None, :, None] - pos_s
        bias_s = bias_tab_g[g_idx, t5_bucket(dist_s)].transpose(0, 1, 4, 2, 3)
        s_s = jnp.einsum('bqgrd,bgqkd->bgrqk', qi, ks,
                         preferred_element_type=jnp.float32) * scale + bias_s
        s_s = jnp.where((dist_s >= 0)[:, :, None], s_s, NEG)
        p_s = jax.nn.softmax(s_s, axis=-1)
        o_s = jnp.einsum('bgrqk,bgqkd->bqgrd', p_s.astype(vs.dtype), vs)
        start = blk * NSA_Q_BLOCK
        kw = lax.dynamic_slice_in_dim(k_win_pad, start, WINDOW + NSA_Q_BLOCK, axis=2)
        vw = lax.dynamic_slice_in_dim(v_win_pad, start, WINDOW + NSA_Q_BLOCK, axis=2)
        k_pos = start - WINDOW + jnp.arange(WINDOW + NSA_Q_BLOCK)
        dist_w = q_pos[:, None] - k_pos[None, :]
        valid_w = (dist_w >= 0) & (dist_w < WINDOW) & (k_pos[None, :] >= 0)
        bias_w = bias_tab[t5_bucket(dist_w)].transpose(2, 3, 0, 1)
        s_w = jnp.einsum('bqgrd,bgkd->bgrqk', qi, kw,
                         preferred_element_type=jnp.float32) * scale + bias_w[None]
        p_w = jax.nn.softmax(jnp.where(valid_w[None, None, None], s_w, NEG), axis=-1)
        o_w = jnp.einsum('bgrqk,bgkd->bqgrd', p_w.astype(vw.dtype), vw)
        o = gi[..., 0:1] * o_c + gi[..., 1:2] * o_s + gi[..., 2:3] * o_w
        return o.astype(qi.dtype)

    o = lax.map(block, (qb, gb, jnp.arange(nblk)))
    o = o.transpose(1, 0, 2, 3, 4, 5).reshape(B, T, H * d)
    return o @ w_out


def setup_inputs(seed: int = 0) -> dict:
    key = jax.random.key(seed)
    ks = jax.random.split(key, 24)
    f32 = jnp.float32
    D, d_a, d_n = D_MODEL, DIFF_HEAD_DIM, NSA_HEAD_DIM
    nrm = lambda k, shape, s: jax.random.normal(k, shape, f32) * s
    gain = lambda k, shape: 1.0 + 0.02 * jax.random.normal(k, shape, f32)
    return {
        "x": nrm(ks[0], (BATCH, SEQ, D), 1.0),
        "c": nrm(ks[1], (BATCH, D), 1.0),
        "rel_bias": nrm(ks[2], (REL_BUCKETS, REL_HEADS), 0.5),
        "ada_w": nrm(ks[3], (DEPTH, D, 6 * D), D ** -0.5),
        "ada_b": nrm(ks[4], (DEPTH, 6 * D), 0.02),
        "attn_norm": gain(ks[5], (DEPTH, D)),
        "mlp_norm": gain(ks[6], (DEPTH, D)),
        "mlp_w1": nrm(ks[7], (DEPTH, D, D_FF), D ** -0.5),
        "mlp_w2": nrm(ks[8], (DEPTH, D_FF, D), D_FF ** -0.5),
        "a_w_in": nrm(ks[9], (N_A_LAYERS, D, 3 * D), D ** -0.5),
        "a_w_out": nrm(ks[10], (N_A_LAYERS, D, D), D ** -0.5),
        "a_lambda": nrm(ks[11], (N_A_LAYERS, 4, d_a), 0.1),
        "a_subln": gain(ks[12], (N_A_LAYERS, 2 * d_a)),
        "kv_ada_w": nrm(ks[13], (D, 2 * D), D ** -0.5),
        "kv_ada_b": nrm(ks[14], (2 * D,), 0.02),
        "kv_norm": gain(ks[15], (D,)),
        "w_kv": nrm(ks[16], (D, KV_COLS), D ** -0.5),
        "cmp_pos": nrm(ks[17], (2, CMP_LEN, d_n), 0.1),
        "cmp_w1": nrm(ks[18], (2, CMP_LEN * d_n, CMP_HIDDEN), (CMP_LEN * d_n) ** -0.5),
        "cmp_w2": nrm(ks[19], (2, CMP_HIDDEN, d_n), CMP_HIDDEN ** -0.5),
        "b_w_in": nrm(ks[20], (N_B_LAYERS, D, NSA_IN_COLS), D ** -0.5),
        "b_w_out": nrm(ks[21], (N_B_LAYERS, D, D), D ** -0.5),
        "final_norm": gain(ks[22], (D,)),
    }


def reference(x, c, rel_bias, ada_w, ada_b, attn_norm, mlp_norm, mlp_w1, mlp_w2,
              a_w_in, a_w_out, a_lambda, a_subln, kv_ada_w, kv_ada_b, kv_norm, w_kv,
              cmp_pos, cmp_w1, cmp_w2, b_w_in, b_w_out, final_norm):
    c_act = jax.nn.silu(c)
    shared = None
    for layer in range(DEPTH):
        mod = (c_act @ ada_w[layer] + ada_b[layer])[:, None, :]
        sh_a, sc_a, gt_a, sh_m, sc_m, gt_m = jnp.split(mod, 6, axis=-1)
        h = modulate(rms_norm(x, attn_norm[layer]), sh_a, sc_a)
        if layer < N_A_LAYERS:
            mix = diff_attention(h, a_w_in[layer], a_w_out[layer], a_lambda[layer],
                                 a_subln[layer], rel_bias, layer)
        else:
            i = layer - N_A_LAYERS
            mix = nsa_attention(h, b_w_in[i], b_w_out[i], rel_bias, *shared)
        x = x + gt_a * mix
        h = modulate(rms_norm(x, mlp_norm[layer]), sh_m, sc_m)
        x = x + gt_m * squared_relu_mlp(h, mlp_w1[layer], mlp_w2[layer])
        if layer == N_A_LAYERS - 1:
            kv_mod = (c_act @ kv_ada_w + kv_ada_b)[:, None, :]
            sh_kv, sc_kv = jnp.split(kv_mod, 2, axis=-1)
            h_kv = modulate(rms_norm(x, kv_norm), sh_kv, sc_kv)
            shared = nsa_shared_kv(h_kv, w_kv, cmp_pos, cmp_w1, cmp_w2)
    return rms_norm(x, final_norm)
```

```cpp
#include <hip/hip_runtime.h>
#include <hip/hip_cooperative_groups.h>
#include <cstdio>
#include <cstdint>
namespace cg = cooperative_groups;

#ifndef NDUP
#define NDUP 0
#endif
#ifndef USE_XCD_BAR
#define USE_XCD_BAR 1
#endif

#define LAS __attribute__((address_space(3)))
typedef unsigned short bf16_t;
typedef short bf16x8 __attribute__((ext_vector_type(8)));
typedef short s16x4 __attribute__((ext_vector_type(4)));
typedef float f32x4 __attribute__((ext_vector_type(4)));
typedef float f32x16 __attribute__((ext_vector_type(16)));
typedef unsigned u32x4 __attribute__((ext_vector_type(4)));
typedef unsigned u32x2 __attribute__((ext_vector_type(2)));
typedef float f32x2_t __attribute__((ext_vector_type(2)));
typedef __bf16 bf16x2_t __attribute__((ext_vector_type(2)));

__device__ __forceinline__ unsigned cvtpk(float lo, float hi) { f32x2_t v = {lo, hi}; bf16x2_t b = __builtin_convertvector(v, bf16x2_t); return __builtin_bit_cast(unsigned, b); }
__device__ __forceinline__ float bf2f(bf16_t v) { return __builtin_bit_cast(float, (unsigned)v << 16); }

constexpr int BATCH = 8, T = 4096, D = 1024, M = BATCH * T, FF = 4096;
constexpr int NQKV = 3072, NKV = 1536, NBIN = 1072, NBINP = 1280;
constexpr float NORM_EPS = 1e-6f;
constexpr float LOG2E = 1.4426950408889634f;
constexpr float SC2 = 0.125f * LOG2E;

constexpr size_t MiB = 1u << 20;
constexpr size_t WS_MOD = 0;
constexpr size_t WS_KVMOD = 4 * 8 * 6144 * 4;
constexpr size_t WS_BAR = 1 * MiB;
constexpr size_t WS_WQKV = 2 * MiB;
constexpr size_t WS_WAO = 14 * MiB;
constexpr size_t WS_W1 = 18 * MiB;
constexpr size_t WS_W2 = 50 * MiB;
constexpr size_t WS_WKV = 82 * MiB;
constexpr size_t WS_WBIN = 85 * MiB;
constexpr size_t WS_WBO = 90 * MiB;
constexpr size_t WS_WC1 = 94 * MiB;
constexpr size_t WS_XN = 96 * MiB;
constexpr size_t WS_BIG = 160 * MiB;
constexpr size_t WS_HID = 224 * MiB;
constexpr size_t WS_KV = 352 * MiB;
constexpr size_t WS_CMP = 448 * MiB;
constexpr size_t WS_O1 = 450 * MiB;
constexpr size_t WS_END = 482 * MiB;

namespace pg8 {
#define PG8_LAS __attribute__((address_space(3)))
constexpr int BM = 256, BK = 64, HALF = 128, HTB = HALF * BK * 2, STAGE_BYTES = 8 * HTB, NXCD = 8, WGM = 8;
__host__ __device__ __forceinline__ int lds_byte(int r, int c) { const int st = (r >> 4) * 2 + (c >> 5), rr = r & 15, cc = c & 31, ob = rr * 64 + cc * 2; return st * 1024 + (ob ^ (((ob >> 9) & 1) << 5)); }
__host__ __device__ __forceinline__ void stage_rc(int b, int& R, int& C) { const int st = b / 1024, sb = b % 1024, swz = sb ^ (((sb >> 9) & 1) << 5); R = (st >> 1) * 16 + swz / 64; C = (st & 1) * 32 + (swz % 64) / 2; }
__host__ __device__ __forceinline__ int perm32(int rho) { const int n = rho >> 4, i = rho & 15; return 8 * (i >> 2) + 4 * n + (i & 3); }

struct Unit { int pm, pn; };
struct Gemm { const bf16_t* A; const bf16_t* Bt; int M, N, K; };

struct Sched {
    int nM, nN, nwg, G, c, mode;
    __device__ void init(int M_, int N_, int G_, int c_, int mode_) { nM = M_ / BM; nN = N_ / BM; nwg = mode_ ? nM : nM * nN; G = G_; c = c_; mode = mode_; }
    __device__ bool next(int i, Unit& u) const {
        const long L = (long)i * G + c; if (L >= nwg) return false;
        if (mode == 1) { u.pm = (int)L; u.pn = (int)L >> 5; return true; }
        int wgid = (int)L; { const int q = nwg / NXCD, r = nwg % NXCD, xcd = wgid % NXCD, off = wgid / NXCD; wgid = (xcd < r ? xcd * (q + 1) : r * (q + 1) + (xcd - r) * q) + off; }
        const int nig = WGM * nN, gid = wgid / nig, fm = gid * WGM, gsz = (nM - fm) < WGM ? (nM - fm) : WGM;
        u.pm = fm + ((wgid % nig) % gsz); u.pn = (wgid % nig) / gsz; return true;
    }
    __device__ __forceinline__ void a_ready(const Unit&) const {}
    __device__ __forceinline__ void done(const Unit&) const {}
};

__device__ __forceinline__ float act_fn(float v, int act) {
    if (act == 1) { const float r = fmaxf(v, 0.f); return r * r; }
    if (act == 2) { const float u = 0.7978845608028654f * (v + 0.044715f * v * v * v); return v * __builtin_amdgcn_rcpf(1.f + __expf(-2.f * u)); }
    return v;
}
struct EpiStore {
    static constexpr bool PERM = true, AFTER_DRAIN = false;
    bf16_t* O; int ldc; int act; int fold; int qcols; int mode;
    __device__ __forceinline__ void operator()(const f32x4 (&acc)[2][2][4][2], const Unit& u, int wr, int wc, int fr, int fq) const {
        const int row0 = u.pm * BM + wr * 64 + fr; const int colt = fold ? 0 : u.pn * BM; const int cw = wc * 32 + 8 * fq;
        const float qs = (u.pn * BM < qcols) ? 0.18033688011112042f : 1.0f;
        const int b = (u.pm * BM) / T, t0 = (u.pm * BM) % T + wr * 64 + fr;
        size_t base[2]; size_t rstride;
        if (mode == 1 && colt >= 1024) {
            if (colt < 2048) { rstride = 64;
#pragma unroll
                for (int bj = 0; bj < 2; ++bj) { const int hd = (colt - 1024) / 128 + bj; base[bj] = (size_t)M * 1024 + ((size_t)((b * 8 + hd) * 2 + (cw >> 6)) * T + t0) * 64 + (cw & 63); } }
            else { rstride = 128;
#pragma unroll
                for (int bj = 0; bj < 2; ++bj) { const int hd = (colt - 2048) / 128 + bj; base[bj] = (size_t)2 * M * 1024 + ((size_t)(b * 8 + hd) * T + t0) * 128 + cw; } }
        } else if (mode == 2) { rstride = 64;
#pragma unroll
            for (int bj = 0; bj < 2; ++bj) { const int c2 = bj * 128 + cw; base[bj] = ((size_t)((u.pn * 8 + b) * 4 + (c2 >> 6)) * T + t0) * 64 + (c2 & 63); }
        } else { rstride = (size_t)ldc;
#pragma unroll
            for (int bj = 0; bj < 2; ++bj) base[bj] = (size_t)row0 * ldc + colt + cw + bj * HALF;
        }
#pragma unroll
        for (int ai = 0; ai < 2; ++ai)
#pragma unroll
            for (int m = 0; m < 4; ++m) { const size_t ro = (size_t)(ai * HALF + m * 16) * rstride;
#pragma unroll
                for (int bj = 0; bj < 2; ++bj) { f32x4 v0 = acc[ai][bj][m][0], v1 = acc[ai][bj][m][1];
                    if (act) {
#pragma unroll
                        for (int e = 0; e < 4; ++e) { v0[e] = act_fn(v0[e], act); v1[e] = act_fn(v1[e], act); } }
                    v0 = v0 * qs; v1 = v1 * qs;
                    u32x4 w; w.x = cvtpk(v0[0], v0[1]); w.y = cvtpk(v0[2], v0[3]); w.z = cvtpk(v1[0], v1[1]); w.w = cvtpk(v1[2], v1[3]);
                    *(u32x4*)(O + base[bj] + ro) = w; } }
    }
};
struct EpiResid {
    static constexpr bool PERM = false, AFTER_DRAIN = false;
    const float* base; float* out; const float* gate; int row_off;
    __device__ __forceinline__ void operator()(const f32x4 (&acc)[2][2][4][2], const Unit& u, int wr, int wc, int fr, int fq) const {
        const int rt = row_off + u.pm * BM; const int b = rt / T; const int row0 = rt + wr * 64 + fr; const int col0 = u.pn * BM + wc * 32 + 4 * fq;
        f32x4 gv[2][2];
#pragma unroll
        for (int bj = 0; bj < 2; ++bj)
#pragma unroll
            for (int n = 0; n < 2; ++n) gv[bj][n] = *(const f32x4*)(gate + (size_t)b * 6144 + col0 + bj * HALF + n * 16);
#pragma unroll
        for (int aim = 0; aim < 4; ++aim) { const int ai = aim >> 1, m0 = (aim & 1) * 2;
            f32x4 xin[2][2][2];
#pragma unroll
            for (int mm = 0; mm < 2; ++mm) { const size_t off = (size_t)(row0 + ai * HALF + (m0 + mm) * 16) * D + col0;
#pragma unroll
                for (int bj = 0; bj < 2; ++bj)
#pragma unroll
                    for (int n = 0; n < 2; ++n) xin[mm][bj][n] = *(const f32x4*)(base + off + bj * HALF + n * 16); }
            asm volatile("" ::: "memory");
#pragma unroll
            for (int mm = 0; mm < 2; ++mm) { const int m = m0 + mm; const size_t off = (size_t)(row0 + ai * HALF + m * 16) * D + col0;
#pragma unroll
                for (int bj = 0; bj < 2; ++bj)
#pragma unroll
                    for (int n = 0; n < 2; ++n) *(f32x4*)(out + off + bj * HALF + n * 16) = xin[mm][bj][n] + gv[bj][n] * acc[ai][bj][m][n]; }
            asm volatile("" ::: "memory");
        }
    }
};

template <class Epi, class SchedT, bool ALIGN_EPI = false, bool SP2 = false>
__device__ __forceinline__ void gemm_phase(PG8_LAS unsigned char* lds, const Gemm g, const SchedT& S, const Epi& E) {
    int tid_ = threadIdx.x; asm volatile("" : "+v"(tid_));
    const int tid = tid_, wid = __builtin_amdgcn_readfirstlane(tid >> 6), lane = tid & 63, wr = wid >> 2, wc = wid & 3, fr = lane & 15, fq = lane >> 4;
    const int K = g.K, nt = K / BK;
    unsigned voffA[2], voffB[2];
#pragma unroll
    for (int i = 0; i < 2; ++i) { int R, C; stage_rc(tid * 16 + i * 8192, R, C); const int Rb = Epi::PERM ? ((R & ~31) + perm32(R & 31)) : R;
        voffA[i] = (unsigned)(R * K + C) * 2u; voffB[i] = (unsigned)(Rb * K + C) * 2u; }
    const size_t kstep = (size_t)(BK * 2);
    const size_t hstep = (size_t)HALF * K * 2;
    const size_t tstep = 2 * hstep;
    const unsigned ldsw = (unsigned)wid * 1024u;
    const int aoff = lds_byte(wr * 64 + fr, fq * 8), boff = lds_byte(wc * 32 + fr, fq * 8);
#define PG8_SA(b, h) (((b) * 2 + (h)) * HTB)
#define PG8_SB(b, h) ((4 + (b) * 2 + (h)) * HTB)
#define PG8_STAGE(bufoff, gbase, voff) do { _Pragma("unroll") for (int _i = 0; _i < 2; ++_i) \
        __builtin_amdgcn_global_load_lds((const unsigned*)((const char*)(gbase) + (voff)[_i]), (PG8_LAS unsigned*)(lds + (bufoff) + ldsw + _i * 8192), 16, 0, 0); } while (0)
#define PG8_LDA(dst, b, h) do { _Pragma("unroll") for (int m = 0; m < 4; ++m) _Pragma("unroll") for (int k = 0; k < 2; ++k) dst[m][k] = *(const PG8_LAS bf16x8*)(lds + PG8_SA(b, h) + aoff + m * 2048 + k * 1024); } while (0)
#define PG8_LDB(dst, b, h) do { _Pragma("unroll") for (int n = 0; n < 2; ++n) _Pragma("unroll") for (int k = 0; k < 2; ++k) dst[n][k] = *(const PG8_LAS bf16x8*)(lds + PG8_SB(b, h) + boff + n * 2048 + k * 1024); } while (0)
#define PG8_MMA(ai, bj, At, Bt) do { __builtin_amdgcn_s_setprio(1); _Pragma("unroll") for (int m = 0; m < 4; ++m) _Pragma("unroll") for (int n = 0; n < 2; ++n) _Pragma("unroll") for (int k = 0; k < 2; ++k) \
        acc[ai][bj][m][n] = __builtin_amdgcn_mfma_f32_16x16x32_bf16(Bt[n][k], At[m][k], acc[ai][bj][m][n], 0, 0, 0); __builtin_amdgcn_s_setprio(0); } while (0)
#define PG8_WAIT_V(n) asm volatile("s_waitcnt vmcnt(" #n ")" ::: "memory")
#define PG8_WAIT_L(n) asm volatile("s_waitcnt lgkmcnt(" #n ")" ::: "memory")
#define PG8_BAR __builtin_amdgcn_s_barrier()
#define PG8_SCHED __builtin_amdgcn_sched_barrier(0)
    Unit cur, nxt; int ui = 0;
    if (!S.next(0, cur)) return;
    f32x4 acc[2][2][4][2];
#pragma unroll
    for (int a = 0; a < 2; ++a)
#pragma unroll
        for (int b = 0; b < 2; ++b)
#pragma unroll
            for (int m = 0; m < 4; ++m)
#pragma unroll
                for (int n = 0; n < 2; ++n) acc[a][b][m][n] = (f32x4){0.f, 0.f, 0.f, 0.f};
    bf16x8 At[4][2], B0[2][2], B1[2][2];
    const char* cA = (const char*)g.A + (size_t)cur.pm * tstep; const char* cB = (const char*)g.Bt + (size_t)cur.pn * tstep;
    S.a_ready(cur);
    if constexpr (SP2) {
        PG8_STAGE(PG8_SB(0, 0), cB, voffB); PG8_STAGE(PG8_SB(0, 1), cB + hstep, voffB); PG8_STAGE(PG8_SA(0, 0), cA, voffA); PG8_STAGE(PG8_SA(0, 1), cA + hstep, voffA);
        if (wr == 1) PG8_BAR;
        PG8_WAIT_V(2); PG8_BAR;
        PG8_STAGE(PG8_SB(1, 0), cB + kstep, voffB); PG8_STAGE(PG8_SA(1, 0), cA + kstep, voffA); PG8_STAGE(PG8_SB(1, 1), cB + hstep + kstep, voffB);
        PG8_WAIT_V(6); PG8_BAR;
    } else {
        PG8_STAGE(PG8_SB(0, 0), cB, voffB); PG8_STAGE(PG8_SA(0, 0), cA, voffA); PG8_STAGE(PG8_SB(0, 1), cB + hstep, voffB); PG8_STAGE(PG8_SA(0, 1), cA + hstep, voffA);
        if (wr == 1) PG8_BAR;
        PG8_WAIT_V(4); PG8_BAR;
        PG8_STAGE(PG8_SB(1, 0), cB + kstep, voffB); PG8_STAGE(PG8_SA(1, 0), cA + kstep, voffA); PG8_STAGE(PG8_SB(1, 1), cB + hstep + kstep, voffB);
        PG8_WAIT_V(6); PG8_BAR;
    }
    for (;;) {
        const bool has_next = S.next(ui + 1, nxt);
        const char* nA = has_next ? (const char*)g.A + (size_t)nxt.pm * tstep : cA; const char* nB = has_next ? (const char*)g.Bt + (size_t)nxt.pn * tstep : cB;
        for (int t = 0; t < nt; t += 2) {
            const bool last = (t == nt - 2);
            const char* a1 = cA + (size_t)(t + 1) * kstep;
            const char* a2 = last ? nA : cA + (size_t)(t + 2) * kstep; const char* b2 = last ? nB : cB + (size_t)(t + 2) * kstep;
            const char* a3 = a2 + kstep; const char* b3 = b2 + kstep;
            if (last && has_next) S.a_ready(nxt);
            if constexpr (SP2) {
            PG8_LDB(B0, 0, 0); PG8_LDB(B1, 0, 1); PG8_SCHED; PG8_LDA(At, 0, 0); PG8_STAGE(PG8_SA(1, 1), a1 + hstep, voffA);
            PG8_WAIT_V(8); PG8_WAIT_L(0); PG8_BAR; PG8_MMA(0, 0, At, B0); PG8_MMA(0, 1, At, B1); PG8_BAR; PG8_SCHED;
            PG8_LDA(At, 0, 1); PG8_STAGE(PG8_SB(0, 0), b2, voffB); PG8_STAGE(PG8_SB(0, 1), b2 + hstep, voffB); PG8_STAGE(PG8_SA(0, 0), a2, voffA);
            PG8_WAIT_V(8); PG8_WAIT_L(0); PG8_BAR; PG8_MMA(1, 0, At, B0); PG8_MMA(1, 1, At, B1); PG8_BAR; PG8_SCHED;
            PG8_LDB(B0, 1, 0); PG8_LDB(B1, 1, 1); PG8_SCHED; PG8_LDA(At, 1, 0); PG8_STAGE(PG8_SA(0, 1), a2 + hstep, voffA);
            PG8_WAIT_V(8); PG8_WAIT_L(0); PG8_BAR; PG8_MMA(0, 0, At, B0); PG8_MMA(0, 1, At, B1); PG8_BAR; PG8_SCHED;
            PG8_LDA(At, 1, 1); PG8_STAGE(PG8_SB(1, 0), b3, voffB); PG8_STAGE(PG8_SB(1, 1), b3 + hstep, voffB); PG8_STAGE(PG8_SA(1, 0), a3, voffA);
            PG8_WAIT_V(8); PG8_WAIT_L(0); PG8_BAR; PG8_MMA(1, 0, At, B0); PG8_MMA(1, 1, At, B1); PG8_BAR; PG8_SCHED;
            } else {
            PG8_LDB(B0, 0, 0); PG8_SCHED; PG8_LDA(At, 0, 0); PG8_STAGE(PG8_SA(1, 1), a1 + hstep, voffA);
            PG8_WAIT_L(8); PG8_BAR; PG8_WAIT_L(0); PG8_MMA(0, 0, At, B0); PG8_BAR; PG8_SCHED;
            PG8_LDB(B1, 0, 1); PG8_STAGE(PG8_SB(0, 0), b2, voffB);
            PG8_BAR; PG8_WAIT_L(0); PG8_MMA(0, 1, At, B1); PG8_BAR;
            PG8_LDA(At, 0, 1); PG8_STAGE(PG8_SA(0, 0), a2, voffA);
            PG8_BAR; PG8_WAIT_L(0); PG8_MMA(1, 0, At, B0); PG8_BAR; PG8_SCHED;
            PG8_STAGE(PG8_SB(0, 1), b2 + hstep, voffB);
            PG8_WAIT_V(6); PG8_BAR; PG8_MMA(1, 1, At, B1); PG8_BAR;
            PG8_LDB(B0, 1, 0); PG8_SCHED; PG8_LDA(At, 1, 0); PG8_STAGE(PG8_SA(0, 1), a2 + hstep, voffA);
            PG8_WAIT_L(8); PG8_BAR; PG8_WAIT_L(0); PG8_MMA(0, 0, At, B0); PG8_BAR; PG8_SCHED;
            PG8_LDB(B1, 1, 1); PG8_STAGE(PG8_SB(1, 0), b3, voffB);
            PG8_BAR; PG8_WAIT_L(0); PG8_MMA(0, 1, At, B1); PG8_BAR;
            PG8_LDA(At, 1, 1); PG8_STAGE(PG8_SA(1, 0), a3, voffA);
            PG8_BAR; PG8_WAIT_L(0); PG8_MMA(1, 0, At, B0); PG8_BAR; PG8_SCHED;
            PG8_STAGE(PG8_SB(1, 1), b3 + hstep, voffB);
            PG8_WAIT_V(6); PG8_BAR; PG8_MMA(1, 1, At, B1); PG8_BAR;
            }
        }
        if constexpr (ALIGN_EPI) { if (wr == 0) PG8_BAR; }
        if constexpr (!Epi::AFTER_DRAIN) { E(acc, cur, wr, wc, fr, fq); S.done(cur); }
        if (!has_next) break;
#pragma unroll
        for (int a = 0; a < 2; ++a)
#pragma unroll
            for (int b = 0; b < 2; ++b)
#pragma unroll
                for (int m = 0; m < 4; ++m)
#pragma unroll
                    for (int n = 0; n < 2; ++n) acc[a][b][m][n] = (f32x4){0.f, 0.f, 0.f, 0.f};
        cur = nxt; cA = nA; cB = nB; ++ui;
        if constexpr (ALIGN_EPI) { if (wr == 1) PG8_BAR; }
    }
    PG8_WAIT_V(0);
    if constexpr (!ALIGN_EPI) { if (wr == 0) PG8_BAR; }
    PG8_BAR;
#undef PG8_SA
#undef PG8_SB
#undef PG8_STAGE
#undef PG8_LDA
#undef PG8_LDB
#undef PG8_MMA
#undef PG8_WAIT_V
#undef PG8_WAIT_L
#undef PG8_BAR
#undef PG8_SCHED
}
}

__device__ __forceinline__ float wave_sum(float v, int lane) {
#pragma unroll
    for (int o = 1; o < 64; o <<= 1) v += __builtin_bit_cast(float, __builtin_amdgcn_ds_bpermute((lane ^ o) << 2, __builtin_bit_cast(int, v)));
    return v;
}
__device__ __forceinline__ int t5_bucket(int n) { if (n < 16) return n; const int v = 16 + (int)(__log2f((float)n * 0.0625f) * (16.0f / 3.0f)); return v > 31 ? 31 : v; }
__device__ __forceinline__ unsigned f2bf(float f) { unsigned u = __builtin_bit_cast(unsigned, f); return (u + 0x7fffu + ((u >> 16) & 1u)) >> 16; }
__device__ __forceinline__ unsigned pk2(float lo, float hi) { return f2bf(lo) | (f2bf(hi) << 16); }

__device__ __forceinline__ void transpose_item(const float* W, int K, int Nsrc, bf16_t* WT, LAS float* scr, int item, int lane) {
    const int nblk = (Nsrc + 31) / 32, kb = item / nblk, nb = item % nblk, k0 = 64 * kb, n0 = 32 * nb;
    const int ncol = n0 + (lane & 31); const bool okc = ncol < Nsrc;
    float tv[32];
#pragma unroll
    for (int i = 0; i < 32; ++i) { const int kk = 2 * i + (lane >> 5); tv[i] = okc ? W[(size_t)(k0 + kk) * Nsrc + ncol] : 0.f; }
#pragma unroll
    for (int i = 0; i < 32; ++i) { const int kk = 2 * i + (lane >> 5); scr[kk * 33 + (lane & 31)] = tv[i]; }
    asm volatile("s_waitcnt lgkmcnt(0)" ::: "memory");
    const int c = lane & 7;
#pragma unroll
    for (int j = 0; j < 4; ++j) { const int n = (lane >> 3) + 8 * j; const LAS float* s = scr + (8 * c) * 33 + n;
        u32x4 o; o.x = pk2(s[0 * 33], s[1 * 33]); o.y = pk2(s[2 * 33], s[3 * 33]); o.z = pk2(s[4 * 33], s[5 * 33]); o.w = pk2(s[6 * 33], s[7 * 33]);
        *(u32x4*)(WT + (size_t)(n0 + n) * K + k0 + 8 * c) = o; }
    asm volatile("s_waitcnt lgkmcnt(0)" ::: "memory");
}

struct Params {
    const float* in[23];
    float* out;
    unsigned char* ws;
    int step_lo, step_hi;
};

constexpr int KP = 144;
constexpr int VP128 = 320, VP64 = 192;
constexpr int ATT_K0 = 0, ATT_V0 = 64 * KP, ATT_STAGE_DIFF = 64 * KP + 64 * VP128;
constexpr int ATT_STAGE_NSA = 64 * KP + 64 * VP64;
#define ATT_BT (4 * ATT_ST)
#define ATT_SEL (ATT_BT + 2048)
#define ATT_UM (ATT_SEL + 512)
#define ATT_IMP (ATT_UM + 64)
constexpr int LDS_BYTES = 139264;
constexpr int LDS_BARST = 139264 - 64;
static_assert(4 * 24576 + 2624 + 32768 <= LDS_BARST && 4 * 16384 + 2624 + 4 * 64 * 65 * 4 <= LDS_BARST && 2 * ATT_STAGE_NSA <= 4 * 16384, "attention LDS map");

__device__ __forceinline__ s16x4 vtr(LAS const char* p) { typedef short v4i16_t __attribute__((ext_vector_type(4))); return __builtin_bit_cast(s16x4, __builtin_amdgcn_ds_read_tr16_b64_v4i16((LAS v4i16_t*)p)); }

__device__ __forceinline__ float pair_max(float v) { float a = v, b = v; asm volatile("s_nop 1\n\tv_permlane32_swap_b32 %0, %1" : "+v"(a), "+v"(b)); return fmaxf(a, b); }
__device__ __forceinline__ float pair_sum(float v) { float a = v, b = v; asm volatile("s_nop 1\n\tv_permlane32_swap_b32 %0, %1" : "+v"(a), "+v"(b)); return a + b; }
__device__ __forceinline__ void qk_tile(f32x16& s0, f32x16& s1, const bf16x8 (&qf)[4], LAS const char* Kb, int lane) {
    LAS const char* kp = Kb + (lane & 31) * KP + (lane >> 5) * 16;
    f32x16 a = {}, b = {};
#pragma unroll
    for (int kk = 0; kk < 4; ++kk) {
        const bf16x8 k0 = *(LAS const bf16x8*)(kp + kk * 32);
        const bf16x8 k1 = *(LAS const bf16x8*)(kp + 32 * KP + kk * 32);
        a = __builtin_amdgcn_mfma_f32_32x32x16_bf16(k0, qf[kk], a, 0, 0, 0);
        b = __builtin_amdgcn_mfma_f32_32x32x16_bf16(k1, qf[kk], b, 0, 0, 0);
    }
    s0 = a; s1 = b;
}
__device__ __forceinline__ void qk_tile_lq(f32x16& s0, f32x16& s1, LAS const char* Qs, LAS const char* Kb, int lane) {
    LAS const char* kp = Kb + (lane & 31) * KP + (lane >> 5) * 16;
    f32x16 a = {}, b = {};
#pragma unroll
    for (int kk = 0; kk < 4; ++kk) {
        const bf16x8 q = *(LAS const bf16x8*)(Qs + kk * 1024 + lane * 16);
        const bf16x8 k0 = *(LAS const bf16x8*)(kp + kk * 32);
        const bf16x8 k1 = *(LAS const bf16x8*)(kp + 32 * KP + kk * 32);
        a = __builtin_amdgcn_mfma_f32_32x32x16_bf16(k0, q, a, 0, 0, 0);
        b = __builtin_amdgcn_mfma_f32_32x32x16_bf16(k1, q, b, 0, 0, 0);
    }
    s0 = a; s1 = b;
}
template <int DVB, int VP>
__device__ __forceinline__ void pv_tile(f32x16 (&o)[DVB], const bf16x8 (&P)[4], LAS const char* Vb, int lane) {
    const int i = lane & 15, gidx = lane >> 4, hh = gidx >> 1, dvh = gidx & 1;
    LAS const char* vp = Vb + (hh * 4 + (i >> 2)) * VP + (16 * dvh + 4 * (i & 3)) * 2;
    s16x4 lo[DVB], hi[DVB];
#pragma unroll
    for (int c = 0; c < DVB; ++c) { lo[c] = vtr(vp + c * 64); hi[c] = vtr(vp + 8 * VP + c * 64); }
#pragma unroll
    for (int ks = 0; ks < 4; ++ks) {
        s16x4 nlo[DVB], nhi[DVB];
        if (ks < 3) {
#pragma unroll
            for (int c = 0; c < DVB; ++c) { nlo[c] = vtr(vp + (16 * (ks + 1)) * VP + c * 64); nhi[c] = vtr(vp + (16 * (ks + 1) + 8) * VP + c * 64); }
        }
#pragma unroll
        for (int c = 0; c < DVB; ++c) {
            const bf16x8 a = (bf16x8){lo[c][0], lo[c][1], lo[c][2], lo[c][3], hi[c][0], hi[c][1], hi[c][2], hi[c][3]};
            o[c] = __builtin_amdgcn_mfma_f32_32x32x16_bf16(a, P[ks], o[c], 0, 0, 0);
        }
        __builtin_amdgcn_sched_barrier(0);
        if (ks < 3) {
#pragma unroll
            for (int c = 0; c < DVB; ++c) { lo[c] = nlo[c]; hi[c] = nhi[c]; }
        }
    }
}
template <bool BIAS>
__device__ __forceinline__ void score_elem(f32x16& s0, f32x16& s1, int base, int win, LAS const float* bt) {
#pragma unroll
    for (int i = 0; i < 16; ++i) {
        const int off = (i >> 2) * 8 + (i & 3);
        const int d0 = base - off, d1 = d0 - 32;
        float b0 = 0.f, b1 = 0.f;
        if (BIAS) { b0 = bt[min(max(d0, 0), 127)]; b1 = bt[min(max(d1, 0), 127)]; }
        s0[i] = ((unsigned)d0 < (unsigned)win) ? s0[i] + b0 : -INFINITY;
        s1[i] = ((unsigned)d1 < (unsigned)win) ? s1[i] + b1 : -INFINITY;
        if (BIAS && (i & 3) == 3) __builtin_amdgcn_sched_barrier(0);
    }
}
__device__ __forceinline__ float row_max32(const f32x16& s0, const f32x16& s1) {
    float a = fmaxf(s0[0], s1[0]);
#pragma unroll
    for (int i = 1; i < 16; ++i) a = fmaxf(a, fmaxf(s0[i], s1[i]));
    return pair_max(a);
}
template <int DVB>
__device__ __forceinline__ void softmax_step(f32x16& s0, f32x16& s1, float& m, float& l, f32x16 (&o)[DVB], bf16x8 (&P)[4], bool sel) {
    float mx = row_max32(s0, s1); mx = sel ? mx : -INFINITY;
    const float mn = fmaxf(m, mx);
    {
        const float a = __builtin_amdgcn_exp2f(m - mn); l *= a;
#pragma unroll
        for (int c = 0; c < DVB; ++c) o[c] *= a;
        m = mn;
    }
    const float ms = sel ? m : INFINITY;
    float sum = 0.f;
#pragma unroll
    for (int i = 0; i < 16; ++i) { s0[i] = __builtin_amdgcn_exp2f(s0[i] - ms); s1[i] = __builtin_amdgcn_exp2f(s1[i] - ms); sum += s0[i] + s1[i]; }
    l += sum;
    u32x4 w0 = {cvtpk(s0[0], s0[1]), cvtpk(s0[2], s0[3]), cvtpk(s0[4], s0[5]), cvtpk(s0[6], s0[7])};
    u32x4 w1 = {cvtpk(s0[8], s0[9]), cvtpk(s0[10], s0[11]), cvtpk(s0[12], s0[13]), cvtpk(s0[14], s0[15])};
    u32x4 w2 = {cvtpk(s1[0], s1[1]), cvtpk(s1[2], s1[3]), cvtpk(s1[4], s1[5]), cvtpk(s1[6], s1[7])};
    u32x4 w3 = {cvtpk(s1[8], s1[9]), cvtpk(s1[10], s1[11]), cvtpk(s1[12], s1[13]), cvtpk(s1[14], s1[15])};
    P[0] = __builtin_bit_cast(bf16x8, w0); P[1] = __builtin_bit_cast(bf16x8, w1); P[2] = __builtin_bit_cast(bf16x8, w2); P[3] = __builtin_bit_cast(bf16x8, w3);
}

__device__ __forceinline__ void glds16(const void* gsrc, unsigned lds_dst) { unsigned keep;
    asm volatile("s_mov_b32 %0, m0\n\ts_mov_b32 m0, %2\n\ts_nop 0\n\tglobal_load_lds_dwordx4 %1, off\n\ts_mov_b32 m0, %0" : "=&s"(keep) : "v"(gsrc), "s"(lds_dst) : "memory"); }
template <int VW>
__device__ __forceinline__ void dma_tile(LAS char* stage, const bf16_t* Kg, const bf16_t* Vg, size_t pitchK, size_t pitchV, int k0, int lane, int wid) {
    const bf16_t* kb = Kg + (size_t)k0 * pitchK; const bf16_t* vb = Vg + (size_t)k0 * pitchV;
    const unsigned sb = (unsigned)__builtin_amdgcn_readfirstlane((int)(unsigned)(uintptr_t)stage);
    { const int r = 8 * wid + (lane >> 3), c = (lane & 7) ^ ((r >> 1) & 7);
      glds16(kb + (unsigned)(r * (unsigned)pitchK + c * 8), sb + wid * 1024); }
    if (VW == 2) {
#pragma unroll
        for (int h = 0; h < 2; ++h) { const int pc = 2 * wid + h, r = 4 * pc + (lane >> 4), c = (lane & 15) ^ ((r & 3) << 2);
            glds16(vb + (unsigned)(r * (unsigned)pitchV + c * 8), sb + 8192 + pc * 1024); }
    } else {
        const int r = 8 * wid + (lane >> 3), c = (lane & 7) ^ (((r >> 1) & 1) << 2);
        glds16(vb + (unsigned)(r * (unsigned)pitchV + c * 8), sb + 8192 + wid * 1024);
    }
}
template <bool QREG>
__device__ __forceinline__ void qk_tile_sw(f32x16& s0, f32x16& s1, const bf16x8* qf, LAS const char* Qs, LAS const char* Kb, int lane) {
    const int r = lane & 31, hh = lane >> 5, sw = (r >> 1) & 7;
    LAS const char* kp = Kb + r * 128 + ((hh ^ (sw & 1)) << 4); const int t = sw >> 1;
    f32x16 a = {}, b = {};
#pragma unroll
    for (int kk = 0; kk < 4; ++kk) {
        const bf16x8 q = QREG ? qf[kk] : *(LAS const bf16x8*)(Qs + kk * 1024 + lane * 16);
        const bf16x8 k0 = *(LAS const bf16x8*)(kp + ((kk ^ t) << 5));
        const bf16x8 k1 = *(LAS const bf16x8*)(kp + ((kk ^ t) << 5) + 32 * 128);
        a = __builtin_amdgcn_mfma_f32_32x32x16_bf16(k0, q, a, 0, 0, 0);
        b = __builtin_amdgcn_mfma_f32_32x32x16_bf16(k1, q, b, 0, 0, 0);
    }
    s0 = a; s1 = b;
}
template <int DVB, int ROWB>
__device__ __forceinline__ void pv_tile_sw(f32x16 (&o)[DVB], const bf16x8 (&P)[4], LAS const char* Vb, int lane) {
    const int i = lane & 15, gidx = lane >> 4, hh = gidx >> 1, dvh = gidx & 1;
    const int q = ROWB == 256 ? ((i >> 2) & 3) : ((i >> 3) & 1);
    LAS const char* vp = Vb + (4 * hh + (i >> 2)) * ROWB + dvh * 32 + ((i & 3) >> 1) * 16 + (i & 1) * 8;
    s16x4 lo[DVB], hi[DVB];
#pragma unroll
    for (int c = 0; c < DVB; ++c) { lo[c] = vtr(vp + ((c ^ q) << 6)); hi[c] = vtr(vp + ((c ^ q) << 6) + 8 * ROWB); }
#pragma unroll
    for (int ks = 0; ks < 4; ++ks) {
        s16x4 nlo[DVB], nhi[DVB];
        if (ks < 3) {
#pragma unroll
            for (int c = 0; c < DVB; ++c) { nlo[c] = vtr(vp + ((c ^ q) << 6) + (16 * (ks + 1)) * ROWB); nhi[c] = vtr(vp + ((c ^ q) << 6) + (16 * (ks + 1) + 8) * ROWB); }
        }
#pragma unroll
        for (int c = 0; c < DVB; ++c) {
            const bf16x8 a = (bf16x8){lo[c][0], lo[c][1], lo[c][2], lo[c][3], hi[c][0], hi[c][1], hi[c][2], hi[c][3]};
            o[c] = __builtin_amdgcn_mfma_f32_32x32x16_bf16(a, P[ks], o[c], 0, 0, 0);
        }
        __builtin_amdgcn_sched_barrier(0);
        if (ks < 3) {
#pragma unroll
            for (int c = 0; c < DVB; ++c) { lo[c] = nlo[c]; hi[c] = nhi[c]; }
        }
    }
}

template <int VW> struct TileRegs { u32x4 k; u32x4 v[VW]; };
template <int VW>
__device__ __forceinline__ void tile_issue(TileRegs<VW>& r, const bf16_t* Kg, const bf16_t* Vg, size_t pitchK, size_t pitchV, int k0, int tid) {
    const bf16_t* kb = Kg + (size_t)k0 * pitchK;
    const bf16_t* vb = Vg + (size_t)k0 * pitchV;
    r.k = *(const u32x4*)(kb + (unsigned)((tid >> 3) * (unsigned)pitchK + (tid & 7) * 8));
    if (VW == 2) {
#pragma unroll
        for (int i = 0; i < 2; ++i) { const int idx = tid + 512 * i; r.v[i] = *(const u32x4*)(vb + (unsigned)((idx >> 4) * (unsigned)pitchV + (idx & 15) * 8)); }
    } else r.v[0] = *(const u32x4*)(vb + (unsigned)((tid >> 3) * (unsigned)pitchV + (tid & 7) * 8));
}
template <int VW>
__device__ __forceinline__ void tile_commit(const TileRegs<VW>& r, LAS char* st, int tid) {
    *(LAS u32x4*)(st + ATT_K0 + (tid >> 3) * KP + (tid & 7) * 16) = r.k;
    if (VW == 2) {
#pragma unroll
        for (int i = 0; i < 2; ++i) { const int idx = tid + 512 * i; *(LAS u32x4*)(st + ATT_V0 + (idx >> 4) * VP128 + (idx & 15) * 16) = r.v[i]; }
    } else *(LAS u32x4*)(st + ATT_V0 + (tid >> 3) * VP64 + (tid & 7) * 16) = r.v[0];
}
#define TILE_LOOP_BEGIN(VW, UMASK, KG, VG, PK, PV) { \
    unsigned long long rem_ = (UMASK); int cur_ = __builtin_ctzll(rem_); rem_ &= rem_ - 1ull; int bufi_ = 0; \
    TileRegs<VW> tr_; tile_issue<VW>(tr_, KG, VG, PK, PV, cur_ * 64, tid); tile_commit<VW>(tr_, lds, tid); __syncthreads(); \
    for (;;) { const int nxt_ = rem_ ? __builtin_ctzll(rem_) : -1; if (rem_) rem_ &= rem_ - 1ull; \
        if (nxt_ >= 0) tile_issue<VW>(tr_, KG, VG, PK, PV, nxt_ * 64, tid); \
        { const int kt = cur_; LAS char* st = lds + bufi_ * ATT_STP;
#define TILE_LOOP_END(VW) } \
        if (nxt_ >= 0) tile_commit<VW>(tr_, lds + (bufi_ ^ 1) * ATT_STP, tid); \
        __syncthreads(); if (nxt_ < 0) break; cur_ = nxt_; bufi_ ^= 1; } }

#define PP_BAR() do { asm volatile("s_waitcnt lgkmcnt(0)" ::: "memory"); __builtin_amdgcn_s_barrier(); asm volatile("" ::: "memory"); } while (0)
#define PP_NEXT(t) do { if (rem_) { t = __builtin_ctzll(rem_); rem_ &= rem_ - 1ull; } else t = -1; } while (0)
#define PP_WAITV(NI, c2, c3) do { if ((c2) && (c3)) { if (NI == 3) asm volatile("s_waitcnt vmcnt(6)" ::: "memory"); else asm volatile("s_waitcnt vmcnt(4)" ::: "memory"); } \
    else if ((c2) || (c3)) { if (NI == 3) asm volatile("s_waitcnt vmcnt(3)" ::: "memory"); else asm volatile("s_waitcnt vmcnt(2)" ::: "memory"); } \
    else asm volatile("s_waitcnt vmcnt(0)" ::: "memory"); } while (0)
#define PP_BEGIN(VW, NI, UMASK, KG, VG, PK, PV) { \
    unsigned long long rem_ = (UMASK); int ta_, tb_, tc_, td_ = -1; PP_NEXT(ta_); PP_NEXT(tb_); PP_NEXT(tc_); int sj_ = 0; \
    dma_tile<VW>(lds, KG, VG, PK, PV, ta_ * 64, lane, wid); \
    if (tb_ >= 0) dma_tile<VW>(lds + ATT_ST, KG, VG, PK, PV, tb_ * 64, lane, wid); \
    if (tc_ >= 0) dma_tile<VW>(lds + 2 * ATT_ST, KG, VG, PK, PV, tc_ * 64, lane, wid); \
    PP_WAITV(NI, tb_ >= 0, tc_ >= 0); PP_BAR(); \
    for (;;) { const int kt = ta_; LAS char* st = lds + sj_ * ATT_ST; \
        if (false) { PP_NEXT(td_); if (td_ >= 0) dma_tile<VW>(lds + ((sj_ + 3) & 3) * ATT_ST, KG, VG, PK, PV, td_ * 64, lane, wid); } {
#define PP_MID(VW, NI, KG, VG, PK, PV) } \
        if (true) { PP_NEXT(td_); if (td_ >= 0) dma_tile<VW>(lds + ((sj_ + 3) & 3) * ATT_ST, KG, VG, PK, PV, td_ * 64, lane, wid); } {
#define PP_END(NI) } if (true) PP_WAITV(NI, tc_ >= 0, td_ >= 0); PP_BAR(); \
        if (tb_ < 0) break; ta_ = tb_; tb_ = tc_; tc_ = td_; td_ = -1; sj_ = (sj_ + 1) & 3; } \
    }

__device__ __forceinline__ void diff_attn_phase(LAS char* lds, const bf16_t* QKV, bf16_t* O, const float* rel_bias, const float* lam_p, const float* subln, int layer, float* stash, int G, int c) {
    constexpr int ATT_ST = 24576;
    int tid_ = threadIdx.x; asm volatile("" : "+v"(tid_));
    const int tid = tid_, lane = tid & 63, wid = __builtin_amdgcn_readfirstlane(tid >> 6), r32 = lane & 31, hh = lane >> 5;
    if (wid >= 4) __builtin_amdgcn_s_setprio(1);
    float s1 = 0.f, s2 = 0.f;
    for (int i = 0; i < 64; ++i) { s1 += lam_p[i] * lam_p[64 + i]; s2 += lam_p[128 + i] * lam_p[192 + i]; }
    const float lam_init = 0.8f - 0.6f * expf(-0.3f * (float)layer);
    const float lam = expf(s1) - expf(s2) + lam_init;
    LAS float* bt = (LAS float*)(lds + ATT_BT);
    size_t pq_ = 64, pv2_ = 128; asm volatile("" : "+s"(pq_), "+s"(pv2_));
    f32x4* mystash = (f32x4*)stash + (size_t)(wid * 64 + lane) * 16;
    for (int it = 0;; ++it) {
        int bh, qb;
        if (G == 256) { if (it >= 4) break; const int j = c >> 6; bh = c & 63; qb = it == 0 ? 15 - j : it == 1 ? 8 + j : it == 2 ? 7 - j : j; }
        else { const int id = it * G + c; if (id >= 1024) break; bh = id & 63; qb = 15 - (id >> 6); }
        const int b = bh >> 3, h = bh & 7, q0 = qb * 256; const size_t rowbase = (size_t)b * T;
        const int qw = q0 + wid * 32, qpos = qw + r32;
        const int NT = (q0 + 256) / 64;
        const unsigned long long um = NT >= 64 ? ~0ull : ((1ull << NT) - 1ull);
        for (int mp = 0; mp < 2; ++mp) {
            if (tid < 128) bt[tid] = (rel_bias[t5_bucket(tid) * 16 + h * 2 + mp] - rel_bias[31 * 16 + h * 2 + mp]) * LOG2E;
            LAS char* Qs = lds + ATT_IMP + wid * 4096;
            { const bf16_t* qp = QKV + (rowbase + qpos) * 1024 + h * 128 + mp * 64 + hh * 8;
#pragma unroll
              for (int kk = 0; kk < 4; ++kk) *(LAS bf16x8*)(Qs + kk * 1024 + lane * 16) = *(const bf16x8*)(qp + kk * 16); }
            f32x16 o[4]; o[0] = f32x16{}; o[1] = f32x16{}; o[2] = f32x16{}; o[3] = f32x16{};
            float m = -1e30f, l = 0.f;
            const bf16_t* Kg = QKV + (size_t)M * 1024 + (size_t)((b * 8 + h) * 2 + mp) * T * 64;
            const bf16_t* Vg = QKV + (size_t)2 * M * 1024 + (size_t)(b * 8 + h) * T * 128;
            bf16x8 P[4];
            PP_BEGIN(2, 3, um, Kg, Vg, pq_, pv2_)
                const int k0 = kt * 64;
                f32x16 sa, sb; qk_tile_sw<false>(sa, sb, nullptr, Qs, st, lane);
                if (qw - (k0 + 63) < 113) score_elem<true>(sa, sb, qpos - k0 - hh * 4, 1 << 30, bt);
                softmax_step<4>(sa, sb, m, l, o, P, true);
            PP_MID(2, 3, Kg, Vg, pq_, pv2_)
                pv_tile_sw<4, 256>(o, P, st + 8192, lane);
            PP_END(3)
            const float lt = pair_sum(l); const float inv = __builtin_amdgcn_rcpf(lt);
            if (mp == 0) {
#pragma unroll
                for (int cc = 0; cc < 4; ++cc)
#pragma unroll
                    for (int g4 = 0; g4 < 4; ++g4) mystash[cc * 4 + g4] = (f32x4){o[cc][g4 * 4] * inv, o[cc][g4 * 4 + 1] * inv, o[cc][g4 * 4 + 2] * inv, o[cc][g4 * 4 + 3] * inv};
            } else {
                float ss = 0.f;
#pragma unroll
                for (int cc = 0; cc < 4; ++cc)
#pragma unroll
                    for (int g4 = 0; g4 < 4; ++g4) { const f32x4 a = mystash[cc * 4 + g4];
#pragma unroll
                        for (int e = 0; e < 4; ++e) { const float v = a[e] - lam * (o[cc][g4 * 4 + e] * inv); o[cc][g4 * 4 + e] = v; ss += v * v; }
                        if (g4 == 3) __builtin_amdgcn_sched_barrier(0); }
                ss = pair_sum(ss);
                const float rs = rsqrtf(ss * (1.f / 128.f) + NORM_EPS) * (1.f - lam_init);
                bf16_t* op = O + (rowbase + qpos) * D + h * 128 + hh * 4;
#pragma unroll
                for (int cc = 0; cc < 4; ++cc)
#pragma unroll
                    for (int g4 = 0; g4 < 4; ++g4) { const int dv = cc * 32 + g4 * 8; const f32x4 sg = *(const f32x4*)(subln + dv + hh * 4);
                        u32x2 w; w.x = cvtpk(o[cc][g4 * 4] * rs * sg[0], o[cc][g4 * 4 + 1] * rs * sg[1]); w.y = cvtpk(o[cc][g4 * 4 + 2] * rs * sg[2], o[cc][g4 * 4 + 3] * rs * sg[3]);
                        *(u32x2*)(op + dv) = w; if (g4 == 3) __builtin_amdgcn_sched_barrier(0); }
            }
        }
    }
    __builtin_amdgcn_s_setprio(0);
}

__device__ __forceinline__ void nsa_phase(LAS char* lds, const bf16_t* PROJ, const bf16_t* KVB, const bf16_t* CMP, bf16_t* O, const float* rel_bias, int G, int c) {
    constexpr int ATT_ST = 16384, ATT_STP = ATT_STAGE_NSA;
    int tid_ = threadIdx.x; asm volatile("" : "+v"(tid_));
    const int tid0_ = tid_; const int tid = tid_, lane = tid & 63, wid = __builtin_amdgcn_readfirstlane(tid >> 6), r32 = lane & 31, hh = lane >> 5;
    const int r = wid & 3, qh = wid >> 2;
    if (wid >= 4) __builtin_amdgcn_s_setprio(1);
    LAS float* btall = (LAS float*)(lds + ATT_BT);
    size_t pkv_ = 64, pc_ = 64; asm volatile("" : "+s"(pkv_), "+s"(pc_));
    LAS float* bt = btall + r * 128;
    LAS unsigned long long* SEL = (LAS unsigned long long*)(lds + ATT_SEL);
    LAS unsigned* UM = (LAS unsigned*)(lds + ATT_UM);
    LAS float* IMP = (LAS float*)(lds + ATT_IMP);
    for (int it = 0;; ++it) {
        int bg, qblk;
        if (G == 256) { if (it >= 8) break; const int j = c >> 5; bg = c & 31; qblk = (it & 1) ? (56 - 8 * it + j) : (63 - 8 * it - j); }
        else { const int id = it * G + c; if (id >= 2048) break; bg = id & 31; qblk = 63 - (id >> 5); }
        const int b = bg >> 2, g = bg & 3, t0 = qblk * 64, hq = g * 4 + r; const size_t rowbase = (size_t)b * T;
        const int qw = t0 + qh * 32, qpos = qw + r32;
        btall[tid] = (rel_bias[t5_bucket(tid & 127) * 16 + g * 4 + (tid >> 7)] - rel_bias[31 * 16 + g * 4 + (tid >> 7)]) * LOG2E;
        LAS float* impr = IMP + (r * 64 + qh * 32 + r32) * 65;
        for (int jj = 0; jj < 33; ++jj) { const int idx = 2 * jj + hh; if (idx < 65) impr[idx] = 0.f; }
        if (tid < 2) UM[tid] = 0u;
        bf16x8 qf[4]; float gate[3];
        { const bf16_t* pp = PROJ + (rowbase + qpos) * NBINP;
#pragma unroll
          for (int kk = 0; kk < 4; ++kk) qf[kk] = *(const bf16x8*)(pp + hq * 64 + kk * 16 + hh * 8);
#pragma unroll
          for (int e = 0; e < 3; ++e) gate[e] = __builtin_amdgcn_rcpf(1.f + __expf(-bf2f(pp[1024 + hq * 3 + e]))); }
        f32x16 ot[2]; ot[0] = f32x16{}; ot[1] = f32x16{};
        const int nmaxb = (t0 + 32) >> 4; const int nct = min(4, (nmaxb >> 6) + 1);
        const unsigned long long umc = (1ull << nct) - 1ull;
        const bf16_t* Kc = CMP + (size_t)((0 * 8 + b) * 4 + g) * 256 * 64;
        const bf16_t* Vc = CMP + (size_t)((1 * 8 + b) * 4 + g) * 256 * 64;
        const int nlim = min((qpos - 31) >> 4, 254);
        float mc = -1e30f, lc = 0.f;
        { int tid = tid0_; asm volatile("" : "+v"(tid)); const int lane = tid & 63, r32 = lane & 31, hh = lane >> 5; (void)r32; (void)hh;
        TILE_LOOP_BEGIN(1, umc, Kc, Vc, pc_, pc_)
            f32x16 sa, sb; qk_tile(sa, sb, qf, st + ATT_K0, lane);
            score_elem<false>(sa, sb, nlim - kt * 64 - hh * 4, 1 << 30, bt);
            const float mx = row_max32(sa, sb); const float mn = fmaxf(mc, mx);
            lc *= __builtin_amdgcn_exp2f(mc - mn); mc = mn;
            float sum = 0.f;
#pragma unroll
            for (int i = 0; i < 16; ++i) sum += __builtin_amdgcn_exp2f(sa[i] - mc) + __builtin_amdgcn_exp2f(sb[i] - mc);
            lc += sum;
        TILE_LOOP_END(1) }
        {
            const float lt = pair_sum(lc); const float invl = lt > 0.f ? __builtin_amdgcn_rcpf(lt) : 0.f;
            f32x16 oc[2]; oc[0] = f32x16{}; oc[1] = f32x16{};
            int tid = tid0_; asm volatile("" : "+v"(tid)); const int lane = tid & 63, r32 = lane & 31, hh = lane >> 5; (void)r32; (void)hh;
            LAS float* impr = IMP + (r * 64 + qh * 32 + r32) * 65;
            TILE_LOOP_BEGIN(1, umc, Kc, Vc, pc_, pc_)
                f32x16 sa, sb; qk_tile(sa, sb, qf, st + ATT_K0, lane);
                score_elem<false>(sa, sb, nlim - kt * 64 - hh * 4, 1 << 30, bt);
#pragma unroll
                for (int i = 0; i < 16; ++i) { sa[i] = __builtin_amdgcn_exp2f(sa[i] - mc) * invl; sb[i] = __builtin_amdgcn_exp2f(sb[i] - mc) * invl; }
#pragma unroll
                for (int kb = 0; kb < 2; ++kb)
#pragma unroll
                    for (int ig = 0; ig < 4; ++ig) { const int j = kt * 16 + kb * 8 + ig * 2 + hh;
                        const float g4 = kb ? ((sb[ig * 4] + sb[ig * 4 + 1]) + (sb[ig * 4 + 2] + sb[ig * 4 + 3])) : ((sa[ig * 4] + sa[ig * 4 + 1]) + (sa[ig * 4 + 2] + sa[ig * 4 + 3]));
                        impr[j] += g4; }
                asm volatile("s_waitcnt lgkmcnt(0)" ::: "memory");
#pragma unroll
                for (int kb = 0; kb < 2; ++kb)
#pragma unroll
                    for (int ig = 0; ig < 4; ++ig) { const int j = kt * 16 + kb * 8 + ig * 2 + hh;
                        impr[j + 1] += kb ? sb[ig * 4 + 3] : sa[ig * 4 + 3]; }
                asm volatile("s_waitcnt lgkmcnt(0)" ::: "memory");
                bf16x8 P[4];
                { u32x4 w0 = {cvtpk(sa[0], sa[1]), cvtpk(sa[2], sa[3]), cvtpk(sa[4], sa[5]), cvtpk(sa[6], sa[7])};
                  u32x4 w1 = {cvtpk(sa[8], sa[9]), cvtpk(sa[10], sa[11]), cvtpk(sa[12], sa[13]), cvtpk(sa[14], sa[15])};
                  u32x4 w2 = {cvtpk(sb[0], sb[1]), cvtpk(sb[2], sb[3]), cvtpk(sb[4], sb[5]), cvtpk(sb[6], sb[7])};
                  u32x4 w3 = {cvtpk(sb[8], sb[9]), cvtpk(sb[10], sb[11]), cvtpk(sb[12], sb[13]), cvtpk(sb[14], sb[15])};
                  P[0] = __builtin_bit_cast(bf16x8, w0); P[1] = __builtin_bit_cast(bf16x8, w1); P[2] = __builtin_bit_cast(bf16x8, w2); P[3] = __builtin_bit_cast(bf16x8, w3); }
                pv_tile<2, VP64>(oc, P, st + ATT_V0, lane);
            TILE_LOOP_END(1)
            ot[0] = oc[0] * gate[0]; ot[1] = oc[1] * gate[0];
        }
        {
            unsigned long long wun = 0ull;
            int tid = tid0_; asm volatile("" : "+v"(tid)); const int lane = tid & 63, r32 = lane & 31, hh = lane >> 5; (void)r32; (void)hh;
#pragma unroll 1
            for (int k = 0; k < 8; ++k) {
                const int q = wid * 8 + k;
                float v = ((IMP[(0 * 64 + q) * 65 + lane] + IMP[(1 * 64 + q) * 65 + lane]) + IMP[(2 * 64 + q) * 65 + lane]) + IMP[(3 * 64 + q) * 65 + lane];
                if (lane == 0 || lane == qblk || lane == qblk - 1) v = 1e4f;
                if (lane > qblk) v = -1e30f;
                int rank = 0; const int vi = __builtin_bit_cast(int, v);
#pragma unroll 8
                for (int jj = 0; jj < 64; ++jj) { const float vj = __builtin_bit_cast(float, __builtin_amdgcn_readlane(vi, jj)); rank += (vj > v || (vj == v && jj < lane)) ? 1 : 0; }
                const unsigned long long mk = __builtin_amdgcn_ballot_w64(rank < 16 && lane <= qblk);
                if (lane == 0) SEL[q] = mk;
                wun |= mk;
            }
            if (lane == 0) { atomicOr((unsigned*)&UM[0], (unsigned)wun); atomicOr((unsigned*)&UM[1], (unsigned)(wun >> 32)); }
            __syncthreads();
        }
        {
            int tid = tid0_; asm volatile("" : "+v"(tid)); const int lane = tid & 63, r32 = lane & 31, hh = lane >> 5; (void)r32; (void)hh;
            const unsigned long long ums = (unsigned long long)UM[0] | ((unsigned long long)UM[1] << 32);
            const unsigned long long mysel = SEL[qh * 32 + r32];
            f32x16 o[2]; o[0] = f32x16{}; o[1] = f32x16{};
            float m = -1e30f, l = 0.f;
            const bf16_t* Kg = KVB + (size_t)((2 * 8 + b) * 4 + g) * T * 64;
            const bf16_t* Vg = KVB + (size_t)((3 * 8 + b) * 4 + g) * T * 64;
            bf16x8 P[4];
            PP_BEGIN(1, 2, ums, Kg, Vg, pkv_, pkv_)
                const bool sel = (mysel >> kt) & 1ull;
                const int k0 = kt * 64;
                f32x16 sa, sb; qk_tile_sw<true>(sa, sb, qf, nullptr, st, lane);
                if (qw - (k0 + 63) < 113) score_elem<true>(sa, sb, qpos - k0 - hh * 4, 1 << 30, bt);
                softmax_step<2>(sa, sb, m, l, o, P, sel);
            PP_MID(1, 2, Kg, Vg, pkv_, pkv_)
                pv_tile_sw<2, 128>(o, P, st + 8192, lane);
            PP_END(2)
            const float lt = pair_sum(l); const float sc = gate[1] * __builtin_amdgcn_rcpf(lt);
            ot[0] += o[0] * sc; ot[1] += o[1] * sc;
        }
        {
            int tid = tid0_; asm volatile("" : "+v"(tid)); const int lane = tid & 63, r32 = lane & 31, hh = lane >> 5; (void)r32; (void)hh;
            const int lo = max(0, qblk - 8);
            const unsigned long long hiM = qblk >= 63 ? ~0ull : ((1ull << (qblk + 1)) - 1ull);
            const unsigned long long umw = hiM & ~((1ull << lo) - 1ull);
            f32x16 o[2]; o[0] = f32x16{}; o[1] = f32x16{};
            float m = -1e30f, l = 0.f;
            const bf16_t* Kg = KVB + (size_t)((4 * 8 + b) * 4 + g) * T * 64;
            const bf16_t* Vg = KVB + (size_t)((5 * 8 + b) * 4 + g) * T * 64;
            bf16x8 P[4];
            PP_BEGIN(1, 2, umw, Kg, Vg, pkv_, pkv_)
                const int k0 = kt * 64;
                f32x16 sa, sb; qk_tile_sw<true>(sa, sb, qf, nullptr, st, lane);
                if (qw - (k0 + 63) < 113 || qw + 31 - k0 >= 512) score_elem<true>(sa, sb, qpos - k0 - hh * 4, 512, bt);
                softmax_step<2>(sa, sb, m, l, o, P, true);
            PP_MID(1, 2, Kg, Vg, pkv_, pkv_)
                pv_tile_sw<2, 128>(o, P, st + 8192, lane);
            PP_END(2)
            const float lt = pair_sum(l); const float sc = gate[2] * __builtin_amdgcn_rcpf(lt);
            ot[0] += o[0] * sc; ot[1] += o[1] * sc;
        }
        { int tid = tid0_; asm volatile("" : "+v"(tid)); const int lane = tid & 63, r32 = lane & 31, hh = lane >> 5; (void)r32; (void)hh;
          bf16_t* op = O + (rowbase + qpos) * D + hq * 64 + hh * 4;
#pragma unroll
          for (int cc = 0; cc < 2; ++cc)
#pragma unroll
              for (int g4 = 0; g4 < 4; ++g4) { u32x2 w; w.x = cvtpk(ot[cc][g4 * 4], ot[cc][g4 * 4 + 1]); w.y = cvtpk(ot[cc][g4 * 4 + 2], ot[cc][g4 * 4 + 3]);
                  *(u32x2*)(op + cc * 32 + g4 * 8) = w; } }
    }
    __builtin_amdgcn_s_setprio(0);
}

#define XB_TMO      128
#define XB_XCNT(j)  (256  + 64 * (j))
#define XB_XSUB(j)  (1280 + 64 * (j))
#define XB_XGEN(j)  (2304 + 64 * (j))
#define XB_TOP      3328
#define XB_TOPGEN   3392
#define XCD_BAR_WORDS 3456
#define XB_SPIN_CAP (1u << 18)

__device__ __forceinline__ unsigned xb_ld(unsigned* p)              { return __hip_atomic_load(p, __ATOMIC_RELAXED, __HIP_MEMORY_SCOPE_AGENT); }
__device__ __forceinline__ unsigned xb_add(unsigned* p, unsigned v) { return __hip_atomic_fetch_add(p, v, __ATOMIC_RELAXED, __HIP_MEMORY_SCOPE_AGENT); }
__device__ __forceinline__ unsigned xb_xcc_id() { return (unsigned)__builtin_amdgcn_s_getreg((3 << 11) | 20) & 0xFu; }
#define XB_SPIN(cond, bar) do { unsigned _sp = 0; while (cond) { __builtin_amdgcn_s_sleep(1); \
    if ((++_sp & 255u) == 0u) { if (xb_ld(&(bar)[XB_TMO])) break; if (_sp > XB_SPIN_CAP) { atomicAdd(&(bar)[XB_TMO], 1u); break; } } } } while (0)

struct XcdBarrier {
    unsigned* bar; unsigned x;
    volatile LAS unsigned* st;
};

__device__ __forceinline__ XcdBarrier xcd_barrier_post(unsigned* bar, volatile LAS unsigned* st) {
    XcdBarrier b; b.bar = bar; b.x = xb_xcc_id(); b.st = st;
    if (threadIdx.x == 0) (void)xb_add(&bar[XB_XCNT(b.x)], 1u);
    return b;
}
__device__ __forceinline__ void xcd_barrier_complete(unsigned* bar, unsigned x, unsigned& nloc, unsigned& nx) {
    const unsigned G = gridDim.x * gridDim.y * gridDim.z;
    unsigned sum, cnt, mine, sp = 0u;
    for (;;) {
        sum = 0u; cnt = 0u; mine = 0u;
#pragma unroll
        for (unsigned j = 0; j < 16; ++j) { const unsigned c = xb_ld(&bar[XB_XCNT(j)]); sum += c; cnt += (c > 0u) ? 1u : 0u; mine = (j == x) ? c : mine; }
        if (sum == G) break;
        __builtin_amdgcn_s_sleep(1);
        if ((++sp & 255u) == 0u) { if (xb_ld(&bar[XB_TMO])) break; if (sp > XB_SPIN_CAP) { atomicAdd(&bar[XB_TMO], 1u); break; } }
    }
    nloc = mine > 0u ? mine : 1u; nx = cnt > 0u ? cnt : 1u;
}

__device__ __forceinline__ void xcd_barrier(const XcdBarrier& b) {
    asm volatile("s_waitcnt vmcnt(0)" ::: "memory");
    __syncthreads();
    if (threadIdx.x == 0) {
        unsigned* bar = b.bar;
        __builtin_amdgcn_s_waitcnt(0);
        unsigned nloc = b.st[0], nx = b.st[1];
        if (nloc == 0u) { xcd_barrier_complete(bar, b.x, nloc, nx); b.st[0] = nloc; b.st[1] = nx; }
        const unsigned old = xb_add(&bar[XB_XSUB(b.x)], 1u);
        const unsigned gen = old / nloc;
        if (old + 1u == (gen + 1u) * nloc) {
            __builtin_amdgcn_fence(__ATOMIC_RELEASE, "agent");
            asm volatile("s_waitcnt vmcnt(0)" ::: "memory");
            const unsigned og = xb_add(&bar[XB_TOP], 1u);
            const unsigned tg = og / nx;
            if (og + 1u == (tg + 1u) * nx) xb_add(&bar[XB_TOPGEN], 1u);
            else XB_SPIN(xb_ld(&bar[XB_TOPGEN]) == tg, bar);
            __builtin_amdgcn_fence(__ATOMIC_ACQUIRE, "agent");
            xb_add(&bar[XB_XGEN(b.x)], 1u);
            asm volatile("s_waitcnt vmcnt(0)" ::: "memory");
        } else {
            XB_SPIN(xb_ld(&bar[XB_XGEN(b.x)]) == gen, bar);
            __builtin_amdgcn_fence(__ATOMIC_ACQUIRE, "agent");
            asm volatile("s_waitcnt vmcnt(0)" ::: "memory");
        }
    }
    __syncthreads();
}

__global__ void __launch_bounds__(512, 2) mk_fwd(Params p) {
    extern __shared__ __attribute__((aligned(16))) unsigned char lds_raw[];
    LAS unsigned char* lds = (LAS unsigned char*)lds_raw;
    volatile LAS unsigned* bar_st = (volatile LAS unsigned*)(lds + LDS_BARST);
    if (threadIdx.x < 2) bar_st[threadIdx.x] = 0u;
    __syncthreads();
    (void)xcd_barrier_post((unsigned*)(p.ws + WS_BAR), bar_st);
    typedef const char __attribute__((address_space(4)))* kaptr_t;
    for (int step = p.step_lo; step < p.step_hi; ++step) {
        kaptr_t ka = (kaptr_t)__builtin_amdgcn_kernarg_segment_ptr();
        asm volatile("" : "+s"(ka));
        int tid_ = threadIdx.x; asm volatile("" : "+v"(tid_));
        int c_ = blockIdx.x; asm volatile("" : "+s"(c_));
        int G_ = gridDim.x; asm volatile("" : "+s"(G_));
        const int tid = tid_, lane = tid & 63, wave = __builtin_amdgcn_readfirstlane(tid >> 6);
        const int G = G_, c = c_;
        const int gw = c * 8 + wave, NGW = G * 8;
#define PIN(i) (*(const float* const __attribute__((address_space(4)))*)(ka + 8 * (i)))
        unsigned char* ws = *(unsigned char* const __attribute__((address_space(4)))*)(ka + 8 * 24);
        const float* x_in = PIN(0);
        float* xres = *(float* const __attribute__((address_space(4)))*)(ka + 8 * 23);
        float* mod = (float*)(ws + WS_MOD);
        float* kvmod = (float*)(ws + WS_KVMOD);
        bf16_t* XN = (bf16_t*)(ws + WS_XN);
        bf16_t* BIG = (bf16_t*)(ws + WS_BIG);
        bf16_t* HID = (bf16_t*)(ws + WS_HID);
        bf16_t* KVB = (bf16_t*)(ws + WS_KV);
        bf16_t* CMP = (bf16_t*)(ws + WS_CMP);
        int kind, layer = 0, sub = 0;
        int es = step;
#ifdef DUP_CLASS
        {
            int s = 0, e = 0;
            for (e = 0; e < 43; ++e) {
                int k2, l2 = 0, s2 = 0;
                if (e == 0) k2 = 0; else if (e <= 18) { k2 = 1; l2 = (e - 1) / 9; s2 = (e - 1) % 9; } else if (e <= 23) { k2 = 2; s2 = e - 19; } else if (e <= 41) { k2 = 1; l2 = 2 + (e - 24) / 9; s2 = (e - 24) % 9; } else k2 = 3;
                const bool d = (DUP_CLASS == 1 && k2 == 1 && s2 == 2 && l2 < 2) || (DUP_CLASS == 2 && k2 == 1 && s2 == 2 && l2 >= 2) ||
                               (DUP_CLASS == 3 && k2 == 1 && (s2 == 5 || s2 == 7)) || (DUP_CLASS == 4 && ((k2 == 1 && (s2 == 0 || s2 == 4)) || (k2 == 2 && s2 == 0))) ||
                               (DUP_CLASS == 5 && k2 == 1 && s2 == 1) || (DUP_CLASS == 6 && k2 == 0) || (DUP_CLASS == 7 && k2 == 2);
                if (s == step) break; ++s; if (d) { if (s == step) break; ++s; }
            }
            es = e;
        }
#endif
        if (es == 0) kind = 0;
        else if (es <= 18) { kind = 1; layer = (es - 1) / 9; sub = (es - 1) % 9; }
        else if (es <= 23) { kind = 2; sub = es - 19; }
        else if (es <= 41) { kind = 1; layer = 2 + (es - 24) / 9; sub = (es - 24) % 9; }
        else kind = 3;

        int gwn = gw, ngwn = NGW;
        if (G > 128) {
            if (kind == 1 && layer == 2 && sub == 0) continue;
            if (kind == 2 && sub == 3 && c >= 64) { kind = 1; layer = 2; sub = 0; gwn = (c - 64) * 8 + wave; ngwn = (G - 64) * 8; }
        }
        if (kind == 0) {
            {
                LAS float* scr = (LAS float*)(lds + wave * 16384);
                for (int it = gw;; it += NGW) {
                    int rr = it; const float* src; bf16_t* dst; int K, Ns;
                    if (rr < 2 * 1536) { const int l = rr / 1536; rr %= 1536; src = PIN(9) + (size_t)l * D * NQKV; dst = (bf16_t*)(ws + WS_WQKV) + (size_t)l * NQKV * D; K = D; Ns = NQKV; }
                    else if ((rr -= 3072) < 2 * 512) { const int l = rr / 512; rr %= 512; src = PIN(10) + (size_t)l * D * D; dst = (bf16_t*)(ws + WS_WAO) + (size_t)l * D * D; K = D; Ns = D; }
                    else if ((rr -= 1024) < 4 * 2048) { const int l = rr / 2048; rr %= 2048; src = PIN(7) + (size_t)l * D * FF; dst = (bf16_t*)(ws + WS_W1) + (size_t)l * D * FF; K = D; Ns = FF; }
                    else if ((rr -= 8192) < 4 * 2048) { const int l = rr / 2048; rr %= 2048; src = PIN(8) + (size_t)l * D * FF; dst = (bf16_t*)(ws + WS_W2) + (size_t)l * D * FF; K = FF; Ns = D; }
                    else if ((rr -= 8192) < 768) { src = PIN(16); dst = (bf16_t*)(ws + WS_WKV); K = D; Ns = NKV; }
                    else if ((rr -= 768) < 2 * 544) { const int l = rr / 544; rr %= 544; src = PIN(20) + (size_t)l * D * NBIN; dst = (bf16_t*)(ws + WS_WBIN) + (size_t)l * NBINP * D; K = D; Ns = NBIN; }
                    else if ((rr -= 1088) < 2 * 512) { const int l = rr / 512; rr %= 512; src = PIN(21) + (size_t)l * D * D; dst = (bf16_t*)(ws + WS_WBO) + (size_t)l * D * D; K = D; Ns = D; }
                    else if ((rr -= 1024) < 2 * 256) { const int l = rr / 256; rr %= 256; src = PIN(18) + (size_t)l * 2048 * 256; dst = (bf16_t*)(ws + WS_WC1) + (size_t)l * 256 * 2048; K = 2048; Ns = 256; }
                    else break;
                    transpose_item(src, K, Ns, dst, scr, rr, lane);
                }
                { unsigned z_ = 0u; asm volatile("" : "+v"(z_));
                for (int i = c * 512 + tid; i < 2 * 192 * 1024 / 8; i += G * 512) { const int l = i / (192 * 128), rem = i % (192 * 128);
                    *(u32x4*)((bf16_t*)(ws + WS_WBIN) + (size_t)l * NBINP * D + (size_t)1088 * D + (size_t)rem * 8) = (u32x4){z_, z_, z_, z_}; } }
            }
            __syncthreads();
            {
                LAS float* cact = (LAS float*)lds;
                LAS float* red = (LAS float*)(lds + 32768);
                for (int i = tid; i < 8192; i += 512) { const float v = PIN(1)[i]; cact[i] = v * __builtin_amdgcn_rcpf(1.f + __expf(-v)); }
                __syncthreads();
                for (int cgi = c; cgi < 416; cgi += G) {
                    const float* W; const float* bias; float* outp; int N, col0, ostride;
                    if (cgi < 384) { const int l = cgi / 96; col0 = (cgi % 96) * 64; W = PIN(3) + (size_t)l * D * 6144; N = 6144; bias = PIN(4) + l * 6144; outp = mod + (size_t)l * 8 * 6144; ostride = 6144; }
                    else { col0 = (cgi - 384) * 64; W = PIN(13); N = 2048; bias = PIN(14); outp = kvmod; ostride = 2048; }
                    float acc[8];
#pragma unroll
                    for (int b = 0; b < 8; ++b) acc[b] = 0.f;
                    const float* wp = W + (size_t)(wave * 128) * N + col0 + lane;
#pragma unroll 32
                    for (int k = 0; k < 128; ++k) { const float wv = wp[(size_t)k * N];
#pragma unroll
                        for (int b = 0; b < 8; ++b) acc[b] += cact[b * 1024 + wave * 128 + k] * wv; }
#pragma unroll
                    for (int b = 0; b < 8; ++b) red[(wave * 8 + b) * 64 + lane] = acc[b];
                    __syncthreads();
                    { const int b = tid >> 6; float s = 0.f;
#pragma unroll
                      for (int w = 0; w < 8; ++w) s += red[(w * 8 + b) * 64 + lane];
                      outp[(size_t)b * ostride + col0 + lane] = s + bias[col0 + lane]; }
                    __syncthreads();
                }
            }
        } else if (kind == 3 || (kind == 1 && (sub == 0 || sub == 4)) || (kind == 2 && sub == 0)) {
            const float* src = (kind == 1 && layer == 0 && sub == 0) ? x_in : xres;
            const float* gamma; const float* shift = nullptr; const float* scale = nullptr; int bstride = 0;
            if (kind == 3) gamma = PIN(22);
            else if (kind == 2) { gamma = PIN(15); shift = kvmod; scale = kvmod + 1024; bstride = 2048; }
            else if (sub == 0) { gamma = PIN(5) + layer * D; shift = mod + (size_t)layer * 8 * 6144; scale = shift + 1024; bstride = 6144; }
            else { gamma = PIN(6) + layer * D; shift = mod + (size_t)layer * 8 * 6144 + 3072; scale = shift + 1024; bstride = 6144; }
            int tid = tid_; asm volatile("" : "+v"(tid)); const int lane = tid & 63; (void)lane;
            for (int chunk = gwn; chunk < M / 16; chunk += ngwn) {
                const int row0 = chunk * 16, b = row0 / T;
                f32x4 A[4], Bv[4];
#pragma unroll
                for (int j = 0; j < 4; ++j) { const int col = 4 * lane + 256 * j; const f32x4 gm = *(const f32x4*)(gamma + col);
                    if (scale) { const f32x4 sc = *(const f32x4*)(scale + (size_t)b * bstride + col); A[j] = gm * (sc + 1.0f); Bv[j] = *(const f32x4*)(shift + (size_t)b * bstride + col); }
                    else { A[j] = gm; Bv[j] = (f32x4){0.f, 0.f, 0.f, 0.f}; } }
#pragma unroll 1
                for (int rq = 0; rq < 16; rq += 4) {
                    f32x4 v[4][4];
#pragma unroll
                    for (int r4 = 0; r4 < 4; ++r4)
#pragma unroll
                        for (int j = 0; j < 4; ++j) v[r4][j] = *(const f32x4*)(src + (size_t)(row0 + rq + r4) * D + 4 * lane + 256 * j);
#pragma unroll
                    for (int r4 = 0; r4 < 4; ++r4) {
                        const size_t ro = (size_t)(row0 + rq + r4) * D; float ss = 0.f;
#pragma unroll
                        for (int j = 0; j < 4; ++j) ss += (v[r4][j].x * v[r4][j].x + v[r4][j].y * v[r4][j].y) + (v[r4][j].z * v[r4][j].z + v[r4][j].w * v[r4][j].w);
                        const float rstd = rsqrtf(wave_sum(ss, lane) * (1.f / D) + NORM_EPS);
#pragma unroll
                        for (int j = 0; j < 4; ++j) { const f32x4 y = v[r4][j] * rstd * A[j] + Bv[j];
                            if (kind == 3) *(f32x4*)(xres + ro + 4 * lane + 256 * j) = y;
                            else { u32x2 w; w.x = cvtpk(y.x, y.y); w.y = cvtpk(y.z, y.w); *(u32x2*)(XN + ro + 4 * lane + 256 * j) = w; } }
                    }
                }
            }
        } else if (kind == 1 && sub == 2) {
#ifndef NO_DIFF
            if (layer < 2) diff_attn_phase((LAS char*)lds, BIG, XN, PIN(2), PIN(11) + layer * 256, PIN(12) + layer * 128, layer, (float*)(ws + WS_O1) + (size_t)c * 32768, G, c);
#endif
#ifndef NO_NSA
            if (layer >= 2) nsa_phase((LAS char*)lds, BIG, KVB, CMP, XN, PIN(2), G, c);
#endif
        } else if (kind == 2 && sub == 2) {
            int tid = tid_; asm volatile("" : "+v"(tid)); const int lane = tid & 63; (void)lane;
            for (size_t idx = (size_t)c * 512 + tid; idx < (size_t)16384 * 256; idx += (size_t)G * 512) {
                const int row = (int)(idx >> 8), c8 = (int)(idx & 255), l = c8 >> 3, d0 = (c8 & 7) * 8;
                const int n = row & 255, g = (row >> 8) & 3, b = (row >> 10) & 7, s = row >> 13;
                const int t = 16 * n + l;
                unsigned z_ = 0u; asm volatile("" : "+v"(z_));
                u32x4 o = {z_, z_, z_, z_};
                if (t < T) {
                    const u32x4 kv = *(const u32x4*)(KVB + ((size_t)((s * 8 + b) * 4 + g) * T + t) * 64 + d0);
                    const float* pp = PIN(17) + (s * 32 + l) * 64 + d0;
                    const f32x4 p0 = *(const f32x4*)pp, p1 = *(const f32x4*)(pp + 4);
                    o.x = cvtpk(bf2f((bf16_t)(kv.x & 0xffff)) + p0.x, bf2f((bf16_t)(kv.x >> 16)) + p0.y);
                    o.y = cvtpk(bf2f((bf16_t)(kv.y & 0xffff)) + p0.z, bf2f((bf16_t)(kv.y >> 16)) + p0.w);
                    o.z = cvtpk(bf2f((bf16_t)(kv.z & 0xffff)) + p1.x, bf2f((bf16_t)(kv.z >> 16)) + p1.y);
                    o.w = cvtpk(bf2f((bf16_t)(kv.w & 0xffff)) + p1.z, bf2f((bf16_t)(kv.w >> 16)) + p1.w);
                }
                *(u32x4*)(BIG + (size_t)row * 2048 + c8 * 8) = o;
            }
        } else if (kind == 2 && sub == 4) {
            int tid = tid_; asm volatile("" : "+v"(tid)); const int lane = tid & 63; (void)lane;
            for (int rg = gw; rg < 16384 / 8; rg += NGW) {
                const int row0 = rg * 8, s = row0 >> 13;
                const float* w2 = PIN(19) + (size_t)s * 256 * 64 + lane;
                float acc[8];
#pragma unroll
                for (int i = 0; i < 8; ++i) acc[i] = 0.f;
                for (int h = 0; h < 256; h += 2) {
                    const float wa = w2[(size_t)h * 64], wb = w2[(size_t)(h + 1) * 64];
#pragma unroll
                    for (int i = 0; i < 8; ++i) { const unsigned hv = *(const unsigned*)(HID + (size_t)(row0 + i) * 256 + h);
                        acc[i] += bf2f((bf16_t)(hv & 0xffff)) * wa + bf2f((bf16_t)(hv >> 16)) * wb; }
                }
#pragma unroll
                for (int i = 0; i < 8; ++i) CMP[(size_t)(row0 + i) * 64 + lane] = (bf16_t)f2bf(acc[i]);
            }
        } else {
            pg8::Gemm g; pg8::Sched S;
            bool resid = false; pg8::EpiStore ES{nullptr, 0, 0, 0, 0, 0}; pg8::EpiResid ER{nullptr, nullptr, nullptr, 0};
            if (kind == 2 && sub == 1) { g = pg8::Gemm{XN, (const bf16_t*)(ws + WS_WKV), M, NKV, D}; S.init(M, NKV, G, c, 0); ES = pg8::EpiStore{KVB, NKV, 0, 0, 0, 2}; }
            else if (kind == 2) { g = pg8::Gemm{BIG, (const bf16_t*)(ws + WS_WC1), 16384, 512, 2048}; S.init(16384, 512, G, c, 1); ES = pg8::EpiStore{HID, 256, 2, 1, 0, 0}; }
            else if (sub == 1) {
                if (layer < 2) { g = pg8::Gemm{XN, (const bf16_t*)(ws + WS_WQKV) + (size_t)layer * NQKV * D, M, NQKV, D}; S.init(M, NQKV, G, c, 0); ES = pg8::EpiStore{BIG, 1024, 0, 0, 1024, 1}; }
                else { g = pg8::Gemm{XN, (const bf16_t*)(ws + WS_WBIN) + (size_t)(layer - 2) * NBINP * D, M, NBINP, D}; S.init(M, NBINP, G, c, 0); ES = pg8::EpiStore{BIG, NBINP, 0, 0, 1024, 0}; }
            } else if (sub == 3) {
                const bf16_t* W = layer < 2 ? (const bf16_t*)(ws + WS_WAO) + (size_t)layer * D * D : (const bf16_t*)(ws + WS_WBO) + (size_t)(layer - 2) * D * D;
                g = pg8::Gemm{XN, W, M, D, D}; S.init(M, D, G, c, 0); resid = true;
                ER = pg8::EpiResid{layer == 0 ? x_in : xres, xres, mod + (size_t)layer * 8 * 6144 + 2048, 0};
            } else if (sub == 5 || sub == 7) {
                const int half = (sub - 5) / 2;
                g = pg8::Gemm{XN + (size_t)half * 16384 * D, (const bf16_t*)(ws + WS_W1) + (size_t)layer * D * FF, 16384, FF, D}; S.init(16384, FF, G, c, 0); ES = pg8::EpiStore{BIG, FF, 1, 0, 0, 0};
            } else {
                const int half = (sub - 6) / 2;
                g = pg8::Gemm{BIG, (const bf16_t*)(ws + WS_W2) + (size_t)layer * D * FF, 16384, D, FF}; S.init(16384, D, G, c, 0); resid = true;
                ER = pg8::EpiResid{xres, xres, mod + (size_t)layer * 8 * 6144 + 5120, half * 16384};
            }
#ifndef NO_GEMM
            if (resid) pg8::gemm_phase<pg8::EpiResid, pg8::Sched, true, true>(lds, g, S, ER);
            else pg8::gemm_phase<pg8::EpiStore, pg8::Sched, true, true>(lds, g, S, ES);
#endif
        }
        if (step + 1 < p.step_hi) {
#if USE_XCD_BAR
            if (step == p.step_lo) cg::this_grid().sync();
            else { XcdBarrier xb; xb.bar = (unsigned*)(ws + WS_BAR); xb.x = xb_xcc_id(); xb.st = (volatile LAS unsigned*)(lds + LDS_BARST); xcd_barrier(xb); }
#else
            cg::this_grid().sync();
#endif
        }
    }
}

extern "C" void kernel_launch(void* const* d_in, const int* in_sizes, int n_in, void* d_out, int out_size, void* d_ws, size_t ws_size, hipStream_t stream) {
    static int grid = 0;
    if (grid == 0) {
        if (n_in != 23 || out_size != M * D || ws_size < WS_END) { fprintf(stderr, "kernel_launch: unexpected shapes (n_in %d out %d ws %zu)\n", n_in, out_size, ws_size); grid = -1; return; }
        int dev = 0, cus = 0, per_cu = 0;
        hipGetDevice(&dev);
        hipDeviceGetAttribute(&cus, hipDeviceAttributeMultiprocessorCount, dev);
        hipFuncSetAttribute((const void*)mk_fwd, hipFuncAttributeMaxDynamicSharedMemorySize, LDS_BYTES);
        if (hipOccupancyMaxActiveBlocksPerMultiprocessor(&per_cu, (const void*)mk_fwd, 512, LDS_BYTES) != hipSuccess || per_cu < 1) { fprintf(stderr, "kernel_launch: occupancy query says %d\n", per_cu); per_cu = 1; }
        (void)hipGetLastError();
        grid = cus;
    }
    if (grid < 0) return;
    hipMemsetAsync((char*)d_ws + WS_BAR, 0, 16384, stream);
    Params p{};
    for (int i = 0; i < 23; ++i) p.in[i] = (const float*)d_in[i];
    p.out = (float*)d_out; p.ws = (unsigned char*)d_ws; p.step_lo = 0; p.step_hi = 43 + NDUP;
    void* args[] = {&p};
    hipError_t e = hipLaunchCooperativeKernel((const void*)mk_fwd, dim3(grid), dim3(512), args, LDS_BYTES, stream);
    if (e != hipSuccess) fprintf(stderr, "cooperative launch failed: %s (grid %d)\n", hipGetErrorString(e), grid);
}
```

```cpp
#include <hip/hip_runtime.h>
#include <hip/hip_cooperative_groups.h>
#include <cstdio>
#include <cstdint>
namespace cg = cooperative_groups;

#ifndef NDUP
#define NDUP 0
#endif
#ifndef USE_XCD_BAR
#define USE_XCD_BAR 1
#endif

#define LAS __attribute__((address_space(3)))
typedef unsigned short bf16_t;
typedef short bf16x8 __attribute__((ext_vector_type(8)));
typedef short s16x4 __attribute__((ext_vector_type(4)));
typedef float f32x4 __attribute__((ext_vector_type(4)));
typedef float f32x16 __attribute__((ext_vector_type(16)));
typedef unsigned u32x4 __attribute__((ext_vector_type(4)));
typedef unsigned u32x2 __attribute__((ext_vector_type(2)));
typedef float f32x2_t __attribute__((ext_vector_type(2)));
typedef __bf16 bf16x2_t __attribute__((ext_vector_type(2)));

__device__ __forceinline__ unsigned cvtpk(float lo, float hi) { f32x2_t v = {lo, hi}; bf16x2_t b = __builtin_convertvector(v, bf16x2_t); return __builtin_bit_cast(unsigned, b); }
__device__ __forceinline__ float bf2f(bf16_t v) { return __builtin_bit_cast(float, (unsigned)v << 16); }

constexpr int BATCH = 8, T = 4096, D = 1024, M = BATCH * T, FF = 4096;
constexpr int NQKV = 3072, NKV = 1536, NBIN = 1072, NBINP = 1280;
constexpr float NORM_EPS = 1e-6f;
constexpr float LOG2E = 1.4426950408889634f;
constexpr float SC2 = 0.125f * LOG2E;

constexpr size_t MiB = 1u << 20;
constexpr size_t WS_MOD = 0;
constexpr size_t WS_KVMOD = 4 * 8 * 6144 * 4;
constexpr size_t WS_BAR = 1 * MiB;
constexpr size_t WS_WQKV = 2 * MiB;
constexpr size_t WS_WAO = 14 * MiB;
constexpr size_t WS_W1 = 18 * MiB;
constexpr size_t WS_W2 = 50 * MiB;
constexpr size_t WS_WKV = 82 * MiB;
constexpr size_t WS_WBIN = 85 * MiB;
constexpr size_t WS_WBO = 90 * MiB;
constexpr size_t WS_WC1 = 94 * MiB;
constexpr size_t WS_XN = 96 * MiB;
constexpr size_t WS_BIG = 160 * MiB;
constexpr size_t WS_HID = 224 * MiB;
constexpr size_t WS_KV = 352 * MiB;
constexpr size_t WS_CMP = 448 * MiB;
constexpr size_t WS_O1 = 450 * MiB;
constexpr size_t WS_END = 482 * MiB;

namespace pg8 {
#define PG8_LAS __attribute__((address_space(3)))
constexpr int BM = 256, BK = 64, HALF = 128, HTB = HALF * BK * 2, STAGE_BYTES = 8 * HTB, NXCD = 8, WGM = 8;
__host__ __device__ __forceinline__ int lds_byte(int r, int c) { const int st = (r >> 4) * 2 + (c >> 5), rr = r & 15, cc = c & 31, ob = rr * 64 + cc * 2; return st * 1024 + (ob ^ (((ob >> 9) & 1) << 5)); }
__host__ __device__ __forceinline__ void stage_rc(int b, int& R, int& C) { const int st = b / 1024, sb = b % 1024, swz = sb ^ (((sb >> 9) & 1) << 5); R = (st >> 1) * 16 + swz / 64; C = (st & 1) * 32 + (swz % 64) / 2; }
__host__ __device__ __forceinline__ int perm32(int rho) { const int n = rho >> 4, i = rho & 15; return 8 * (i >> 2) + 4 * n + (i & 3); }

struct Unit { int pm, pn; };
struct Gemm { const bf16_t* A; const bf16_t* Bt; int M, N, K; };

struct Sched {
    int nM, nN, nwg, G, c, mode;
    __device__ void init(int M_, int N_, int G_, int c_, int mode_) { nM = M_ / BM; nN = N_ / BM; nwg = mode_ ? nM : nM * nN; G = G_; c = c_; mode = mode_; }
    __device__ bool next(int i, Unit& u) const {
        const long L = (long)i * G + c; if (L >= nwg) return false;
        if (mode == 1) { u.pm = (int)L; u.pn = (int)L >> 5; return true; }
        int wgid = (int)L; { const int q = nwg / NXCD, r = nwg % NXCD, xcd = wgid % NXCD, off = wgid / NXCD; wgid = (xcd < r ? xcd * (q + 1) : r * (q + 1) + (xcd - r) * q) + off; }
        const int nig = WGM * nN, gid = wgid / nig, fm = gid * WGM, gsz = (nM - fm) < WGM ? (nM - fm) : WGM;
        u.pm = fm + ((wgid % nig) % gsz); u.pn = (wgid % nig) / gsz; return true;
    }
    __device__ __forceinline__ void a_ready(const Unit&) const {}
    __device__ __forceinline__ void done(const Unit&) const {}
};

__device__ __forceinline__ float act_fn(float v, int act) {
    if (act == 1) { const float r = fmaxf(v, 0.f); return r * r; }
    if (act == 2) { const float u = 0.7978845608028654f * (v + 0.044715f * v * v * v); return v * __builtin_amdgcn_rcpf(1.f + __expf(-2.f * u)); }
    return v;
}
struct EpiStore {
    static constexpr bool PERM = true, AFTER_DRAIN = false;
    bf16_t* O; int ldc; int act; int fold; int qcols; int mode;
    __device__ __forceinline__ void operator()(const f32x4 (&acc)[2][2][4][2], const Unit& u, int wr, int wc, int fr, int fq) const {
        const int row0 = u.pm * BM + wr * 64 + fr; const int colt = fold ? 0 : u.pn * BM; const int cw = wc * 32 + 8 * fq;
        const float qs = (u.pn * BM < qcols) ? 0.18033688011112042f : 1.0f;
        const int b = (u.pm * BM) / T, t0 = (u.pm * BM) % T + wr * 64 + fr;
        size_t base[2]; size_t rstride;
        if (mode == 1 && colt >= 1024) {
            if (colt < 2048) { rstride = 64;
#pragma unroll
                for (int bj = 0; bj < 2; ++bj) { const int hd = (colt - 1024) / 128 + bj; base[bj] = (size_t)M * 1024 + ((size_t)((b * 8 + hd) * 2 + (cw >> 6)) * T + t0) * 64 + (cw & 63); } }
            else { rstride = 128;
#pragma unroll
                for (int bj = 0; bj < 2; ++bj) { const int hd = (colt - 2048) / 128 + bj; base[bj] = (size_t)2 * M * 1024 + ((size_t)(b * 8 + hd) * T + t0) * 128 + cw; } }
        } else if (mode == 2) { rstride = 64;
#pragma unroll
            for (int bj = 0; bj < 2; ++bj) { const int c2 = bj * 128 + cw; base[bj] = ((size_t)((u.pn * 8 + b) * 4 + (c2 >> 6)) * T + t0) * 64 + (c2 & 63); }
        } else { rstride = (size_t)ldc;
#pragma unroll
            for (int bj = 0; bj < 2; ++bj) base[bj] = (size_t)row0 * ldc + colt + cw + bj * HALF;
        }
#pragma unroll
        for (int ai = 0; ai < 2; ++ai)
#pragma unroll
            for (int m = 0; m < 4; ++m) { const size_t ro = (size_t)(ai * HALF + m * 16) * rstride;
#pragma unroll
                for (int bj = 0; bj < 2; ++bj) { f32x4 v0 = acc[ai][bj][m][0], v1 = acc[ai][bj][m][1];
                    if (act) {
#pragma unroll
                        for (int e = 0; e < 4; ++e) { v0[e] = act_fn(v0[e], act); v1[e] = act_fn(v1[e], act); } }
                    v0 = v0 * qs; v1 = v1 * qs;
                    u32x4 w; w.x = cvtpk(v0[0], v0[1]); w.y = cvtpk(v0[2], v0[3]); w.z = cvtpk(v1[0], v1[1]); w.w = cvtpk(v1[2], v1[3]);
                    *(u32x4*)(O + base[bj] + ro) = w; } }
    }
};
struct EpiResid {
    static constexpr bool PERM = false, AFTER_DRAIN = false;
    const float* base; float* out; const float* gate; int row_off;
    __device__ __forceinline__ void operator()(const f32x4 (&acc)[2][2][4][2], const Unit& u, int wr, int wc, int fr, int fq) const {
        const int rt = row_off + u.pm * BM; const int b = rt / T; const int row0 = rt + wr * 64 + fr; const int col0 = u.pn * BM + wc * 32 + 4 * fq;
        f32x4 gv[2][2];
#pragma unroll
        for (int bj = 0; bj < 2; ++bj)
#pragma unroll
            for (int n = 0; n < 2; ++n) gv[bj][n] = *(const f32x4*)(gate + (size_t)b * 6144 + col0 + bj * HALF + n * 16);
#pragma unroll
        for (int aim = 0; aim < 4; ++aim) { const int ai = aim >> 1, m0 = (aim & 1) * 2;
            f32x4 xin[2][2][2];
#pragma unroll
            for (int mm = 0; mm < 2; ++mm) { const size_t off = (size_t)(row0 + ai * HALF + (m0 + mm) * 16) * D + col0;
#pragma unroll
                for (int bj = 0; bj < 2; ++bj)
#pragma unroll
                    for (int n = 0; n < 2; ++n) xin[mm][bj][n] = *(const f32x4*)(base + off + bj * HALF + n * 16); }
            asm volatile("" ::: "memory");
#pragma unroll
            for (int mm = 0; mm < 2; ++mm) { const int m = m0 + mm; const size_t off = (size_t)(row0 + ai * HALF + m * 16) * D + col0;
#pragma unroll
                for (int bj = 0; bj < 2; ++bj)
#pragma unroll
                    for (int n = 0; n < 2; ++n) *(f32x4*)(out + off + bj * HALF + n * 16) = xin[mm][bj][n] + gv[bj][n] * acc[ai][bj][m][n]; }
            asm volatile("" ::: "memory");
        }
    }
};

template <class Epi, class SchedT, bool ALIGN_EPI = false, bool SP2 = false>
__device__ __forceinline__ void gemm_phase(PG8_LAS unsigned char* lds, const Gemm g, const SchedT& S, const Epi& E) {
    int tid_ = threadIdx.x; asm volatile("" : "+v"(tid_));
    const int tid = tid_, wid = __builtin_amdgcn_readfirstlane(tid >> 6), lane = tid & 63, wr = wid >> 2, wc = wid & 3, fr = lane & 15, fq = lane >> 4;
    const int K = g.K, nt = K / BK;
    unsigned voffA[2], voffB[2];
#pragma unroll
    for (int i = 0; i < 2; ++i) { int R, C; stage_rc(tid * 16 + i * 8192, R, C); const int Rb = Epi::PERM ? ((R & ~31) + perm32(R & 31)) : R;
        voffA[i] = (unsigned)(R * K + C) * 2u; voffB[i] = (unsigned)(Rb * K + C) * 2u; }
    const size_t kstep = (size_t)(BK * 2);
    const size_t hstep = (size_t)HALF * K * 2;
    const size_t tstep = 2 * hstep;
    const unsigned ldsw = (unsigned)wid * 1024u;
    const int aoff = lds_byte(wr * 64 + fr, fq * 8), boff = lds_byte(wc * 32 + fr, fq * 8);
#define PG8_SA(b, h) (((b) * 2 + (h)) * HTB)
#define PG8_SB(b, h) ((4 + (b) * 2 + (h)) * HTB)
#define PG8_STAGE(bufoff, gbase, voff) do { _Pragma("unroll") for (int _i = 0; _i < 2; ++_i) \
        __builtin_amdgcn_global_load_lds((const unsigned*)((const char*)(gbase) + (voff)[_i]), (PG8_LAS unsigned*)(lds + (bufoff) + ldsw + _i * 8192), 16, 0, 0); } while (0)
#define PG8_LDA(dst, b, h) do { _Pragma("unroll") for (int m = 0; m < 4; ++m) _Pragma("unroll") for (int k = 0; k < 2; ++k) dst[m][k] = *(const PG8_LAS bf16x8*)(lds + PG8_SA(b, h) + aoff + m * 2048 + k * 1024); } while (0)
#define PG8_LDB(dst, b, h) do { _Pragma("unroll") for (int n = 0; n < 2; ++n) _Pragma("unroll") for (int k = 0; k < 2; ++k) dst[n][k] = *(const PG8_LAS bf16x8*)(lds + PG8_SB(b, h) + boff + n * 2048 + k * 1024); } while (0)
#define PG8_MMA(ai, bj, At, Bt) do { __builtin_amdgcn_s_setprio(1); _Pragma("unroll") for (int m = 0; m < 4; ++m) _Pragma("unroll") for (int n = 0; n < 2; ++n) _Pragma("unroll") for (int k = 0; k < 2; ++k) \
        acc[ai][bj][m][n] = __builtin_amdgcn_mfma_f32_16x16x32_bf16(Bt[n][k], At[m][k], acc[ai][bj][m][n], 0, 0, 0); __builtin_amdgcn_s_setprio(0); } while (0)
#define PG8_WAIT_V(n) asm volatile("s_waitcnt vmcnt(" #n ")" ::: "memory")
#define PG8_WAIT_L(n) asm volatile("s_waitcnt lgkmcnt(" #n ")" ::: "memory")
#define PG8_BAR __builtin_amdgcn_s_barrier()
#define PG8_SCHED __builtin_amdgcn_sched_barrier(0)
    Unit cur, nxt; int ui = 0;
    if (!S.next(0, cur)) return;
    f32x4 acc[2][2][4][2];
#pragma unroll
    for (int a = 0; a < 2; ++a)
#pragma unroll
        for (int b = 0; b < 2; ++b)
#pragma unroll
            for (int m = 0; m < 4; ++m)
#pragma unroll
                for (int n = 0; n < 2; ++n) acc[a][b][m][n] = (f32x4){0.f, 0.f, 0.f, 0.f};
    bf16x8 At[4][2], B0[2][2], B1[2][2];
    const char* cA = (const char*)g.A + (size_t)cur.pm * tstep; const char* cB = (const char*)g.Bt + (size_t)cur.pn * tstep;
    S.a_ready(cur);
    if constexpr (SP2) {
        PG8_STAGE(PG8_SB(0, 0), cB, voffB); PG8_STAGE(PG8_SB(0, 1), cB + hstep, voffB); PG8_STAGE(PG8_SA(0, 0), cA, voffA); PG8_STAGE(PG8_SA(0, 1), cA + hstep, voffA);
        if (wr == 1) PG8_BAR;
        PG8_WAIT_V(2); PG8_BAR;
        PG8_STAGE(PG8_SB(1, 0), cB + kstep, voffB); PG8_STAGE(PG8_SA(1, 0), cA + kstep, voffA); PG8_STAGE(PG8_SB(1, 1), cB + hstep + kstep, voffB);
        PG8_WAIT_V(6); PG8_BAR;
    } else {
        PG8_STAGE(PG8_SB(0, 0), cB, voffB); PG8_STAGE(PG8_SA(0, 0), cA, voffA); PG8_STAGE(PG8_SB(0, 1), cB + hstep, voffB); PG8_STAGE(PG8_SA(0, 1), cA + hstep, voffA);
        if (wr == 1) PG8_BAR;
        PG8_WAIT_V(4); PG8_BAR;
        PG8_STAGE(PG8_SB(1, 0), cB + kstep, voffB); PG8_STAGE(PG8_SA(1, 0), cA + kstep, voffA); PG8_STAGE(PG8_SB(1, 1), cB + hstep + kstep, voffB);
        PG8_WAIT_V(6); PG8_BAR;
    }
    for (;;) {
        const bool has_next = S.next(ui + 1, nxt);
        const char* nA = has_next ? (const char*)g.A + (size_t)nxt.pm * tstep : cA; const char* nB = has_next ? (const char*)g.Bt + (size_t)nxt.pn * tstep : cB;
        for (int t = 0; t < nt; t += 2) {
            const bool last = (t == nt - 2);
            const char* a1 = cA + (size_t)(t + 1) * kstep;
            const char* a2 = last ? nA : cA + (size_t)(t + 2) * kstep; const char* b2 = last ? nB : cB + (size_t)(t + 2) * kstep;
            const char* a3 = a2 + kstep; const char* b3 = b2 + kstep;
            if (last && has_next) S.a_ready(nxt);
            if constexpr (SP2) {
            PG8_LDB(B0, 0, 0); PG8_LDB(B1, 0, 1); PG8_SCHED; PG8_LDA(At, 0, 0); PG8_STAGE(PG8_SA(1, 1), a1 + hstep, voffA);
            PG8_WAIT_V(8); PG8_WAIT_L(0); PG8_BAR; PG8_MMA(0, 0, At, B0); PG8_MMA(0, 1, At, B1); PG8_BAR; PG8_SCHED;
            PG8_LDA(At, 0, 1); PG8_STAGE(PG8_SB(0, 0), b2, voffB); PG8_STAGE(PG8_SB(0, 1), b2 + hstep, voffB); PG8_STAGE(PG8_SA(0, 0), a2, voffA);
            PG8_WAIT_V(8); PG8_WAIT_L(0); PG8_BAR; PG8_MMA(1, 0, At, B0); PG8_MMA(1, 1, At, B1); PG8_BAR; PG8_SCHED;
            PG8_LDB(B0, 1, 0); PG8_LDB(B1, 1, 1); PG8_SCHED; PG8_LDA(At, 1, 0); PG8_STAGE(PG8_SA(0, 1), a2 + hstep, voffA);
            PG8_WAIT_V(8); PG8_WAIT_L(0); PG8_BAR; PG8_MMA(0, 0, At, B0); PG8_MMA(0, 1, At, B1); PG8_BAR; PG8_SCHED;
            PG8_LDA(At, 1, 1); PG8_STAGE(PG8_SB(1, 0), b3, voffB); PG8_STAGE(PG8_SB(1, 1), b3 + hstep, voffB); PG8_STAGE(PG8_SA(1, 0), a3, voffA);
            PG8_WAIT_V(8); PG8_WAIT_L(0); PG8_BAR; PG8_MMA(1, 0, At, B0); PG8_MMA(1, 1, At, B1); PG8_BAR; PG8_SCHED;
            } else {
            PG8_LDB(B0, 0, 0); PG8_SCHED; PG8_LDA(At, 0, 0); PG8_STAGE(PG8_SA(1, 1), a1 + hstep, voffA);
            PG8_WAIT_L(8); PG8_BAR; PG8_WAIT_L(0); PG8_MMA(0, 0, At, B0); PG8_BAR; PG8_SCHED;
            PG8_LDB(B1, 0, 1); PG8_STAGE(PG8_SB(0, 0), b2, voffB);
            PG8_BAR; PG8_WAIT_L(0); PG8_MMA(0, 1, At, B1); PG8_BAR;
            PG8_LDA(At, 0, 1); PG8_STAGE(PG8_SA(0, 0), a2, voffA);
            PG8_BAR; PG8_WAIT_L(0); PG8_MMA(1, 0, At, B0); PG8_BAR; PG8_SCHED;
            PG8_STAGE(PG8_SB(0, 1), b2 + hstep, voffB);
            PG8_WAIT_V(6); PG8_BAR; PG8_MMA(1, 1, At, B1); PG8_BAR;
            PG8_LDB(B0, 1, 0); PG8_SCHED; PG8_LDA(At, 1, 0); PG8_STAGE(PG8_SA(0, 1), a2 + hstep, voffA);
            PG8_WAIT_L(8); PG8_BAR; PG8_WAIT_L(0); PG8_MMA(0, 0, At, B0); PG8_BAR; PG8_SCHED;
            PG8_LDB(B1, 1, 1); PG8_STAGE(PG8_SB(1, 0), b3, voffB);
            PG8_BAR; PG8_WAIT_L(0); PG8_MMA(0, 1, At, B1); PG8_BAR;
            PG8_LDA(At, 1, 1); PG8_STAGE(PG8_SA(1, 0), a3, voffA);
            PG8_BAR; PG8_WAIT_L(0); PG8_MMA(1, 0, At, B0); PG8_BAR; PG8_SCHED;
            PG8_STAGE(PG8_SB(1, 1), b3 + hstep, voffB);
            PG8_WAIT_V(6); PG8_BAR; PG8_MMA(1, 1, At, B1); PG8_BAR;
            }
        }
        if constexpr (ALIGN_EPI) { if (wr == 0) PG8_BAR; }
        if constexpr (!Epi::AFTER_DRAIN) { E(acc, cur, wr, wc, fr, fq); S.done(cur); }
        if (!has_next) break;
#pragma unroll
        for (int a = 0; a < 2; ++a)
#pragma unroll
            for (int b = 0; b < 2; ++b)
#pragma unroll
                for (int m = 0; m < 4; ++m)
#pragma unroll
                    for (int n = 0; n < 2; ++n) acc[a][b][m][n] = (f32x4){0.f, 0.f, 0.f, 0.f};
        cur = nxt; cA = nA; cB = nB; ++ui;
        if constexpr (ALIGN_EPI) { if (wr == 1) PG8_BAR; }
    }
    PG8_WAIT_V(0);
    if constexpr (!ALIGN_EPI) { if (wr == 0) PG8_BAR; }
    PG8_BAR;
#undef PG8_SA
#undef PG8_SB
#undef PG8_STAGE
#undef PG8_LDA
#undef PG8_LDB
#undef PG8_MMA
#undef PG8_WAIT_V
#undef PG8_WAIT_L
#undef PG8_BAR
#undef PG8_SCHED
}
}

__device__ __forceinline__ float wave_sum(float v, int lane) {
#pragma unroll
    for (int o = 1; o < 64; o <<= 1) v += __builtin_bit_cast(float, __builtin_amdgcn_ds_bpermute((lane ^ o) << 2, __builtin_bit_cast(int, v)));
    return v;
}
__device__ __forceinline__ int t5_bucket(int n) { if (n < 16) return n; const int v = 16 + (int)(__log2f((float)n * 0.0625f) * (16.0f / 3.0f)); return v > 31 ? 31 : v; }
__device__ __forceinline__ unsigned f2bf(float f) { unsigned u = __builtin_bit_cast(unsigned, f); return (u + 0x7fffu + ((u >> 16) & 1u)) >> 16; }
__device__ __forceinline__ unsigned pk2(float lo, float hi) { return f2bf(lo) | (f2bf(hi) << 16); }

__device__ __forceinline__ void transpose_item(const float* W, int K, int Nsrc, bf16_t* WT, LAS float* scr, int item, int lane) {
    const int nblk = (Nsrc + 31) / 32, kb = item / nblk, nb = item % nblk, k0 = 64 * kb, n0 = 32 * nb;
    const int ncol = n0 + (lane & 31); const bool okc = ncol < Nsrc;
    float tv[32];
#pragma unroll
    for (int i = 0; i < 32; ++i) { const int kk = 2 * i + (lane >> 5); tv[i] = okc ? W[(size_t)(k0 + kk) * Nsrc + ncol] : 0.f; }
#pragma unroll
    for (int i = 0; i < 32; ++i) { const int kk = 2 * i + (lane >> 5); scr[kk * 33 + (lane & 31)] = tv[i]; }
    asm volatile("s_waitcnt lgkmcnt(0)" ::: "memory");
    const int c = lane & 7;
#pragma unroll
    for (int j = 0; j < 4; ++j) { const int n = (lane >> 3) + 8 * j; const LAS float* s = scr + (8 * c) * 33 + n;
        u32x4 o; o.x = pk2(s[0 * 33], s[1 * 33]); o.y = pk2(s[2 * 33], s[3 * 33]); o.z = pk2(s[4 * 33], s[5 * 33]); o.w = pk2(s[6 * 33], s[7 * 33]);
        *(u32x4*)(WT + (size_t)(n0 + n) * K + k0 + 8 * c) = o; }
    asm volatile("s_waitcnt lgkmcnt(0)" ::: "memory");
}

struct Params {
    const float* in[23];
    float* out;
    unsigned char* ws;
    int step_lo, step_hi;
};

constexpr int KP = 144;
constexpr int VP128 = 320, VP64 = 192;
constexpr int ATT_K0 = 0, ATT_V0 = 64 * KP, ATT_STAGE_DIFF = 64 * KP + 64 * VP128;
constexpr int ATT_STAGE_NSA = 64 * KP + 64 * VP64;
#define ATT_BT (4 * ATT_ST)
#define ATT_SEL (ATT_BT + 2048)
#define ATT_UM (ATT_SEL + 512)
#define ATT_IMP (ATT_UM + 64)
constexpr int LDS_BYTES = 139264;
constexpr int LDS_BARST = 139264 - 64;
static_assert(4 * 24576 + 2624 + 32768 <= LDS_BARST && 4 * 16384 + 2624 + 4 * 64 * 65 * 4 <= LDS_BARST && 2 * ATT_STAGE_NSA <= 4 * 16384, "attention LDS map");

__device__ __forceinline__ s16x4 vtr(LAS const char* p) { typedef short v4i16_t __attribute__((ext_vector_type(4))); return __builtin_bit_cast(s16x4, __builtin_amdgcn_ds_read_tr16_b64_v4i16((LAS v4i16_t*)p)); }

__device__ __forceinline__ float pair_max(float v) { float a = v, b = v; asm volatile("s_nop 1\n\tv_permlane32_swap_b32 %0, %1" : "+v"(a), "+v"(b)); return fmaxf(a, b); }
__device__ __forceinline__ float pair_sum(float v) { float a = v, b = v; asm volatile("s_nop 1\n\tv_permlane32_swap_b32 %0, %1" : "+v"(a), "+v"(b)); return a + b; }
__device__ __forceinline__ void qk_tile(f32x16& s0, f32x16& s1, const bf16x8 (&qf)[4], LAS const char* Kb, int lane) {
    LAS const char* kp = Kb + (lane & 31) * KP + (lane >> 5) * 16;
    f32x16 a = {}, b = {};
#pragma unroll
    for (int kk = 0; kk < 4; ++kk) {
        const bf16x8 k0 = *(LAS const bf16x8*)(kp + kk * 32);
        const bf16x8 k1 = *(LAS const bf16x8*)(kp + 32 * KP + kk * 32);
        a = __builtin_amdgcn_mfma_f32_32x32x16_bf16(k0, qf[kk], a, 0, 0, 0);
        b = __builtin_amdgcn_mfma_f32_32x32x16_bf16(k1, qf[kk], b, 0, 0, 0);
    }
    s0 = a; s1 = b;
}
__device__ __forceinline__ void qk_tile_lq(f32x16& s0, f32x16& s1, LAS const char* Qs, LAS const char* Kb, int lane) {
    LAS const char* kp = Kb + (lane & 31) * KP + (lane >> 5) * 16;
    f32x16 a = {}, b = {};
#pragma unroll
    for (int kk = 0; kk < 4; ++kk) {
        const bf16x8 q = *(LAS const bf16x8*)(Qs + kk * 1024 + lane * 16);
        const bf16x8 k0 = *(LAS const bf16x8*)(kp + kk * 32);
        const bf16x8 k1 = *(LAS const bf16x8*)(kp + 32 * KP + kk * 32);
        a = __builtin_amdgcn_mfma_f32_32x32x16_bf16(k0, q, a, 0, 0, 0);
        b = __builtin_amdgcn_mfma_f32_32x32x16_bf16(k1, q, b, 0, 0, 0);
    }
    s0 = a; s1 = b;
}
template <int DVB, int VP>
__device__ __forceinline__ void pv_tile(f32x16 (&o)[DVB], const bf16x8 (&P)[4], LAS const char* Vb, int lane) {
    const int i = lane & 15, gidx = lane >> 4, hh = gidx >> 1, dvh = gidx & 1;
    LAS const char* vp = Vb + (hh * 4 + (i >> 2)) * VP + (16 * dvh + 4 * (i & 3)) * 2;
    s16x4 lo[DVB], hi[DVB];
#pragma unroll
    for (int c = 0; c < DVB; ++c) { lo[c] = vtr(vp + c * 64); hi[c] = vtr(vp + 8 * VP + c * 64); }
#pragma unroll
    for (int ks = 0; ks < 4; ++ks) {
        s16x4 nlo[DVB], nhi[DVB];
        if (ks < 3) {
#pragma unroll
            for (int c = 0; c < DVB; ++c) { nlo[c] = vtr(vp + (16 * (ks + 1)) * VP + c * 64); nhi[c] = vtr(vp + (16 * (ks + 1) + 8) * VP + c * 64); }
        }
#pragma unroll
        for (int c = 0; c < DVB; ++c) {
            const bf16x8 a = (bf16x8){lo[c][0], lo[c][1], lo[c][2], lo[c][3], hi[c][0], hi[c][1], hi[c][2], hi[c][3]};
            o[c] = __builtin_amdgcn_mfma_f32_32x32x16_bf16(a, P[ks], o[c], 0, 0, 0);
        }
        __builtin_amdgcn_sched_barrier(0);
        if (ks < 3) {
#pragma unroll
            for (int c = 0; c < DVB; ++c) { lo[c] = nlo[c]; hi[c] = nhi[c]; }
        }
    }
}
template <bool BIAS>
__device__ __forceinline__ void score_elem(f32x16& s0, f32x16& s1, int base, int win, LAS const float* bt) {
#pragma unroll
    for (int i = 0; i < 16; ++i) {
        const int off = (i >> 2) * 8 + (i & 3);
        const int d0 = base - off, d1 = d0 - 32;
        float b0 = 0.f, b1 = 0.f;
        if (BIAS) { b0 = bt[min(max(d0, 0), 127)]; b1 = bt[min(max(d1, 0), 127)]; }
        s0[i] = ((unsigned)d0 < (unsigned)win) ? s0[i] + b0 : -INFINITY;
        s1[i] = ((unsigned)d1 < (unsigned)win) ? s1[i] + b1 : -INFINITY;
        if (BIAS && (i & 3) == 3) __builtin_amdgcn_sched_barrier(0);
    }
}
__device__ __forceinline__ float row_max32(const f32x16& s0, const f32x16& s1) {
    float a = fmaxf(s0[0], s1[0]);
#pragma unroll
    for (int i = 1; i < 16; ++i) a = fmaxf(a, fmaxf(s0[i], s1[i]));
    return pair_max(a);
}
template <int DVB>
__device__ __forceinline__ void softmax_step(f32x16& s0, f32x16& s1, float& m, float& l, f32x16 (&o)[DVB], bf16x8 (&P)[4], bool sel) {
    float mx = row_max32(s0, s1); mx = sel ? mx : -INFINITY;
    const float mn = fmaxf(m, mx);
    {
        const float a = __builtin_amdgcn_exp2f(m - mn); l *= a;
#pragma unroll
        for (int c = 0; c < DVB; ++c) o[c] *= a;
        m = mn;
    }
    const float ms = sel ? m : INFINITY;
    float sum = 0.f;
#pragma unroll
    for (int i = 0; i < 16; ++i) { s0[i] = __builtin_amdgcn_exp2f(s0[i] - ms); s1[i] = __builtin_amdgcn_exp2f(s1[i] - ms); sum += s0[i] + s1[i]; }
    l += sum;
    u32x4 w0 = {cvtpk(s0[0], s0[1]), cvtpk(s0[2], s0[3]), cvtpk(s0[4], s0[5]), cvtpk(s0[6], s0[7])};
    u32x4 w1 = {cvtpk(s0[8], s0[9]), cvtpk(s0[10], s0[11]), cvtpk(s0[12], s0[13]), cvtpk(s0[14], s0[15])};
    u32x4 w2 = {cvtpk(s1[0], s1[1]), cvtpk(s1[2], s1[3]), cvtpk(s1[4], s1[5]), cvtpk(s1[6], s1[7])};
    u32x4 w3 = {cvtpk(s1[8], s1[9]), cvtpk(s1[10], s1[11]), cvtpk(s1[12], s1[13]), cvtpk(s1[14], s1[15])};
    P[0] = __builtin_bit_cast(bf16x8, w0); P[1] = __builtin_bit_cast(bf16x8, w1); P[2] = __builtin_bit_cast(bf16x8, w2); P[3] = __builtin_bit_cast(bf16x8, w3);
}

__device__ __forceinline__ void glds16(const void* gsrc, unsigned lds_dst) { unsigned keep;
    asm volatile("s_mov_b32 %0, m0\n\ts_mov_b32 m0, %2\n\ts_nop 0\n\tglobal_load_lds_dwordx4 %1, off\n\ts_mov_b32 m0, %0" : "=&s"(keep) : "v"(gsrc), "s"(lds_dst) : "memory"); }
template <int VW>
__device__ __forceinline__ void dma_tile(LAS char* stage, const bf16_t* Kg, const bf16_t* Vg, size_t pitchK, size_t pitchV, int k0, int lane, int wid) {
    const bf16_t* kb = Kg + (size_t)k0 * pitchK; const bf16_t* vb = Vg + (size_t)k0 * pitchV;
    const unsigned sb = (unsigned)__builtin_amdgcn_readfirstlane((int)(unsigned)(uintptr_t)stage);
    { const int r = 8 * wid + (lane >> 3), c = (lane & 7) ^ ((r >> 1) & 7);
      glds16(kb + (unsigned)(r * (unsigned)pitchK + c * 8), sb + wid * 1024); }
    if (VW == 2) {
#pragma unroll
        for (int h = 0; h < 2; ++h) { const int pc = 2 * wid + h, r = 4 * pc + (lane >> 4), c = (lane & 15) ^ ((r & 3) << 2);
            glds16(vb + (unsigned)(r * (unsigned)pitchV + c * 8), sb + 8192 + pc * 1024); }
    } else {
        const int r = 8 * wid + (lane >> 3), c = (lane & 7) ^ (((r >> 1) & 1) << 2);
        glds16(vb + (unsigned)(r * (unsigned)pitchV + c * 8), sb + 8192 + wid * 1024);
    }
}
template <bool QREG>
__device__ __forceinline__ void qk_tile_sw(f32x16& s0, f32x16& s1, const bf16x8* qf, LAS const char* Qs, LAS const char* Kb, int lane) {
    const int r = lane & 31, hh = lane >> 5, sw = (r >> 1) & 7;
    LAS const char* kp = Kb + r * 128 + ((hh ^ (sw & 1)) << 4); const int t = sw >> 1;
    f32x16 a = {}, b = {};
#pragma unroll
    for (int kk = 0; kk < 4; ++kk) {
        const bf16x8 q = QREG ? qf[kk] : *(LAS const bf16x8*)(Qs + kk * 1024 + lane * 16);
        const bf16x8 k0 = *(LAS const bf16x8*)(kp + ((kk ^ t) << 5));
        const bf16x8 k1 = *(LAS const bf16x8*)(kp + ((kk ^ t) << 5) + 32 * 128);
        a = __builtin_amdgcn_mfma_f32_32x32x16_bf16(k0, q, a, 0, 0, 0);
        b = __builtin_amdgcn_mfma_f32_32x32x16_bf16(k1, q, b, 0, 0, 0);
    }
    s0 = a; s1 = b;
}
template <int DVB, int ROWB>
__device__ __forceinline__ void pv_tile_sw(f32x16 (&o)[DVB], const bf16x8 (&P)[4], LAS const char* Vb, int lane) {
    const int i = lane & 15, gidx = lane >> 4, hh = gidx >> 1, dvh = gidx & 1;
    const int q = ROWB == 256 ? ((i >> 2) & 3) : ((i >> 3) & 1);
    LAS const char* vp = Vb + (4 * hh + (i >> 2)) * ROWB + dvh * 32 + ((i & 3) >> 1) * 16 + (i & 1) * 8;
    s16x4 lo[DVB], hi[DVB];
#pragma unroll
    for (int c = 0; c < DVB; ++c) { lo[c] = vtr(vp + ((c ^ q) << 6)); hi[c] = vtr(vp + ((c ^ q) << 6) + 8 * ROWB); }
#pragma unroll
    for (int ks = 0; ks < 4; ++ks) {
        s16x4 nlo[DVB], nhi[DVB];
        if (ks < 3) {
#pragma unroll
            for (int c = 0; c < DVB; ++c) { nlo[c] = vtr(vp + ((c ^ q) << 6) + (16 * (ks + 1)) * ROWB); nhi[c] = vtr(vp + ((c ^ q) << 6) + (16 * (ks + 1) + 8) * ROWB); }
        }
#pragma unroll
        for (int c = 0; c < DVB; ++c) {
            const bf16x8 a = (bf16x8){lo[c][0], lo[c][1], lo[c][2], lo[c][3], hi[c][0], hi[c][1], hi[c][2], hi[c][3]};
            o[c] = __builtin_amdgcn_mfma_f32_32x32x16_bf16(a, P[ks], o[c], 0, 0, 0);
        }
        __builtin_amdgcn_sched_barrier(0);
        if (ks < 3) {
#pragma unroll
            for (int c = 0; c < DVB; ++c) { lo[c] = nlo[c]; hi[c] = nhi[c]; }
        }
    }
}

template <int VW> struct TileRegs { u32x4 k; u32x4 v[VW]; };
template <int VW>
__device__ __forceinline__ void tile_issue(TileRegs<VW>& r, const bf16_t* Kg, const bf16_t* Vg, size_t pitchK, size_t pitchV, int k0, int tid) {
    const bf16_t* kb = Kg + (size_t)k0 * pitchK;
    const bf16_t* vb = Vg + (size_t)k0 * pitchV;
    r.k = *(const u32x4*)(kb + (unsigned)((tid >> 3) * (unsigned)pitchK + (tid & 7) * 8));
    if (VW == 2) {
#pragma unroll
        for (int i = 0; i < 2; ++i) { const int idx = tid + 512 * i; r.v[i] = *(const u32x4*)(vb + (unsigned)((idx >> 4) * (unsigned)pitchV + (idx & 15) * 8)); }
    } else r.v[0] = *(const u32x4*)(vb + (unsigned)((tid >> 3) * (unsigned)pitchV + (tid & 7) * 8));
}
template <int VW>
__device__ __forceinline__ void tile_commit(const TileRegs<VW>& r, LAS char* st, int tid) {
    *(LAS u32x4*)(st + ATT_K0 + (tid >> 3) * KP + (tid & 7) * 16) = r.k;
    if (VW == 2) {
#pragma unroll
        for (int i = 0; i < 2; ++i) { const int idx = tid + 512 * i; *(LAS u32x4*)(st + ATT_V0 + (idx >> 4) * VP128 + (idx & 15) * 16) = r.v[i]; }
    } else *(LAS u32x4*)(st + ATT_V0 + (tid >> 3) * VP64 + (tid & 7) * 16) = r.v[0];
}
#define TILE_LOOP_BEGIN(VW, UMASK, KG, VG, PK, PV) { \
    unsigned long long rem_ = (UMASK); int cur_ = __builtin_ctzll(rem_); rem_ &= rem_ - 1ull; int bufi_ = 0; \
    TileRegs<VW> tr_; tile_issue<VW>(tr_, KG, VG, PK, PV, cur_ * 64, tid); tile_commit<VW>(tr_, lds, tid); __syncthreads(); \
    for (;;) { const int nxt_ = rem_ ? __builtin_ctzll(rem_) : -1; if (rem_) rem_ &= rem_ - 1ull; \
        if (nxt_ >= 0) tile_issue<VW>(tr_, KG, VG, PK, PV, nxt_ * 64, tid); \
        { const int kt = cur_; LAS char* st = lds + bufi_ * ATT_STP;
#define TILE_LOOP_END(VW) } \
        if (nxt_ >= 0) tile_commit<VW>(tr_, lds + (bufi_ ^ 1) * ATT_STP, tid); \
        __syncthreads(); if (nxt_ < 0) break; cur_ = nxt_; bufi_ ^= 1; } }

#define PP_BAR() do { asm volatile("s_waitcnt lgkmcnt(0)" ::: "memory"); __builtin_amdgcn_s_barrier(); asm volatile("" ::: "memory"); } while (0)
#define PP_NEXT(t) do { if (rem_) { t = __builtin_ctzll(rem_); rem_ &= rem_ - 1ull; } else t = -1; } while (0)
#define PP_WAITV(NI, c2, c3) do { if ((c2) && (c3)) { if (NI == 3) asm volatile("s_waitcnt vmcnt(6)" ::: "memory"); else asm volatile("s_waitcnt vmcnt(4)" ::: "memory"); } \
    else if ((c2) || (c3)) { if (NI == 3) asm volatile("s_waitcnt vmcnt(3)" ::: "memory"); else asm volatile("s_waitcnt vmcnt(2)" ::: "memory"); } \
    else asm volatile("s_waitcnt vmcnt(0)" ::: "memory"); } while (0)
#define PP_BEGIN(VW, NI, UMASK, KG, VG, PK, PV) { \
    unsigned long long rem_ = (UMASK); int ta_, tb_, tc_, td_ = -1; PP_NEXT(ta_); PP_NEXT(tb_); PP_NEXT(tc_); int sj_ = 0; \
    dma_tile<VW>(lds, KG, VG, PK, PV, ta_ * 64, lane, wid); \
    if (tb_ >= 0) dma_tile<VW>(lds + ATT_ST, KG, VG, PK, PV, tb_ * 64, lane, wid); \
    if (tc_ >= 0) dma_tile<VW>(lds + 2 * ATT_ST, KG, VG, PK, PV, tc_ * 64, lane, wid); \
    PP_WAITV(NI, tb_ >= 0, tc_ >= 0); PP_BAR(); \
    for (;;) { const int kt = ta_; LAS char* st = lds + sj_ * ATT_ST; \
        if (false) { PP_NEXT(td_); if (td_ >= 0) dma_tile<VW>(lds + ((sj_ + 3) & 3) * ATT_ST, KG, VG, PK, PV, td_ * 64, lane, wid); } {
#define PP_MID(VW, NI, KG, VG, PK, PV) } \
        if (true) { PP_NEXT(td_); if (td_ >= 0) dma_tile<VW>(lds + ((sj_ + 3) & 3) * ATT_ST, KG, VG, PK, PV, td_ * 64, lane, wid); } {
#define PP_END(NI) } if (true) PP_WAITV(NI, tc_ >= 0, td_ >= 0); PP_BAR(); \
        if (tb_ < 0) break; ta_ = tb_; tb_ = tc_; tc_ = td_; td_ = -1; sj_ = (sj_ + 1) & 3; } \
    }

__device__ __forceinline__ void diff_attn_phase(LAS char* lds, const bf16_t* QKV, bf16_t* O, const float* rel_bias, const float* lam_p, const float* subln, int layer, float* stash, int G, int c) {
    constexpr int ATT_ST = 24576;
    int tid_ = threadIdx.x; asm volatile("" : "+v"(tid_));
    const int tid = tid_, lane = tid & 63, wid = __builtin_amdgcn_readfirstlane(tid >> 6), r32 = lane & 31, hh = lane >> 5;
    if (wid >= 4) __builtin_amdgcn_s_setprio(1);
    float s1 = 0.f, s2 = 0.f;
    for (int i = 0; i < 64; ++i) { s1 += lam_p[i] * lam_p[64 + i]; s2 += lam_p[128 + i] * lam_p[192 + i]; }
    const float lam_init = 0.8f - 0.6f * expf(-0.3f * (float)layer);
    const float lam = expf(s1) - expf(s2) + lam_init;
    LAS float* bt = (LAS float*)(lds + ATT_BT);
    size_t pq_ = 64, pv2_ = 128; asm volatile("" : "+s"(pq_), "+s"(pv2_));
    f32x4* mystash = (f32x4*)stash + (size_t)(wid * 64 + lane) * 16;
    for (int it = 0;; ++it) {
        int bh, qb;
        if (G == 256) { if (it >= 4) break; const int j = c >> 6; bh = c & 63; qb = it == 0 ? 15 - j : it == 1 ? 8 + j : it == 2 ? 7 - j : j; }
        else { const int id = it * G + c; if (id >= 1024) break; bh = id & 63; qb = 15 - (id >> 6); }
        const int b = bh >> 3, h = bh & 7, q0 = qb * 256; const size_t rowbase = (size_t)b * T;
        const int qw = q0 + wid * 32, qpos = qw + r32;
        const int NT = (q0 + 256) / 64;
        const unsigned long long um = NT >= 64 ? ~0ull : ((1ull << NT) - 1ull);
        for (int mp = 0; mp < 2; ++mp) {
            if (tid < 128) bt[tid] = (rel_bias[t5_bucket(tid) * 16 + h * 2 + mp] - rel_bias[31 * 16 + h * 2 + mp]) * LOG2E;
            LAS char* Qs = lds + ATT_IMP + wid * 4096;
            { const bf16_t* qp = QKV + (rowbase + qpos) * 1024 + h * 128 + mp * 64 + hh * 8;
#pragma unroll
              for (int kk = 0; kk < 4; ++kk) *(LAS bf16x8*)(Qs + kk * 1024 + lane * 16) = *(const bf16x8*)(qp + kk * 16); }
            f32x16 o[4]; o[0] = f32x16{}; o[1] = f32x16{}; o[2] = f32x16{}; o[3] = f32x16{};
            float m = -1e30f, l = 0.f;
            const bf16_t* Kg = QKV + (size_t)M * 1024 + (size_t)((b * 8 + h) * 2 + mp) * T * 64;
            const bf16_t* Vg = QKV + (size_t)2 * M * 1024 + (size_t)(b * 8 + h) * T * 128;
            bf16x8 P[4];
            PP_BEGIN(2, 3, um, Kg, Vg, pq_, pv2_)
                const int k0 = kt * 64;
                if (k0 <= qw + 31) {
                    f32x16 sa, sb; qk_tile_sw<false>(sa, sb, nullptr, Qs, st, lane);
                    if (qw - (k0 + 63) < 113) score_elem<true>(sa, sb, qpos - k0 - hh * 4, 1 << 30, bt);
                    softmax_step<4>(sa, sb, m, l, o, P, true);
                    pv_tile_sw<4, 256>(o, P, st + 8192, lane);
                }
            PP_MID(2, 3, Kg, Vg, pq_, pv2_)
            PP_END(3)
            const float lt = pair_sum(l); const float inv = __builtin_amdgcn_rcpf(lt);
            if (mp == 0) {
#pragma unroll
                for (int cc = 0; cc < 4; ++cc)
#pragma unroll
                    for (int g4 = 0; g4 < 4; ++g4) mystash[cc * 4 + g4] = (f32x4){o[cc][g4 * 4] * inv, o[cc][g4 * 4 + 1] * inv, o[cc][g4 * 4 + 2] * inv, o[cc][g4 * 4 + 3] * inv};
            } else {
                float ss = 0.f;
#pragma unroll
                for (int cc = 0; cc < 4; ++cc)
#pragma unroll
                    for (int g4 = 0; g4 < 4; ++g4) { const f32x4 a = mystash[cc * 4 + g4];
#pragma unroll
                        for (int e = 0; e < 4; ++e) { const float v = a[e] - lam * (o[cc][g4 * 4 + e] * inv); o[cc][g4 * 4 + e] = v; ss += v * v; }
                        if (g4 == 3) __builtin_amdgcn_sched_barrier(0); }
                ss = pair_sum(ss);
                const float rs = rsqrtf(ss * (1.f / 128.f) + NORM_EPS) * (1.f - lam_init);
                bf16_t* op = O + (rowbase + qpos) * D + h * 128 + hh * 4;
#pragma unroll
                for (int cc = 0; cc < 4; ++cc)
#pragma unroll
                    for (int g4 = 0; g4 < 4; ++g4) { const int dv = cc * 32 + g4 * 8; const f32x4 sg = *(const f32x4*)(subln + dv + hh * 4);
                        u32x2 w; w.x = cvtpk(o[cc][g4 * 4] * rs * sg[0], o[cc][g4 * 4 + 1] * rs * sg[1]); w.y = cvtpk(o[cc][g4 * 4 + 2] * rs * sg[2], o[cc][g4 * 4 + 3] * rs * sg[3]);
                        *(u32x2*)(op + dv) = w; if (g4 == 3) __builtin_amdgcn_sched_barrier(0); }
            }
        }
    }
    __builtin_amdgcn_s_setprio(0);
}

__device__ __forceinline__ void nsa_phase(LAS char* lds, const bf16_t* PROJ, const bf16_t* KVB, const bf16_t* CMP, bf16_t* O, const float* rel_bias, int G, int c) {
    constexpr int ATT_ST = 16384, ATT_STP = ATT_STAGE_NSA;
    int tid_ = threadIdx.x; asm volatile("" : "+v"(tid_));
    const int tid0_ = tid_; const int tid = tid_, lane = tid & 63, wid = __builtin_amdgcn_readfirstlane(tid >> 6), r32 = lane & 31, hh = lane >> 5;
    const int r = wid & 3, qh = wid >> 2;
    if (wid >= 4) __builtin_amdgcn_s_setprio(1);
    LAS float* btall = (LAS float*)(lds + ATT_BT);
    size_t pkv_ = 64, pc_ = 64; asm volatile("" : "+s"(pkv_), "+s"(pc_));
    LAS float* bt = btall + r * 128;
    LAS unsigned long long* SEL = (LAS unsigned long long*)(lds + ATT_SEL);
    LAS unsigned* UM = (LAS unsigned*)(lds + ATT_UM);
    LAS float* IMP = (LAS float*)(lds + ATT_IMP);
    for (int it = 0;; ++it) {
        int bg, qblk;
        if (G == 256) { if (it >= 8) break; const int j = c >> 5; bg = c & 31; qblk = (it & 1) ? (56 - 8 * it + j) : (63 - 8 * it - j); }
        else { const int id = it * G + c; if (id >= 2048) break; bg = id & 31; qblk = 63 - (id >> 5); }
        const int b = bg >> 2, g = bg & 3, t0 = qblk * 64, hq = g * 4 + r; const size_t rowbase = (size_t)b * T;
        const int qw = t0 + qh * 32, qpos = qw + r32;
        btall[tid] = (rel_bias[t5_bucket(tid & 127) * 16 + g * 4 + (tid >> 7)] - rel_bias[31 * 16 + g * 4 + (tid >> 7)]) * LOG2E;
        LAS float* impr = IMP + (r * 64 + qh * 32 + r32) * 65;
        for (int jj = 0; jj < 33; ++jj) { const int idx = 2 * jj + hh; if (idx < 65) impr[idx] = 0.f; }
        if (tid < 2) UM[tid] = 0u;
        bf16x8 qf[4]; float gate[3];
        { const bf16_t* pp = PROJ + (rowbase + qpos) * NBINP;
#pragma unroll
          for (int kk = 0; kk < 4; ++kk) qf[kk] = *(const bf16x8*)(pp + hq * 64 + kk * 16 + hh * 8);
#pragma unroll
          for (int e = 0; e < 3; ++e) gate[e] = __builtin_amdgcn_rcpf(1.f + __expf(-bf2f(pp[1024 + hq * 3 + e]))); }
        f32x16 ot[2]; ot[0] = f32x16{}; ot[1] = f32x16{};
        const int nmaxb = (t0 + 32) >> 4; const int nct = min(4, (nmaxb >> 6) + 1);
        const unsigned long long umc = (1ull << nct) - 1ull;
        const bf16_t* Kc = CMP + (size_t)((0 * 8 + b) * 4 + g) * 256 * 64;
        const bf16_t* Vc = CMP + (size_t)((1 * 8 + b) * 4 + g) * 256 * 64;
        const int nlim = min((qpos - 31) >> 4, 254);
        float mc = -1e30f, lc = 0.f;
        { int tid = tid0_; asm volatile("" : "+v"(tid)); const int lane = tid & 63, r32 = lane & 31, hh = lane >> 5; (void)r32; (void)hh;
        TILE_LOOP_BEGIN(1, umc, Kc, Vc, pc_, pc_)
            f32x16 sa, sb; qk_tile(sa, sb, qf, st + ATT_K0, lane);
            score_elem<false>(sa, sb, nlim - kt * 64 - hh * 4, 1 << 30, bt);
            const float mx = row_max32(sa, sb); const float mn = fmaxf(mc, mx);
            lc *= __builtin_amdgcn_exp2f(mc - mn); mc = mn;
            float sum = 0.f;
#pragma unroll
            for (int i = 0; i < 16; ++i) sum += __builtin_amdgcn_exp2f(sa[i] - mc) + __builtin_amdgcn_exp2f(sb[i] - mc);
            lc += sum;
        TILE_LOOP_END(1) }
        {
            const float lt = pair_sum(lc); const float invl = lt > 0.f ? __builtin_amdgcn_rcpf(lt) : 0.f;
            f32x16 oc[2]; oc[0] = f32x16{}; oc[1] = f32x16{};
            int tid = tid0_; asm volatile("" : "+v"(tid)); const int lane = tid & 63, r32 = lane & 31, hh = lane >> 5; (void)r32; (void)hh;
            LAS float* impr = IMP + (r * 64 + qh * 32 + r32) * 65;
            TILE_LOOP_BEGIN(1, umc, Kc, Vc, pc_, pc_)
                f32x16 sa, sb; qk_tile(sa, sb, qf, st + ATT_K0, lane);
                score_elem<false>(sa, sb, nlim - kt * 64 - hh * 4, 1 << 30, bt);
#pragma unroll
                for (int i = 0; i < 16; ++i) { sa[i] = __builtin_amdgcn_exp2f(sa[i] - mc) * invl; sb[i] = __builtin_amdgcn_exp2f(sb[i] - mc) * invl; }
#pragma unroll
                for (int kb = 0; kb < 2; ++kb)
#pragma unroll
                    for (int ig = 0; ig < 4; ++ig) { const int j = kt * 16 + kb * 8 + ig * 2 + hh;
                        const float g4 = kb ? ((sb[ig * 4] + sb[ig * 4 + 1]) + (sb[ig * 4 + 2] + sb[ig * 4 + 3])) : ((sa[ig * 4] + sa[ig * 4 + 1]) + (sa[ig * 4 + 2] + sa[ig * 4 + 3]));
                        impr[j] += g4; }
                asm volatile("s_waitcnt lgkmcnt(0)" ::: "memory");
#pragma unroll
                for (int kb = 0; kb < 2; ++kb)
#pragma unroll
                    for (int ig = 0; ig < 4; ++ig) { const int j = kt * 16 + kb * 8 + ig * 2 + hh;
                        impr[j + 1] += kb ? sb[ig * 4 + 3] : sa[ig * 4 + 3]; }
                asm volatile("s_waitcnt lgkmcnt(0)" ::: "memory");
                bf16x8 P[4];
                { u32x4 w0 = {cvtpk(sa[0], sa[1]), cvtpk(sa[2], sa[3]), cvtpk(sa[4], sa[5]), cvtpk(sa[6], sa[7])};
                  u32x4 w1 = {cvtpk(sa[8], sa[9]), cvtpk(sa[10], sa[11]), cvtpk(sa[12], sa[13]), cvtpk(sa[14], sa[15])};
                  u32x4 w2 = {cvtpk(sb[0], sb[1]), cvtpk(sb[2], sb[3]), cvtpk(sb[4], sb[5]), cvtpk(sb[6], sb[7])};
                  u32x4 w3 = {cvtpk(sb[8], sb[9]), cvtpk(sb[10], sb[11]), cvtpk(sb[12], sb[13]), cvtpk(sb[14], sb[15])};
                  P[0] = __builtin_bit_cast(bf16x8, w0); P[1] = __builtin_bit_cast(bf16x8, w1); P[2] = __builtin_bit_cast(bf16x8, w2); P[3] = __builtin_bit_cast(bf16x8, w3); }
                pv_tile<2, VP64>(oc, P, st + ATT_V0, lane);
            TILE_LOOP_END(1)
            ot[0] = oc[0] * gate[0]; ot[1] = oc[1] * gate[0];
        }
        {
            unsigned long long wun = 0ull;
            int tid = tid0_; asm volatile("" : "+v"(tid)); const int lane = tid & 63, r32 = lane & 31, hh = lane >> 5; (void)r32; (void)hh;
#pragma unroll 1
            for (int k = 0; k < 8; ++k) {
                const int q = wid * 8 + k;
                float v = ((IMP[(0 * 64 + q) * 65 + lane] + IMP[(1 * 64 + q) * 65 + lane]) + IMP[(2 * 64 + q) * 65 + lane]) + IMP[(3 * 64 + q) * 65 + lane];
                if (lane == 0 || lane == qblk || lane == qblk - 1) v = 1e4f;
                if (lane > qblk) v = -1e30f;
                int rank = 0; const int vi = __builtin_bit_cast(int, v);
#pragma unroll 8
                for (int jj = 0; jj < 64; ++jj) { const float vj = __builtin_bit_cast(float, __builtin_amdgcn_readlane(vi, jj)); rank += (vj > v || (vj == v && jj < lane)) ? 1 : 0; }
                const unsigned long long mk = __builtin_amdgcn_ballot_w64(rank < 16 && lane <= qblk);
                if (lane == 0) SEL[q] = mk;
                wun |= mk;
            }
            if (lane == 0) { atomicOr((unsigned*)&UM[0], (unsigned)wun); atomicOr((unsigned*)&UM[1], (unsigned)(wun >> 32)); }
            __syncthreads();
        }
        {
            int tid = tid0_; asm volatile("" : "+v"(tid)); const int lane = tid & 63, r32 = lane & 31, hh = lane >> 5; (void)r32; (void)hh;
            const unsigned long long ums = (unsigned long long)UM[0] | ((unsigned long long)UM[1] << 32);
            const unsigned long long mysel = SEL[qh * 32 + r32];
            f32x16 o[2]; o[0] = f32x16{}; o[1] = f32x16{};
            float m = -1e30f, l = 0.f;
            const bf16_t* Kg = KVB + (size_t)((2 * 8 + b) * 4 + g) * T * 64;
            const bf16_t* Vg = KVB + (size_t)((3 * 8 + b) * 4 + g) * T * 64;
            bf16x8 P[4];
            PP_BEGIN(1, 2, ums, Kg, Vg, pkv_, pkv_)
                const bool sel = (mysel >> kt) & 1ull;
                const int k0 = kt * 64;
                f32x16 sa, sb; qk_tile_sw<true>(sa, sb, qf, nullptr, st, lane);
                if (qw - (k0 + 63) < 113) score_elem<true>(sa, sb, qpos - k0 - hh * 4, 1 << 30, bt);
                softmax_step<2>(sa, sb, m, l, o, P, sel);
            PP_MID(1, 2, Kg, Vg, pkv_, pkv_)
                pv_tile_sw<2, 128>(o, P, st + 8192, lane);
            PP_END(2)
            const float lt = pair_sum(l); const float sc = gate[1] * __builtin_amdgcn_rcpf(lt);
            ot[0] += o[0] * sc; ot[1] += o[1] * sc;
        }
        {
            int tid = tid0_; asm volatile("" : "+v"(tid)); const int lane = tid & 63, r32 = lane & 31, hh = lane >> 5; (void)r32; (void)hh;
            const int lo = max(0, qblk - 8);
            const unsigned long long hiM = qblk >= 63 ? ~0ull : ((1ull << (qblk + 1)) - 1ull);
            const unsigned long long umw = hiM & ~((1ull << lo) - 1ull);
            f32x16 o[2]; o[0] = f32x16{}; o[1] = f32x16{};
            float m = -1e30f, l = 0.f;
            const bf16_t* Kg = KVB + (size_t)((4 * 8 + b) * 4 + g) * T * 64;
            const bf16_t* Vg = KVB + (size_t)((5 * 8 + b) * 4 + g) * T * 64;
            bf16x8 P[4];
            PP_BEGIN(1, 2, umw, Kg, Vg, pkv_, pkv_)
                const int k0 = kt * 64;
                f32x16 sa, sb; qk_tile_sw<true>(sa, sb, qf, nullptr, st, lane);
                if (qw - (k0 + 63) < 113 || qw + 31 - k0 >= 512) score_elem<true>(sa, sb, qpos - k0 - hh * 4, 512, bt);
                softmax_step<2>(sa, sb, m, l, o, P, true);
            PP_MID(1, 2, Kg, Vg, pkv_, pkv_)
                pv_tile_sw<2, 128>(o, P, st + 8192, lane);
            PP_END(2)
            const float lt = pair_sum(l); const float sc = gate[2] * __builtin_amdgcn_rcpf(lt);
            ot[0] += o[0] * sc; ot[1] += o[1] * sc;
        }
        { int tid = tid0_; asm volatile("" : "+v"(tid)); const int lane = tid & 63, r32 = lane & 31, hh = lane >> 5; (void)r32; (void)hh;
          bf16_t* op = O + (rowbase + qpos) * D + hq * 64 + hh * 4;
#pragma unroll
          for (int cc = 0; cc < 2; ++cc)
#pragma unroll
              for (int g4 = 0; g4 < 4; ++g4) { u32x2 w; w.x = cvtpk(ot[cc][g4 * 4], ot[cc][g4 * 4 + 1]); w.y = cvtpk(ot[cc][g4 * 4 + 2], ot[cc][g4 * 4 + 3]);
                  *(u32x2*)(op + cc * 32 + g4 * 8) = w; } }
    }
    __builtin_amdgcn_s_setprio(0);
}

#define XB_TMO      128
#define XB_XCNT(j)  (256  + 64 * (j))
#define XB_XSUB(j)  (1280 + 64 * (j))
#define XB_XGEN(j)  (2304 + 64 * (j))
#define XB_TOP      3328
#define XB_TOPGEN   3392
#define XCD_BAR_WORDS 3456
#define XB_SPIN_CAP (1u << 18)

__device__ __forceinline__ unsigned xb_ld(unsigned* p)              { return __hip_atomic_load(p, __ATOMIC_RELAXED, __HIP_MEMORY_SCOPE_AGENT); }
__device__ __forceinline__ unsigned xb_add(unsigned* p, unsigned v) { return __hip_atomic_fetch_add(p, v, __ATOMIC_RELAXED, __HIP_MEMORY_SCOPE_AGENT); }
__device__ __forceinline__ unsigned xb_xcc_id() { return (unsigned)__builtin_amdgcn_s_getreg((3 << 11) | 20) & 0xFu; }
#define XB_SPIN(cond, bar) do { unsigned _sp = 0; while (cond) { __builtin_amdgcn_s_sleep(1); \
    if ((++_sp & 255u) == 0u) { if (xb_ld(&(bar)[XB_TMO])) break; if (_sp > XB_SPIN_CAP) { atomicAdd(&(bar)[XB_TMO], 1u); break; } } } } while (0)

struct XcdBarrier {
    unsigned* bar; unsigned x;
    volatile LAS unsigned* st;
};

__device__ __forceinline__ XcdBarrier xcd_barrier_post(unsigned* bar, volatile LAS unsigned* st) {
    XcdBarrier b; b.bar = bar; b.x = xb_xcc_id(); b.st = st;
    if (threadIdx.x == 0) (void)xb_add(&bar[XB_XCNT(b.x)], 1u);
    return b;
}
__device__ __forceinline__ void xcd_barrier_complete(unsigned* bar, unsigned x, unsigned& nloc, unsigned& nx) {
    const unsigned G = gridDim.x * gridDim.y * gridDim.z;
    unsigned sum, cnt, mine, sp = 0u;
    for (;;) {
        sum = 0u; cnt = 0u; mine = 0u;
#pragma unroll
        for (unsigned j = 0; j < 16; ++j) { const unsigned c = xb_ld(&bar[XB_XCNT(j)]); sum += c; cnt += (c > 0u) ? 1u : 0u; mine = (j == x) ? c : mine; }
        if (sum == G) break;
        __builtin_amdgcn_s_sleep(1);
        if ((++sp & 255u) == 0u) { if (xb_ld(&bar[XB_TMO])) break; if (sp > XB_SPIN_CAP) { atomicAdd(&bar[XB_TMO], 1u); break; } }
    }
    nloc = mine > 0u ? mine : 1u; nx = cnt > 0u ? cnt : 1u;
}

__device__ __forceinline__ void xcd_barrier(const XcdBarrier& b) {
    asm volatile("s_waitcnt vmcnt(0)" ::: "memory");
    __syncthreads();
    if (threadIdx.x == 0) {
        unsigned* bar = b.bar;
        __builtin_amdgcn_s_waitcnt(0);
        unsigned nloc = b.st[0], nx = b.st[1];
        if (nloc == 0u) { xcd_barrier_complete(bar, b.x, nloc, nx); b.st[0] = nloc; b.st[1] = nx; }
        const unsigned old = xb_add(&bar[XB_XSUB(b.x)], 1u);
        const unsigned gen = old / nloc;
        if (old + 1u == (gen + 1u) * nloc) {
            __builtin_amdgcn_fence(__ATOMIC_RELEASE, "agent");
            asm volatile("s_waitcnt vmcnt(0)" ::: "memory");
            const unsigned og = xb_add(&bar[XB_TOP], 1u);
            const unsigned tg = og / nx;
            if (og + 1u == (tg + 1u) * nx) xb_add(&bar[XB_TOPGEN], 1u);
            else XB_SPIN(xb_ld(&bar[XB_TOPGEN]) == tg, bar);
            __builtin_amdgcn_fence(__ATOMIC_ACQUIRE, "agent");
            xb_add(&bar[XB_XGEN(b.x)], 1u);
            asm volatile("s_waitcnt vmcnt(0)" ::: "memory");
        } else {
            XB_SPIN(xb_ld(&bar[XB_XGEN(b.x)]) == gen, bar);
            __builtin_amdgcn_fence(__ATOMIC_ACQUIRE, "agent");
            asm volatile("s_waitcnt vmcnt(0)" ::: "memory");
        }
    }
    __syncthreads();
}

__global__ void __launch_bounds__(512, 2) mk_fwd(Params p) {
    extern __shared__ __attribute__((aligned(16))) unsigned char lds_raw[];
    LAS unsigned char* lds = (LAS unsigned char*)lds_raw;
    volatile LAS unsigned* bar_st = (volatile LAS unsigned*)(lds + LDS_BARST);
    if (threadIdx.x < 2) bar_st[threadIdx.x] = 0u;
    __syncthreads();
    (void)xcd_barrier_post((unsigned*)(p.ws + WS_BAR), bar_st);
    typedef const char __attribute__((address_space(4)))* kaptr_t;
    for (int step = p.step_lo; step < p.step_hi; ++step) {
        kaptr_t ka = (kaptr_t)__builtin_amdgcn_kernarg_segment_ptr();
        asm volatile("" : "+s"(ka));
        int tid_ = threadIdx.x; asm volatile("" : "+v"(tid_));
        int c_ = blockIdx.x; asm volatile("" : "+s"(c_));
        int G_ = gridDim.x; asm volatile("" : "+s"(G_));
        const int tid = tid_, lane = tid & 63, wave = __builtin_amdgcn_readfirstlane(tid >> 6);
        const int G = G_, c = c_;
        const int gw = c * 8 + wave, NGW = G * 8;
#define PIN(i) (*(const float* const __attribute__((address_space(4)))*)(ka + 8 * (i)))
        unsigned char* ws = *(unsigned char* const __attribute__((address_space(4)))*)(ka + 8 * 24);
        const float* x_in = PIN(0);
        float* xres = *(float* const __attribute__((address_space(4)))*)(ka + 8 * 23);
        float* mod = (float*)(ws + WS_MOD);
        float* kvmod = (float*)(ws + WS_KVMOD);
        bf16_t* XN = (bf16_t*)(ws + WS_XN);
        bf16_t* BIG = (bf16_t*)(ws + WS_BIG);
        bf16_t* HID = (bf16_t*)(ws + WS_HID);
        bf16_t* KVB = (bf16_t*)(ws + WS_KV);
        bf16_t* CMP = (bf16_t*)(ws + WS_CMP);
        int kind, layer = 0, sub = 0;
        int es = step;
#ifdef DUP_CLASS
        {
            int s = 0, e = 0;
            for (e = 0; e < 43; ++e) {
                int k2, l2 = 0, s2 = 0;
                if (e == 0) k2 = 0; else if (e <= 18) { k2 = 1; l2 = (e - 1) / 9; s2 = (e - 1) % 9; } else if (e <= 23) { k2 = 2; s2 = e - 19; } else if (e <= 41) { k2 = 1; l2 = 2 + (e - 24) / 9; s2 = (e - 24) % 9; } else k2 = 3;
                const bool d = (DUP_CLASS == 1 && k2 == 1 && s2 == 2 && l2 < 2) || (DUP_CLASS == 2 && k2 == 1 && s2 == 2 && l2 >= 2) ||
                               (DUP_CLASS == 3 && k2 == 1 && (s2 == 5 || s2 == 7)) || (DUP_CLASS == 4 && ((k2 == 1 && (s2 == 0 || s2 == 4)) || (k2 == 2 && s2 == 0))) ||
                               (DUP_CLASS == 5 && k2 == 1 && s2 == 1) || (DUP_CLASS == 6 && k2 == 0) || (DUP_CLASS == 7 && k2 == 2);
                if (s == step) break; ++s; if (d) { if (s == step) break; ++s; }
            }
            es = e;
        }
#endif
        if (es == 0) kind = 0;
        else if (es <= 18) { kind = 1; layer = (es - 1) / 9; sub = (es - 1) % 9; }
        else if (es <= 23) { kind = 2; sub = es - 19; }
        else if (es <= 41) { kind = 1; layer = 2 + (es - 24) / 9; sub = (es - 24) % 9; }
        else kind = 3;

        int gwn = gw, ngwn = NGW;
        if (G > 128) {
            if (kind == 1 && layer == 2 && sub == 0) continue;
            if (kind == 2 && sub == 3 && c >= 64) { kind = 1; layer = 2; sub = 0; gwn = (c - 64) * 8 + wave; ngwn = (G - 64) * 8; }
        }
        if (kind == 0) {
            {
                LAS float* scr = (LAS float*)(lds + wave * 16384);
                for (int it = gw;; it += NGW) {
                    int rr = it; const float* src; bf16_t* dst; int K, Ns;
                    if (rr < 2 * 1536) { const int l = rr / 1536; rr %= 1536; src = PIN(9) + (size_t)l * D * NQKV; dst = (bf16_t*)(ws + WS_WQKV) + (size_t)l * NQKV * D; K = D; Ns = NQKV; }
                    else if ((rr -= 3072) < 2 * 512) { const int l = rr / 512; rr %= 512; src = PIN(10) + (size_t)l * D * D; dst = (bf16_t*)(ws + WS_WAO) + (size_t)l * D * D; K = D; Ns = D; }
                    else if ((rr -= 1024) < 4 * 2048) { const int l = rr / 2048; rr %= 2048; src = PIN(7) + (size_t)l * D * FF; dst = (bf16_t*)(ws + WS_W1) + (size_t)l * D * FF; K = D; Ns = FF; }
                    else if ((rr -= 8192) < 4 * 2048) { const int l = rr / 2048; rr %= 2048; src = PIN(8) + (size_t)l * D * FF; dst = (bf16_t*)(ws + WS_W2) + (size_t)l * D * FF; K = FF; Ns = D; }
                    else if ((rr -= 8192) < 768) { src = PIN(16); dst = (bf16_t*)(ws + WS_WKV); K = D; Ns = NKV; }
                    else if ((rr -= 768) < 2 * 544) { const int l = rr / 544; rr %= 544; src = PIN(20) + (size_t)l * D * NBIN; dst = (bf16_t*)(ws + WS_WBIN) + (size_t)l * NBINP * D; K = D; Ns = NBIN; }
                    else if ((rr -= 1088) < 2 * 512) { const int l = rr / 512; rr %= 512; src = PIN(21) + (size_t)l * D * D; dst = (bf16_t*)(ws + WS_WBO) + (size_t)l * D * D; K = D; Ns = D; }
                    else if ((rr -= 1024) < 2 * 256) { const int l = rr / 256; rr %= 256; src = PIN(18) + (size_t)l * 2048 * 256; dst = (bf16_t*)(ws + WS_WC1) + (size_t)l * 256 * 2048; K = 2048; Ns = 256; }
                    else break;
                    transpose_item(src, K, Ns, dst, scr, rr, lane);
                }
                { unsigned z_ = 0u; asm volatile("" : "+v"(z_));
                for (int i = c * 512 + tid; i < 2 * 192 * 1024 / 8; i += G * 512) { const int l = i / (192 * 128), rem = i % (192 * 128);
                    *(u32x4*)((bf16_t*)(ws + WS_WBIN) + (size_t)l * NBINP * D + (size_t)1088 * D + (size_t)rem * 8) = (u32x4){z_, z_, z_, z_}; } }
            }
            __syncthreads();
            {
                LAS float* cact = (LAS float*)lds;
                LAS float* red = (LAS float*)(lds + 32768);
                for (int i = tid; i < 8192; i += 512) { const float v = PIN(1)[i]; cact[i] = v * __builtin_amdgcn_rcpf(1.f + __expf(-v)); }
                __syncthreads();
                for (int cgi = c; cgi < 416; cgi += G) {
                    const float* W; const float* bias; float* outp; int N, col0, ostride;
                    if (cgi < 384) { const int l = cgi / 96; col0 = (cgi % 96) * 64; W = PIN(3) + (size_t)l * D * 6144; N = 6144; bias = PIN(4) + l * 6144; outp = mod + (size_t)l * 8 * 6144; ostride = 6144; }
                    else { col0 = (cgi - 384) * 64; W = PIN(13); N = 2048; bias = PIN(14); outp = kvmod; ostride = 2048; }
                    float acc[8];
#pragma unroll
                    for (int b = 0; b < 8; ++b) acc[b] = 0.f;
                    const float* wp = W + (size_t)(wave * 128) * N + col0 + lane;
#pragma unroll 32
                    for (int k = 0; k < 128; ++k) { const float wv = wp[(size_t)k * N];
#pragma unroll
                        for (int b = 0; b < 8; ++b) acc[b] += cact[b * 1024 + wave * 128 + k] * wv; }
#pragma unroll
                    for (int b = 0; b < 8; ++b) red[(wave * 8 + b) * 64 + lane] = acc[b];
                    __syncthreads();
                    { const int b = tid >> 6; float s = 0.f;
#pragma unroll
                      for (int w = 0; w < 8; ++w) s += red[(w * 8 + b) * 64 + lane];
                      outp[(size_t)b * ostride + col0 + lane] = s + bias[col0 + lane]; }
                    __syncthreads();
                }
            }
        } else if (kind == 3 || (kind == 1 && (sub == 0 || sub == 4)) || (kind == 2 && sub == 0)) {
            const float* src = (kind == 1 && layer == 0 && sub == 0) ? x_in : xres;
            const float* gamma; const float* shift = nullptr; const float* scale = nullptr; int bstride = 0;
            if (kind == 3) gamma = PIN(22);
            else if (kind == 2) { gamma = PIN(15); shift = kvmod; scale = kvmod + 1024; bstride = 2048; }
            else if (sub == 0) { gamma = PIN(5) + layer * D; shift = mod + (size_t)layer * 8 * 6144; scale = shift + 1024; bstride = 6144; }
            else { gamma = PIN(6) + layer * D; shift = mod + (size_t)layer * 8 * 6144 + 3072; scale = shift + 1024; bstride = 6144; }
            int tid = tid_; asm volatile("" : "+v"(tid)); const int lane = tid & 63; (void)lane;
            for (int chunk = gwn; chunk < M / 16; chunk += ngwn) {
                const int row0 = chunk * 16, b = row0 / T;
                f32x4 A[4], Bv[4];
#pragma unroll
                for (int j = 0; j < 4; ++j) { const int col = 4 * lane + 256 * j; const f32x4 gm = *(const f32x4*)(gamma + col);
                    if (scale) { const f32x4 sc = *(const f32x4*)(scale + (size_t)b * bstride + col); A[j] = gm * (sc + 1.0f); Bv[j] = *(const f32x4*)(shift + (size_t)b * bstride + col); }
                    else { A[j] = gm; Bv[j] = (f32x4){0.f, 0.f, 0.f, 0.f}; } }
#pragma unroll 1
                for (int rq = 0; rq < 16; rq += 4) {
                    f32x4 v[4][4];
#pragma unroll
                    for (int r4 = 0; r4 < 4; ++r4)
#pragma unroll
                        for (int j = 0; j < 4; ++j) v[r4][j] = *(const f32x4*)(src + (size_t)(row0 + rq + r4) * D + 4 * lane + 256 * j);
#pragma unroll
                    for (int r4 = 0; r4 < 4; ++r4) {
                        const size_t ro = (size_t)(row0 + rq + r4) * D; float ss = 0.f;
#pragma unroll
                        for (int j = 0; j < 4; ++j) ss += (v[r4][j].x * v[r4][j].x + v[r4][j].y * v[r4][j].y) + (v[r4][j].z * v[r4][j].z + v[r4][j].w * v[r4][j].w);
                        const float rstd = rsqrtf(wave_sum(ss, lane) * (1.f / D) + NORM_EPS);
#pragma unroll
                        for (int j = 0; j < 4; ++j) { const f32x4 y = v[r4][j] * rstd * A[j] + Bv[j];
                            if (kind == 3) *(f32x4*)(xres + ro + 4 * lane + 256 * j) = y;
                            else { u32x2 w; w.x = cvtpk(y.x, y.y); w.y = cvtpk(y.z, y.w); *(u32x2*)(XN + ro + 4 * lane + 256 * j) = w; } }
                    }
                }
            }
        } else if (kind == 1 && sub == 2) {
#ifndef NO_DIFF
            if (layer < 2) diff_attn_phase((LAS char*)lds, BIG, XN, PIN(2), PIN(11) + layer * 256, PIN(12) + layer * 128, layer, (float*)(ws + WS_O1) + (size_t)c * 32768, G, c);
#endif
#ifndef NO_NSA
            if (layer >= 2) nsa_phase((LAS char*)lds, BIG, KVB, CMP, XN, PIN(2), G, c);
#endif
        } else if (kind == 2 && sub == 2) {
            int tid = tid_; asm volatile("" : "+v"(tid)); const int lane = tid & 63; (void)lane;
            for (size_t idx = (size_t)c * 512 + tid; idx < (size_t)16384 * 256; idx += (size_t)G * 512) {
                const int row = (int)(idx >> 8), c8 = (int)(idx & 255), l = c8 >> 3, d0 = (c8 & 7) * 8;
                const int n = row & 255, g = (row >> 8) & 3, b = (row >> 10) & 7, s = row >> 13;
                const int t = 16 * n + l;
                unsigned z_ = 0u; asm volatile("" : "+v"(z_));
                u32x4 o = {z_, z_, z_, z_};
                if (t < T) {
                    const u32x4 kv = *(const u32x4*)(KVB + ((size_t)((s * 8 + b) * 4 + g) * T + t) * 64 + d0);
                    const float* pp = PIN(17) + (s * 32 + l) * 64 + d0;
                    const f32x4 p0 = *(const f32x4*)pp, p1 = *(const f32x4*)(pp + 4);
                    o.x = cvtpk(bf2f((bf16_t)(kv.x & 0xffff)) + p0.x, bf2f((bf16_t)(kv.x >> 16)) + p0.y);
                    o.y = cvtpk(bf2f((bf16_t)(kv.y & 0xffff)) + p0.z, bf2f((bf16_t)(kv.y >> 16)) + p0.w);
                    o.z = cvtpk(bf2f((bf16_t)(kv.z & 0xffff)) + p1.x, bf2f((bf16_t)(kv.z >> 16)) + p1.y);
                    o.w = cvtpk(bf2f((bf16_t)(kv.w & 0xffff)) + p1.z, bf2f((bf16_t)(kv.w >> 16)) + p1.w);
                }
                *(u32x4*)(BIG + (size_t)row * 2048 + c8 * 8) = o;
            }
        } else if (kind == 2 && sub == 4) {
            int tid = tid_; asm volatile("" : "+v"(tid)); const int lane = tid & 63; (void)lane;
            for (int rg = gw; rg < 16384 / 8; rg += NGW) {
                const int row0 = rg * 8, s = row0 >> 13;
                const float* w2 = PIN(19) + (size_t)s * 256 * 64 + lane;
                float acc[8];
#pragma unroll
                for (int i = 0; i < 8; ++i) acc[i] = 0.f;
                for (int h = 0; h < 256; h += 2) {
                    const float wa = w2[(size_t)h * 64], wb = w2[(size_t)(h + 1) * 64];
#pragma unroll
                    for (int i = 0; i < 8; ++i) { const unsigned hv = *(const unsigned*)(HID + (size_t)(row0 + i) * 256 + h);
                        acc[i] += bf2f((bf16_t)(hv & 0xffff)) * wa + bf2f((bf16_t)(hv >> 16)) * wb; }
                }
#pragma unroll
                for (int i = 0; i < 8; ++i) CMP[(size_t)(row0 + i) * 64 + lane] = (bf16_t)f2bf(acc[i]);
            }
        } else {
            pg8::Gemm g; pg8::Sched S;
            bool resid = false; pg8::EpiStore ES{nullptr, 0, 0, 0, 0, 0}; pg8::EpiResid ER{nullptr, nullptr, nullptr, 0};
            if (kind == 2 && sub == 1) { g = pg8::Gemm{XN, (const bf16_t*)(ws + WS_WKV), M, NKV, D}; S.init(M, NKV, G, c, 0); ES = pg8::EpiStore{KVB, NKV, 0, 0, 0, 2}; }
            else if (kind == 2) { g = pg8::Gemm{BIG, (const bf16_t*)(ws + WS_WC1), 16384, 512, 2048}; S.init(16384, 512, G, c, 1); ES = pg8::EpiStore{HID, 256, 2, 1, 0, 0}; }
            else if (sub == 1) {
                if (layer < 2) { g = pg8::Gemm{XN, (const bf16_t*)(ws + WS_WQKV) + (size_t)layer * NQKV * D, M, NQKV, D}; S.init(M, NQKV, G, c, 0); ES = pg8::EpiStore{BIG, 1024, 0, 0, 1024, 1}; }
                else { g = pg8::Gemm{XN, (const bf16_t*)(ws + WS_WBIN) + (size_t)(layer - 2) * NBINP * D, M, NBINP, D}; S.init(M, NBINP, G, c, 0); ES = pg8::EpiStore{BIG, NBINP, 0, 0, 1024, 0}; }
            } else if (sub == 3) {
                const bf16_t* W = layer < 2 ? (const bf16_t*)(ws + WS_WAO) + (size_t)layer * D * D : (const bf16_t*)(ws + WS_WBO) + (size_t)(layer - 2) * D * D;
                g = pg8::Gemm{XN, W, M, D, D}; S.init(M, D, G, c, 0); resid = true;
                ER = pg8::EpiResid{layer == 0 ? x_in : xres, xres, mod + (size_t)layer * 8 * 6144 + 2048, 0};
            } else if (sub == 5 || sub == 7) {
                const int half = (sub - 5) / 2;
                g = pg8::Gemm{XN + (size_t)half * 16384 * D, (const bf16_t*)(ws + WS_W1) + (size_t)layer * D * FF, 16384, FF, D}; S.init(16384, FF, G, c, 0); ES = pg8::EpiStore{BIG, FF, 1, 0, 0, 0};
            } else {
                const int half = (sub - 6) / 2;
                g = pg8::Gemm{BIG, (const bf16_t*)(ws + WS_W2) + (size_t)layer * D * FF, 16384, D, FF}; S.init(16384, D, G, c, 0); resid = true;
                ER = pg8::EpiResid{xres, xres, mod + (size_t)layer * 8 * 6144 + 5120, half * 16384};
            }
#ifndef NO_GEMM
            if (resid) pg8::gemm_phase<pg8::EpiResid, pg8::Sched, true, true>(lds, g, S, ER);
            else pg8::gemm_phase<pg8::EpiStore, pg8::Sched, true, true>(lds, g, S, ES);
#endif
        }
        if (step + 1 < p.step_hi) {
#if USE_XCD_BAR
            if (step == p.step_lo) cg::this_grid().sync();
            else { XcdBarrier xb; xb.bar = (unsigned*)(ws + WS_BAR); xb.x = xb_xcc_id(); xb.st = (volatile LAS unsigned*)(lds + LDS_BARST); xcd_barrier(xb); }
#else
            cg::this_grid().sync();
#endif
        }
    }
}

extern "C" void kernel_launch(void* const* d_in, const int* in_sizes, int n_in, void* d_out, int out_size, void* d_ws, size_t ws_size, hipStream_t stream) {
    static int grid = 0;
    if (grid == 0) {
        if (n_in != 23 || out_size != M * D || ws_size < WS_END) { fprintf(stderr, "kernel_launch: unexpected shapes (n_in %d out %d ws %zu)\n", n_in, out_size, ws_size); grid = -1; return; }
        int dev = 0, cus = 0, per_cu = 0;
        hipGetDevice(&dev);
        hipDeviceGetAttribute(&cus, hipDeviceAttributeMultiprocessorCount, dev);
        hipFuncSetAttribute((const void*)mk_fwd, hipFuncAttributeMaxDynamicSharedMemorySize, LDS_BYTES);
        if (hipOccupancyMaxActiveBlocksPerMultiprocessor(&per_cu, (const void*)mk_fwd, 512, LDS_BYTES) != hipSuccess || per_cu < 1) { fprintf(stderr, "kernel_launch: occupancy query says %d\n", per_cu); per_cu = 1; }
        (void)hipGetLastError();
        grid = cus;
    }
    if (grid < 0) return;
    hipMemsetAsync((char*)d_ws + WS_BAR, 0, 16384, stream);
    Params p{};
    for (int i = 0; i < 23; ++i) p.in[i] = (const float*)d_in[i];
    p.out = (float*)d_out; p.ws = (unsigned char*)d_ws; p.step_lo = 0; p.step_hi = 43 + NDUP;
    void* args[] = {&p};
    hipError_t e = hipLaunchCooperativeKernel((const void*)mk_fwd, dim3(grid), dim3(512), args, LDS_BYTES, stream);
    if (e != hipSuccess) fprintf(stderr, "cooperative launch failed: %s (grid %d)\n", hipGetErrorString(e), grid);
}
```

```cpp
#include <hip/hip_runtime.h>
#include <hip/hip_cooperative_groups.h>
#include <cstdio>
#include <cstdint>
namespace cg = cooperative_groups;

#ifndef NDUP
#define NDUP 0
#endif
#ifndef USE_XCD_BAR
#define USE_XCD_BAR 1
#endif

#define LAS __attribute__((address_space(3)))
typedef unsigned short bf16_t;
typedef short bf16x8 __attribute__((ext_vector_type(8)));
typedef short s16x4 __attribute__((ext_vector_type(4)));
typedef float f32x4 __attribute__((ext_vector_type(4)));
typedef float f32x16 __attribute__((ext_vector_type(16)));
typedef unsigned u32x4 __attribute__((ext_vector_type(4)));
typedef unsigned u32x2 __attribute__((ext_vector_type(2)));
typedef float f32x2_t __attribute__((ext_vector_type(2)));
typedef __bf16 bf16x2_t __attribute__((ext_vector_type(2)));

__device__ __forceinline__ unsigned cvtpk(float lo, float hi) { f32x2_t v = {lo, hi}; bf16x2_t b = __builtin_convertvector(v, bf16x2_t); return __builtin_bit_cast(unsigned, b); }
__device__ __forceinline__ float bf2f(bf16_t v) { return __builtin_bit_cast(float, (unsigned)v << 16); }

constexpr int BATCH = 8, T = 4096, D = 1024, M = BATCH * T, FF = 4096;
constexpr int NQKV = 3072, NKV = 1536, NBIN = 1072, NBINP = 1280;
constexpr float NORM_EPS = 1e-6f;
constexpr float LOG2E = 1.4426950408889634f;
constexpr float SC2 = 0.125f * LOG2E;

constexpr size_t MiB = 1u << 20;
constexpr size_t WS_MOD = 0;
constexpr size_t WS_KVMOD = 4 * 8 * 6144 * 4;
constexpr size_t WS_BAR = 1 * MiB;
constexpr size_t WS_WQKV = 2 * MiB;
constexpr size_t WS_WAO = 14 * MiB;
constexpr size_t WS_W1 = 18 * MiB;
constexpr size_t WS_W2 = 50 * MiB;
constexpr size_t WS_WKV = 82 * MiB;
constexpr size_t WS_WBIN = 85 * MiB;
constexpr size_t WS_WBO = 90 * MiB;
constexpr size_t WS_WC1 = 94 * MiB;
constexpr size_t WS_XN = 96 * MiB;
constexpr size_t WS_BIG = 160 * MiB;
constexpr size_t WS_HID = 224 * MiB;
constexpr size_t WS_KV = 352 * MiB;
constexpr size_t WS_CMP = 448 * MiB;
constexpr size_t WS_O1 = 450 * MiB;
constexpr size_t WS_END = 482 * MiB;

namespace pg8 {
#define PG8_LAS __attribute__((address_space(3)))
constexpr int BM = 256, BK = 64, HALF = 128, HTB = HALF * BK * 2, STAGE_BYTES = 8 * HTB, NXCD = 8, WGM = 8;
__host__ __device__ __forceinline__ int lds_byte(int r, int c) { const int st = (r >> 4) * 2 + (c >> 5), rr = r & 15, cc = c & 31, ob = rr * 64 + cc * 2; return st * 1024 + (ob ^ (((ob >> 9) & 1) << 5)); }
__host__ __device__ __forceinline__ void stage_rc(int b, int& R, int& C) { const int st = b / 1024, sb = b % 1024, swz = sb ^ (((sb >> 9) & 1) << 5); R = (st >> 1) * 16 + swz / 64; C = (st & 1) * 32 + (swz % 64) / 2; }
__host__ __device__ __forceinline__ int perm32(int rho) { const int n = rho >> 4, i = rho & 15; return 8 * (i >> 2) + 4 * n + (i & 3); }

struct Unit { int pm, pn; };
struct Gemm { const bf16_t* A; const bf16_t* Bt; int M, N, K; };

struct Sched {
    int nM, nN, nwg, G, c, mode;
    __device__ void init(int M_, int N_, int G_, int c_, int mode_) { nM = M_ / BM; nN = N_ / BM; nwg = mode_ ? nM : nM * nN; G = G_; c = c_; mode = mode_; }
    __device__ bool next(int i, Unit& u) const {
        const long L = (long)i * G + c; if (L >= nwg) return false;
        if (mode == 1) { u.pm = (int)L; u.pn = (int)L >> 5; return true; }
        int wgid = (int)L; { const int q = nwg / NXCD, r = nwg % NXCD, xcd = wgid % NXCD, off = wgid / NXCD; wgid = (xcd < r ? xcd * (q + 1) : r * (q + 1) + (xcd - r) * q) + off; }
        const int nig = WGM * nN, gid = wgid / nig, fm = gid * WGM, gsz = (nM - fm) < WGM ? (nM - fm) : WGM;
        u.pm = fm + ((wgid % nig) % gsz); u.pn = (wgid % nig) / gsz; return true;
    }
    __device__ __forceinline__ void a_ready(const Unit&) const {}
    __device__ __forceinline__ void done(const Unit&) const {}
};

__device__ __forceinline__ float act_fn(float v, int act) {
    if (act == 1) { const float r = fmaxf(v, 0.f); return r * r; }
    if (act == 2) { const float u = 0.7978845608028654f * (v + 0.044715f * v * v * v); return v * __builtin_amdgcn_rcpf(1.f + __expf(-2.f * u)); }
    return v;
}
struct EpiStore {
    static constexpr bool PERM = true, AFTER_DRAIN = false;
    bf16_t* O; int ldc; int act; int fold; int qcols; int mode;
    __device__ __forceinline__ void operator()(const f32x4 (&acc)[2][2][4][2], const Unit& u, int wr, int wc, int fr, int fq) const {
        const int row0 = u.pm * BM + wr * 64 + fr; const int colt = fold ? 0 : u.pn * BM; const int cw = wc * 32 + 8 * fq;
        const float qs = (u.pn * BM < qcols) ? 0.18033688011112042f : 1.0f;
        const int b = (u.pm * BM) / T, t0 = (u.pm * BM) % T + wr * 64 + fr;
        size_t base[2]; size_t rstride;
        if (mode == 1 && colt >= 1024) {
            if (colt < 2048) { rstride = 64;
#pragma unroll
                for (int bj = 0; bj < 2; ++bj) { const int hd = (colt - 1024) / 128 + bj; base[bj] = (size_t)M * 1024 + ((size_t)((b * 8 + hd) * 2 + (cw >> 6)) * T + t0) * 64 + (cw & 63); } }
            else { rstride = 128;
#pragma unroll
                for (int bj = 0; bj < 2; ++bj) { const int hd = (colt - 2048) / 128 + bj; base[bj] = (size_t)2 * M * 1024 + ((size_t)(b * 8 + hd) * T + t0) * 128 + cw; } }
        } else if (mode == 2) { rstride = 64;
#pragma unroll
            for (int bj = 0; bj < 2; ++bj) { const int c2 = bj * 128 + cw; base[bj] = ((size_t)((u.pn * 8 + b) * 4 + (c2 >> 6)) * T + t0) * 64 + (c2 & 63); }
        } else { rstride = (size_t)ldc;
#pragma unroll
            for (int bj = 0; bj < 2; ++bj) base[bj] = (size_t)row0 * ldc + colt + cw + bj * HALF;
        }
#pragma unroll
        for (int ai = 0; ai < 2; ++ai)
#pragma unroll
            for (int m = 0; m < 4; ++m) { const size_t ro = (size_t)(ai * HALF + m * 16) * rstride;
#pragma unroll
                for (int bj = 0; bj < 2; ++bj) { f32x4 v0 = acc[ai][bj][m][0], v1 = acc[ai][bj][m][1];
                    if (act) {
#pragma unroll
                        for (int e = 0; e < 4; ++e) { v0[e] = act_fn(v0[e], act); v1[e] = act_fn(v1[e], act); } }
                    v0 = v0 * qs; v1 = v1 * qs;
                    u32x4 w; w.x = cvtpk(v0[0], v0[1]); w.y = cvtpk(v0[2], v0[3]); w.z = cvtpk(v1[0], v1[1]); w.w = cvtpk(v1[2], v1[3]);
                    *(u32x4*)(O + base[bj] + ro) = w; } }
    }
};
struct EpiResid {
    static constexpr bool PERM = false, AFTER_DRAIN = false;
    const float* base; float* out; const float* gate; int row_off;
    __device__ __forceinline__ void operator()(const f32x4 (&acc)[2][2][4][2], const Unit& u, int wr, int wc, int fr, int fq) const {
        const int rt = row_off + u.pm * BM; const int b = rt / T; const int row0 = rt + wr * 64 + fr; const int col0 = u.pn * BM + wc * 32 + 4 * fq;
        f32x4 gv[2][2];
#pragma unroll
        for (int bj = 0; bj < 2; ++bj)
#pragma unroll
            for (int n = 0; n < 2; ++n) gv[bj][n] = *(const f32x4*)(gate + (size_t)b * 6144 + col0 + bj * HALF + n * 16);
#pragma unroll
        for (int aim = 0; aim < 4; ++aim) { const int ai = aim >> 1, m0 = (aim & 1) * 2;
            f32x4 xin[2][2][2];
#pragma unroll
            for (int mm = 0; mm < 2; ++mm) { const size_t off = (size_t)(row0 + ai * HALF + (m0 + mm) * 16) * D + col0;
#pragma unroll
                for (int bj = 0; bj < 2; ++bj)
#pragma unroll
                    for (int n = 0; n < 2; ++n) xin[mm][bj][n] = *(const f32x4*)(base + off + bj * HALF + n * 16); }
            asm volatile("" ::: "memory");
#pragma unroll
            for (int mm = 0; mm < 2; ++mm) { const int m = m0 + mm; const size_t off = (size_t)(row0 + ai * HALF + m * 16) * D + col0;
#pragma unroll
                for (int bj = 0; bj < 2; ++bj)
#pragma unroll
                    for (int n = 0; n < 2; ++n) *(f32x4*)(out + off + bj * HALF + n * 16) = xin[mm][bj][n] + gv[bj][n] * acc[ai][bj][m][n]; }
            asm volatile("" ::: "memory");
        }
    }
};

template <class Epi, class SchedT, bool ALIGN_EPI = false, bool SP2 = false>
__device__ __forceinline__ void gemm_phase(PG8_LAS unsigned char* lds, const Gemm g, const SchedT& S, const Epi& E) {
    int tid_ = threadIdx.x; asm volatile("" : "+v"(tid_));
    const int tid = tid_, wid = __builtin_amdgcn_readfirstlane(tid >> 6), lane = tid & 63, wr = wid >> 2, wc = wid & 3, fr = lane & 15, fq = lane >> 4;
    const int K = g.K, nt = K / BK;
    unsigned voffA[2], voffB[2];
#pragma unroll
    for (int i = 0; i < 2; ++i) { int R, C; stage_rc(tid * 16 + i * 8192, R, C); const int Rb = Epi::PERM ? ((R & ~31) + perm32(R & 31)) : R;
        voffA[i] = (unsigned)(R * K + C) * 2u; voffB[i] = (unsigned)(Rb * K + C) * 2u; }
    const size_t kstep = (size_t)(BK * 2);
    const size_t hstep = (size_t)HALF * K * 2;
    const size_t tstep = 2 * hstep;
    const unsigned ldsw = (unsigned)wid * 1024u;
    const int aoff = lds_byte(wr * 64 + fr, fq * 8), boff = lds_byte(wc * 32 + fr, fq * 8);
#define PG8_SA(b, h) (((b) * 2 + (h)) * HTB)
#define PG8_SB(b, h) ((4 + (b) * 2 + (h)) * HTB)
#define PG8_STAGE(bufoff, gbase, voff) do { _Pragma("unroll") for (int _i = 0; _i < 2; ++_i) \
        __builtin_amdgcn_global_load_lds((const unsigned*)((const char*)(gbase) + (voff)[_i]), (PG8_LAS unsigned*)(lds + (bufoff) + ldsw + _i * 8192), 16, 0, 0); } while (0)
#define PG8_LDA(dst, b, h) do { _Pragma("unroll") for (int m = 0; m < 4; ++m) _Pragma("unroll") for (int k = 0; k < 2; ++k) dst[m][k] = *(const PG8_LAS bf16x8*)(lds + PG8_SA(b, h) + aoff + m * 2048 + k * 1024); } while (0)
#define PG8_LDB(dst, b, h) do { _Pragma("unroll") for (int n = 0; n < 2; ++n) _Pragma("unroll") for (int k = 0; k < 2; ++k) dst[n][k] = *(const PG8_LAS bf16x8*)(lds + PG8_SB(b, h) + boff + n * 2048 + k * 1024); } while (0)
#define PG8_MMA(ai, bj, At, Bt) do { __builtin_amdgcn_s_setprio(1); _Pragma("unroll") for (int m = 0; m < 4; ++m) _Pragma("unroll") for (int n = 0; n < 2; ++n) _Pragma("unroll") for (int k = 0; k < 2; ++k) \
        acc[ai][bj][m][n] = __builtin_amdgcn_mfma_f32_16x16x32_bf16(Bt[n][k], At[m][k], acc[ai][bj][m][n], 0, 0, 0); __builtin_amdgcn_s_setprio(0); } while (0)
#define PG8_WAIT_V(n) asm volatile("s_waitcnt vmcnt(" #n ")" ::: "memory")
#define PG8_WAIT_L(n) asm volatile("s_waitcnt lgkmcnt(" #n ")" ::: "memory")
#define PG8_BAR __builtin_amdgcn_s_barrier()
#define PG8_SCHED __builtin_amdgcn_sched_barrier(0)
    Unit cur, nxt; int ui = 0;
    if (!S.next(0, cur)) return;
    f32x4 acc[2][2][4][2];
#pragma unroll
    for (int a = 0; a < 2; ++a)
#pragma unroll
        for (int b = 0; b < 2; ++b)
#pragma unroll
            for (int m = 0; m < 4; ++m)
#pragma unroll
                for (int n = 0; n < 2; ++n) acc[a][b][m][n] = (f32x4){0.f, 0.f, 0.f, 0.f};
    bf16x8 At[4][2], B0[2][2], B1[2][2];
    const char* cA = (const char*)g.A + (size_t)cur.pm * tstep; const char* cB = (const char*)g.Bt + (size_t)cur.pn * tstep;
    S.a_ready(cur);
    if constexpr (SP2) {
        PG8_STAGE(PG8_SB(0, 0), cB, voffB); PG8_STAGE(PG8_SB(0, 1), cB + hstep, voffB); PG8_STAGE(PG8_SA(0, 0), cA, voffA); PG8_STAGE(PG8_SA(0, 1), cA + hstep, voffA);
        if (wr == 1) PG8_BAR;
        PG8_WAIT_V(2); PG8_BAR;
        PG8_STAGE(PG8_SB(1, 0), cB + kstep, voffB); PG8_STAGE(PG8_SA(1, 0), cA + kstep, voffA); PG8_STAGE(PG8_SB(1, 1), cB + hstep + kstep, voffB);
        PG8_WAIT_V(6); PG8_BAR;
    } else {
        PG8_STAGE(PG8_SB(0, 0), cB, voffB); PG8_STAGE(PG8_SA(0, 0), cA, voffA); PG8_STAGE(PG8_SB(0, 1), cB + hstep, voffB); PG8_STAGE(PG8_SA(0, 1), cA + hstep, voffA);
        if (wr == 1) PG8_BAR;
        PG8_WAIT_V(4); PG8_BAR;
        PG8_STAGE(PG8_SB(1, 0), cB + kstep, voffB); PG8_STAGE(PG8_SA(1, 0), cA + kstep, voffA); PG8_STAGE(PG8_SB(1, 1), cB + hstep + kstep, voffB);
        PG8_WAIT_V(6); PG8_BAR;
    }
    for (;;) {
        const bool has_next = S.next(ui + 1, nxt);
        const char* nA = has_next ? (const char*)g.A + (size_t)nxt.pm * tstep : cA; const char* nB = has_next ? (const char*)g.Bt + (size_t)nxt.pn * tstep : cB;
        for (int t = 0; t < nt; t += 2) {
            const bool last = (t == nt - 2);
            const char* a1 = cA + (size_t)(t + 1) * kstep;
            const char* a2 = last ? nA : cA + (size_t)(t + 2) * kstep; const char* b2 = last ? nB : cB + (size_t)(t + 2) * kstep;
            const char* a3 = a2 + kstep; const char* b3 = b2 + kstep;
            if (last && has_next) S.a_ready(nxt);
            if constexpr (SP2) {
            PG8_LDB(B0, 0, 0); PG8_LDB(B1, 0, 1); PG8_SCHED; PG8_LDA(At, 0, 0); PG8_STAGE(PG8_SA(1, 1), a1 + hstep, voffA);
            PG8_WAIT_V(8); PG8_WAIT_L(0); PG8_BAR; PG8_MMA(0, 0, At, B0); PG8_MMA(0, 1, At, B1); PG8_BAR; PG8_SCHED;
            PG8_LDA(At, 0, 1); PG8_STAGE(PG8_SB(0, 0), b2, voffB); PG8_STAGE(PG8_SB(0, 1), b2 + hstep, voffB); PG8_STAGE(PG8_SA(0, 0), a2, voffA);
            PG8_WAIT_V(8); PG8_WAIT_L(0); PG8_BAR; PG8_MMA(1, 0, At, B0); PG8_MMA(1, 1, At, B1); PG8_BAR; PG8_SCHED;
            PG8_LDB(B0, 1, 0); PG8_LDB(B1, 1, 1); PG8_SCHED; PG8_LDA(At, 1, 0); PG8_STAGE(PG8_SA(0, 1), a2 + hstep, voffA);
            PG8_WAIT_V(8); PG8_WAIT_L(0); PG8_BAR; PG8_MMA(0, 0, At, B0); PG8_MMA(0, 1, At, B1); PG8_BAR; PG8_SCHED;
            PG8_LDA(At, 1, 1); PG8_STAGE(PG8_SB(1, 0), b3, voffB); PG8_STAGE(PG8_SB(1, 1), b3 + hstep, voffB); PG8_STAGE(PG8_SA(1, 0), a3, voffA);
            PG8_WAIT_V(8); PG8_WAIT_L(0); PG8_BAR; PG8_MMA(1, 0, At, B0); PG8_MMA(1, 1, At, B1); PG8_BAR; PG8_SCHED;
            } else {
            PG8_LDB(B0, 0, 0); PG8_SCHED; PG8_LDA(At, 0, 0); PG8_STAGE(PG8_SA(1, 1), a1 + hstep, voffA);
            PG8_WAIT_L(8); PG8_BAR; PG8_WAIT_L(0); PG8_MMA(0, 0, At, B0); PG8_BAR; PG8_SCHED;
            PG8_LDB(B1, 0, 1); PG8_STAGE(PG8_SB(0, 0), b2, voffB);
            PG8_BAR; PG8_WAIT_L(0); PG8_MMA(0, 1, At, B1); PG8_BAR;
            PG8_LDA(At, 0, 1); PG8_STAGE(PG8_SA(0, 0), a2, voffA);
            PG8_BAR; PG8_WAIT_L(0); PG8_MMA(1, 0, At, B0); PG8_BAR; PG8_SCHED;
            PG8_STAGE(PG8_SB(0, 1), b2 + hstep, voffB);
            PG8_WAIT_V(6); PG8_BAR; PG8_MMA(1, 1, At, B1); PG8_BAR;
            PG8_LDB(B0, 1, 0); PG8_SCHED; PG8_LDA(At, 1, 0); PG8_STAGE(PG8_SA(0, 1), a2 + hstep, voffA);
            PG8_WAIT_L(8); PG8_BAR; PG8_WAIT_L(0); PG8_MMA(0, 0, At, B0); PG8_BAR; PG8_SCHED;
            PG8_LDB(B1, 1, 1); PG8_STAGE(PG8_SB(1, 0), b3, voffB);
            PG8_BAR; PG8_WAIT_L(0); PG8_MMA(0, 1, At, B1); PG8_BAR;
            PG8_LDA(At, 1, 1); PG8_STAGE(PG8_SA(1, 0), a3, voffA);
            PG8_BAR; PG8_WAIT_L(0); PG8_MMA(1, 0, At, B0); PG8_BAR; PG8_SCHED;
            PG8_STAGE(PG8_SB(1, 1), b3 + hstep, voffB);
            PG8_WAIT_V(6); PG8_BAR; PG8_MMA(1, 1, At, B1); PG8_BAR;
            }
        }
        if constexpr (ALIGN_EPI) { if (wr == 0) PG8_BAR; }
        if constexpr (!Epi::AFTER_DRAIN) { E(acc, cur, wr, wc, fr, fq); S.done(cur); }
        if (!has_next) break;
#pragma unroll
        for (int a = 0; a < 2; ++a)
#pragma unroll
            for (int b = 0; b < 2; ++b)
#pragma unroll
                for (int m = 0; m < 4; ++m)
#pragma unroll
                    for (int n = 0; n < 2; ++n) acc[a][b][m][n] = (f32x4){0.f, 0.f, 0.f, 0.f};
        cur = nxt; cA = nA; cB = nB; ++ui;
        if constexpr (ALIGN_EPI) { if (wr == 1) PG8_BAR; }
    }
    PG8_WAIT_V(0);
    if constexpr (!ALIGN_EPI) { if (wr == 0) PG8_BAR; }
    PG8_BAR;
#undef PG8_SA
#undef PG8_SB
#undef PG8_STAGE
#undef PG8_LDA
#undef PG8_LDB
#undef PG8_MMA
#undef PG8_WAIT_V
#undef PG8_WAIT_L
#undef PG8_BAR
#undef PG8_SCHED
}
}

__device__ __forceinline__ float wave_sum(float v, int lane) {
#pragma unroll
    for (int o = 1; o < 64; o <<= 1) v += __builtin_bit_cast(float, __builtin_amdgcn_ds_bpermute((lane ^ o) << 2, __builtin_bit_cast(int, v)));
    return v;
}
__device__ __forceinline__ int t5_bucket(int n) { if (n < 16) return n; const int v = 16 + (int)(__log2f((float)n * 0.0625f) * (16.0f / 3.0f)); return v > 31 ? 31 : v; }
__device__ __forceinline__ unsigned f2bf(float f) { unsigned u = __builtin_bit_cast(unsigned, f); return (u + 0x7fffu + ((u >> 16) & 1u)) >> 16; }
__device__ __forceinline__ unsigned pk2(float lo, float hi) { return f2bf(lo) | (f2bf(hi) << 16); }

__device__ __forceinline__ void transpose_item(const float* W, int K, int Nsrc, bf16_t* WT, LAS float* scr, int item, int lane) {
    const int nblk = (Nsrc + 31) / 32, kb = item / nblk, nb = item % nblk, k0 = 64 * kb, n0 = 32 * nb;
    const int ncol = n0 + (lane & 31); const bool okc = ncol < Nsrc;
    float tv[32];
#pragma unroll
    for (int i = 0; i < 32; ++i) { const int kk = 2 * i + (lane >> 5); tv[i] = okc ? W[(size_t)(k0 + kk) * Nsrc + ncol] : 0.f; }
#pragma unroll
    for (int i = 0; i < 32; ++i) { const int kk = 2 * i + (lane >> 5); scr[kk * 33 + (lane & 31)] = tv[i]; }
    asm volatile("s_waitcnt lgkmcnt(0)" ::: "memory");
    const int c = lane & 7;
#pragma unroll
    for (int j = 0; j < 4; ++j) { const int n = (lane >> 3) + 8 * j; const LAS float* s = scr + (8 * c) * 33 + n;
        u32x4 o; o.x = pk2(s[0 * 33], s[1 * 33]); o.y = pk2(s[2 * 33], s[3 * 33]); o.z = pk2(s[4 * 33], s[5 * 33]); o.w = pk2(s[6 * 33], s[7 * 33]);
        *(u32x4*)(WT + (size_t)(n0 + n) * K + k0 + 8 * c) = o; }
    asm volatile("s_waitcnt lgkmcnt(0)" ::: "memory");
}

struct Params {
    const float* in[23];
    float* out;
    unsigned char* ws;
    int step_lo, step_hi;
};

constexpr int KP = 144;
constexpr int VP128 = 320, VP64 = 192;
constexpr int ATT_K0 = 0, ATT_V0 = 64 * KP, ATT_STAGE_DIFF = 64 * KP + 64 * VP128;
constexpr int ATT_STAGE_NSA = 64 * KP + 64 * VP64;
#define ATT_BT (4 * ATT_ST)
#define ATT_SEL (ATT_BT + 2048)
#define ATT_UM (ATT_SEL + 512)
#define ATT_IMP (ATT_UM + 64)
constexpr int LDS_BYTES = 139264;
constexpr int LDS_BARST = 139264 - 64;
static_assert(4 * 24576 + 2624 + 32768 <= LDS_BARST && 4 * 16384 + 2624 + 4 * 64 * 65 * 4 <= LDS_BARST && 2 * ATT_STAGE_NSA <= 4 * 16384, "attention LDS map");

__device__ __forceinline__ s16x4 vtr(LAS const char* p) { typedef short v4i16_t __attribute__((ext_vector_type(4))); return __builtin_bit_cast(s16x4, __builtin_amdgcn_ds_read_tr16_b64_v4i16((LAS v4i16_t*)p)); }

__device__ __forceinline__ float pair_max(float v) { float a = v, b = v; asm volatile("s_nop 1\n\tv_permlane32_swap_b32 %0, %1" : "+v"(a), "+v"(b)); return fmaxf(a, b); }
__device__ __forceinline__ float pair_sum(float v) { float a = v, b = v; asm volatile("s_nop 1\n\tv_permlane32_swap_b32 %0, %1" : "+v"(a), "+v"(b)); return a + b; }
__device__ __forceinline__ void qk_tile(f32x16& s0, f32x16& s1, const bf16x8 (&qf)[4], LAS const char* Kb, int lane) {
    LAS const char* kp = Kb + (lane & 31) * KP + (lane >> 5) * 16;
    f32x16 a = {}, b = {};
#pragma unroll
    for (int kk = 0; kk < 4; ++kk) {
        const bf16x8 k0 = *(LAS const bf16x8*)(kp + kk * 32);
        const bf16x8 k1 = *(LAS const bf16x8*)(kp + 32 * KP + kk * 32);
        a = __builtin_amdgcn_mfma_f32_32x32x16_bf16(k0, qf[kk], a, 0, 0, 0);
        b = __builtin_amdgcn_mfma_f32_32x32x16_bf16(k1, qf[kk], b, 0, 0, 0);
    }
    s0 = a; s1 = b;
}
__device__ __forceinline__ void qk_tile_lq(f32x16& s0, f32x16& s1, LAS const char* Qs, LAS const char* Kb, int lane) {
    LAS const char* kp = Kb + (lane & 31) * KP + (lane >> 5) * 16;
    f32x16 a = {}, b = {};
#pragma unroll
    for (int kk = 0; kk < 4; ++kk) {
        const bf16x8 q = *(LAS const bf16x8*)(Qs + kk * 1024 + lane * 16);
        const bf16x8 k0 = *(LAS const bf16x8*)(kp + kk * 32);
        const bf16x8 k1 = *(LAS const bf16x8*)(kp + 32 * KP + kk * 32);
        a = __builtin_amdgcn_mfma_f32_32x32x16_bf16(k0, q, a, 0, 0, 0);
        b = __builtin_amdgcn_mfma_f32_32x32x16_bf16(k1, q, b, 0, 0, 0);
    }
    s0 = a; s1 = b;
}
template <int DVB, int VP>
__device__ __forceinline__ void pv_tile(f32x16 (&o)[DVB], const bf16x8 (&P)[4], LAS const char* Vb, int lane) {
    const int i = lane & 15, gidx = lane >> 4, hh = gidx >> 1, dvh = gidx & 1;
    LAS const char* vp = Vb + (hh * 4 + (i >> 2)) * VP + (16 * dvh + 4 * (i & 3)) * 2;
    s16x4 lo[DVB], hi[DVB];
#pragma unroll
    for (int c = 0; c < DVB; ++c) { lo[c] = vtr(vp + c * 64); hi[c] = vtr(vp + 8 * VP + c * 64); }
#pragma unroll
    for (int ks = 0; ks < 4; ++ks) {
        s16x4 nlo[DVB], nhi[DVB];
        if (ks < 3) {
#pragma unroll
            for (int c = 0; c < DVB; ++c) { nlo[c] = vtr(vp + (16 * (ks + 1)) * VP + c * 64); nhi[c] = vtr(vp + (16 * (ks + 1) + 8) * VP + c * 64); }
        }
#pragma unroll
        for (int c = 0; c < DVB; ++c) {
            const bf16x8 a = (bf16x8){lo[c][0], lo[c][1], lo[c][2], lo[c][3], hi[c][0], hi[c][1], hi[c][2], hi[c][3]};
            o[c] = __builtin_amdgcn_mfma_f32_32x32x16_bf16(a, P[ks], o[c], 0, 0, 0);
        }
        __builtin_amdgcn_sched_barrier(0);
        if (ks < 3) {
#pragma unroll
            for (int c = 0; c < DVB; ++c) { lo[c] = nlo[c]; hi[c] = nhi[c]; }
        }
    }
}
template <bool BIAS>
__device__ __forceinline__ void score_elem(f32x16& s0, f32x16& s1, int base, int win, LAS const float* bt) {
#pragma unroll
    for (int i = 0; i < 16; ++i) {
        const int off = (i >> 2) * 8 + (i & 3);
        const int d0 = base - off, d1 = d0 - 32;
        float b0 = 0.f, b1 = 0.f;
        if (BIAS) { b0 = bt[min(max(d0, 0), 127)]; b1 = bt[min(max(d1, 0), 127)]; }
        s0[i] = ((unsigned)d0 < (unsigned)win) ? s0[i] + b0 : -INFINITY;
        s1[i] = ((unsigned)d1 < (unsigned)win) ? s1[i] + b1 : -INFINITY;
        if (BIAS && (i & 3) == 3) __builtin_amdgcn_sched_barrier(0);
    }
}
__device__ __forceinline__ float row_max32(const f32x16& s0, const f32x16& s1) {
    float a = fmaxf(s0[0], s1[0]);
#pragma unroll
    for (int i = 1; i < 16; ++i) a = fmaxf(a, fmaxf(s0[i], s1[i]));
    return pair_max(a);
}
template <int DVB>
__device__ __forceinline__ void softmax_step(f32x16& s0, f32x16& s1, float& m, float& l, f32x16 (&o)[DVB], bf16x8 (&P)[4], bool sel) {
    float mx = row_max32(s0, s1); mx = sel ? mx : -INFINITY;
    const float mn = fmaxf(m, mx);
    {
        const float a = __builtin_amdgcn_exp2f(m - mn); l *= a;
#pragma unroll
        for (int c = 0; c < DVB; ++c) o[c] *= a;
        m = mn;
    }
    const float ms = sel ? m : INFINITY;
    float sum = 0.f;
#pragma unroll
    for (int i = 0; i < 16; ++i) { s0[i] = __builtin_amdgcn_exp2f(s0[i] - ms); s1[i] = __builtin_amdgcn_exp2f(s1[i] - ms); sum += s0[i] + s1[i]; }
    l += sum;
    u32x4 w0 = {cvtpk(s0[0], s0[1]), cvtpk(s0[2], s0[3]), cvtpk(s0[4], s0[5]), cvtpk(s0[6], s0[7])};
    u32x4 w1 = {cvtpk(s0[8], s0[9]), cvtpk(s0[10], s0[11]), cvtpk(s0[12], s0[13]), cvtpk(s0[14], s0[15])};
    u32x4 w2 = {cvtpk(s1[0], s1[1]), cvtpk(s1[2], s1[3]), cvtpk(s1[4], s1[5]), cvtpk(s1[6], s1[7])};
    u32x4 w3 = {cvtpk(s1[8], s1[9]), cvtpk(s1[10], s1[11]), cvtpk(s1[12], s1[13]), cvtpk(s1[14], s1[15])};
    P[0] = __builtin_bit_cast(bf16x8, w0); P[1] = __builtin_bit_cast(bf16x8, w1); P[2] = __builtin_bit_cast(bf16x8, w2); P[3] = __builtin_bit_cast(bf16x8, w3);
}

__device__ __forceinline__ void glds16(const void* gsrc, unsigned lds_dst) { unsigned keep;
    asm volatile("s_mov_b32 %0, m0\n\ts_mov_b32 m0, %2\n\ts_nop 0\n\tglobal_load_lds_dwordx4 %1, off\n\ts_mov_b32 m0, %0" : "=&s"(keep) : "v"(gsrc), "s"(lds_dst) : "memory"); }
template <int VW>
__device__ __forceinline__ void dma_tile(LAS char* stage, const bf16_t* Kg, const bf16_t* Vg, size_t pitchK, size_t pitchV, int k0, int lane, int wid) {
    const bf16_t* kb = Kg + (size_t)k0 * pitchK; const bf16_t* vb = Vg + (size_t)k0 * pitchV;
    const unsigned sb = (unsigned)__builtin_amdgcn_readfirstlane((int)(unsigned)(uintptr_t)stage);
    { const int r = 8 * wid + (lane >> 3), c = (lane & 7) ^ ((r >> 1) & 7);
      glds16(kb + (unsigned)(r * (unsigned)pitchK + c * 8), sb + wid * 1024); }
    if (VW == 2) {
#pragma unroll
        for (int h = 0; h < 2; ++h) { const int pc = 2 * wid + h, r = 4 * pc + (lane >> 4), c = (lane & 15) ^ ((r & 3) << 2);
            glds16(vb + (unsigned)(r * (unsigned)pitchV + c * 8), sb + 8192 + pc * 1024); }
    } else {
        const int r = 8 * wid + (lane >> 3), c = (lane & 7) ^ (((r >> 1) & 1) << 2);
        glds16(vb + (unsigned)(r * (unsigned)pitchV + c * 8), sb + 8192 + wid * 1024);
    }
}
template <bool QREG>
__device__ __forceinline__ void qk_tile_sw(f32x16& s0, f32x16& s1, const bf16x8* qf, LAS const char* Qs, LAS const char* Kb, int lane) {
    const int r = lane & 31, hh = lane >> 5, sw = (r >> 1) & 7;
    LAS const char* kp = Kb + r * 128 + ((hh ^ (sw & 1)) << 4); const int t = sw >> 1;
    f32x16 a = {}, b = {};
#pragma unroll
    for (int kk = 0; kk < 4; ++kk) {
        const bf16x8 q = QREG ? qf[kk] : *(LAS const bf16x8*)(Qs + kk * 1024 + lane * 16);
        const bf16x8 k0 = *(LAS const bf16x8*)(kp + ((kk ^ t) << 5));
        const bf16x8 k1 = *(LAS const bf16x8*)(kp + ((kk ^ t) << 5) + 32 * 128);
        a = __builtin_amdgcn_mfma_f32_32x32x16_bf16(k0, q, a, 0, 0, 0);
        b = __builtin_amdgcn_mfma_f32_32x32x16_bf16(k1, q, b, 0, 0, 0);
    }
    s0 = a; s1 = b;
}
template <int DVB, int ROWB>
__device__ __forceinline__ void pv_tile_sw(f32x16 (&o)[DVB], const bf16x8 (&P)[4], LAS const char* Vb, int lane) {
    const int i = lane & 15, gidx = lane >> 4, hh = gidx >> 1, dvh = gidx & 1;
    const int q = ROWB == 256 ? ((i >> 2) & 3) : ((i >> 3) & 1);
    LAS const char* vp = Vb + (4 * hh + (i >> 2)) * ROWB + dvh * 32 + ((i & 3) >> 1) * 16 + (i & 1) * 8;
    s16x4 lo[DVB], hi[DVB];
#pragma unroll
    for (int c = 0; c < DVB; ++c) { lo[c] = vtr(vp + ((c ^ q) << 6)); hi[c] = vtr(vp + ((c ^ q) << 6) + 8 * ROWB); }
#pragma unroll
    for (int ks = 0; ks < 4; ++ks) {
        s16x4 nlo[DVB], nhi[DVB];
        if (ks < 3) {
#pragma unroll
            for (int c = 0; c < DVB; ++c) { nlo[c] = vtr(vp + ((c ^ q) << 6) + (16 * (ks + 1)) * ROWB); nhi[c] = vtr(vp + ((c ^ q) << 6) + (16 * (ks + 1) + 8) * ROWB); }
        }
#pragma unroll
        for (int c = 0; c < DVB; ++c) {
            const bf16x8 a = (bf16x8){lo[c][0], lo[c][1], lo[c][2], lo[c][3], hi[c][0], hi[c][1], hi[c][2], hi[c][3]};
            o[c] = __builtin_amdgcn_mfma_f32_32x32x16_bf16(a, P[ks], o[c], 0, 0, 0);
        }
        __builtin_amdgcn_sched_barrier(0);
        if (ks < 3) {
#pragma unroll
            for (int c = 0; c < DVB; ++c) { lo[c] = nlo[c]; hi[c] = nhi[c]; }
        }
    }
}

template <int VW> struct TileRegs { u32x4 k; u32x4 v[VW]; };
template <int VW>
__device__ __forceinline__ void tile_issue(TileRegs<VW>& r, const bf16_t* Kg, const bf16_t* Vg, size_t pitchK, size_t pitchV, int k0, int tid) {
    const bf16_t* kb = Kg + (size_t)k0 * pitchK;
    const bf16_t* vb = Vg + (size_t)k0 * pitchV;
    r.k = *(const u32x4*)(kb + (unsigned)((tid >> 3) * (unsigned)pitchK + (tid & 7) * 8));
    if (VW == 2) {
#pragma unroll
        for (int i = 0; i < 2; ++i) { const int idx = tid + 512 * i; r.v[i] = *(const u32x4*)(vb + (unsigned)((idx >> 4) * (unsigned)pitchV + (idx & 15) * 8)); }
    } else r.v[0] = *(const u32x4*)(vb + (unsigned)((tid >> 3) * (unsigned)pitchV + (tid & 7) * 8));
}
template <int VW>
__device__ __forceinline__ void tile_commit(const TileRegs<VW>& r, LAS char* st, int tid) {
    *(LAS u32x4*)(st + ATT_K0 + (tid >> 3) * KP + (tid & 7) * 16) = r.k;
    if (VW == 2) {
#pragma unroll
        for (int i = 0; i < 2; ++i) { const int idx = tid + 512 * i; *(LAS u32x4*)(st + ATT_V0 + (idx >> 4) * VP128 + (idx & 15) * 16) = r.v[i]; }
    } else *(LAS u32x4*)(st + ATT_V0 + (tid >> 3) * VP64 + (tid & 7) * 16) = r.v[0];
}
#define TILE_LOOP_BEGIN(VW, UMASK, KG, VG, PK, PV) { \
    unsigned long long rem_ = (UMASK); int cur_ = __builtin_ctzll(rem_); rem_ &= rem_ - 1ull; int bufi_ = 0; \
    TileRegs<VW> tr_; tile_issue<VW>(tr_, KG, VG, PK, PV, cur_ * 64, tid); tile_commit<VW>(tr_, lds, tid); __syncthreads(); \
    for (;;) { const int nxt_ = rem_ ? __builtin_ctzll(rem_) : -1; if (rem_) rem_ &= rem_ - 1ull; \
        if (nxt_ >= 0) tile_issue<VW>(tr_, KG, VG, PK, PV, nxt_ * 64, tid); \
        { const int kt = cur_; LAS char* st = lds + bufi_ * ATT_STP;
#define TILE_LOOP_END(VW) } \
        if (nxt_ >= 0) tile_commit<VW>(tr_, lds + (bufi_ ^ 1) * ATT_STP, tid); \
        __syncthreads(); if (nxt_ < 0) break; cur_ = nxt_; bufi_ ^= 1; } }

#define PP_BAR() do { asm volatile("s_waitcnt lgkmcnt(0)" ::: "memory"); __builtin_amdgcn_s_barrier(); asm volatile("" ::: "memory"); } while (0)
#define PP_NEXT(t) do { if (rem_) { t = __builtin_ctzll(rem_); rem_ &= rem_ - 1ull; } else t = -1; } while (0)
#define PP_WAITV(NI, c2, c3) do { if ((c2) && (c3)) { if (NI == 3) asm volatile("s_waitcnt vmcnt(6)" ::: "memory"); else asm volatile("s_waitcnt vmcnt(4)" ::: "memory"); } \
    else if ((c2) || (c3)) { if (NI == 3) asm volatile("s_waitcnt vmcnt(3)" ::: "memory"); else asm volatile("s_waitcnt vmcnt(2)" ::: "memory"); } \
    else asm volatile("s_waitcnt vmcnt(0)" ::: "memory"); } while (0)
#define PP_BEGIN(VW, NI, UMASK, KG, VG, PK, PV) { \
    unsigned long long rem_ = (UMASK); int ta_, tb_, tc_, td_ = -1; PP_NEXT(ta_); PP_NEXT(tb_); PP_NEXT(tc_); int sj_ = 0; \
    dma_tile<VW>(lds, KG, VG, PK, PV, ta_ * 64, lane, wid); \
    if (tb_ >= 0) dma_tile<VW>(lds + ATT_ST, KG, VG, PK, PV, tb_ * 64, lane, wid); \
    if (tc_ >= 0) dma_tile<VW>(lds + 2 * ATT_ST, KG, VG, PK, PV, tc_ * 64, lane, wid); \
    PP_WAITV(NI, tb_ >= 0, tc_ >= 0); PP_BAR(); \
    for (;;) { const int kt = ta_; LAS char* st = lds + sj_ * ATT_ST; \
        if (false) { PP_NEXT(td_); if (td_ >= 0) dma_tile<VW>(lds + ((sj_ + 3) & 3) * ATT_ST, KG, VG, PK, PV, td_ * 64, lane, wid); } {
#define PP_MID(VW, NI, KG, VG, PK, PV) } \
        if (true) { PP_NEXT(td_); if (td_ >= 0) dma_tile<VW>(lds + ((sj_ + 3) & 3) * ATT_ST, KG, VG, PK, PV, td_ * 64, lane, wid); } {
#define PP_END(NI) } if (true) PP_WAITV(NI, tc_ >= 0, td_ >= 0); PP_BAR(); \
        if (tb_ < 0) break; ta_ = tb_; tb_ = tc_; tc_ = td_; td_ = -1; sj_ = (sj_ + 1) & 3; } \
    }

__device__ __forceinline__ void diff_attn_phase(LAS char* lds, const bf16_t* QKV, bf16_t* O, const float* rel_bias, const float* lam_p, const float* subln, int layer, float* stash, int G, int c) {
    constexpr int ATT_ST = 24576;
    int tid_ = threadIdx.x; asm volatile("" : "+v"(tid_));
    const int tid = tid_, lane = tid & 63, wid = __builtin_amdgcn_readfirstlane(tid >> 6), r32 = lane & 31, hh = lane >> 5;
    if (wid >= 4) __builtin_amdgcn_s_setprio(1);
    float s1 = 0.f, s2 = 0.f;
    for (int i = 0; i < 64; ++i) { s1 += lam_p[i] * lam_p[64 + i]; s2 += lam_p[128 + i] * lam_p[192 + i]; }
    const float lam_init = 0.8f - 0.6f * expf(-0.3f * (float)layer);
    const float lam = expf(s1) - expf(s2) + lam_init;
    LAS float* bt = (LAS float*)(lds + ATT_BT);
    size_t pq_ = 64, pv2_ = 128; asm volatile("" : "+s"(pq_), "+s"(pv2_));
    f32x4* mystash = (f32x4*)stash + (size_t)(wid * 64 + lane) * 16;
    for (int it = 0;; ++it) {
        int bh, qb;
        if (G == 256) { if (it >= 4) break; const int j = c >> 6; bh = c & 63; qb = it == 0 ? 15 - j : it == 1 ? 8 + j : it == 2 ? 7 - j : j; }
        else { const int id = it * G + c; if (id >= 1024) break; bh = id & 63; qb = 15 - (id >> 6); }
        const int b = bh >> 3, h = bh & 7, q0 = qb * 256; const size_t rowbase = (size_t)b * T;
        const int qw = q0 + wid * 32, qpos = qw + r32;
        const int NT = (q0 + 256) / 64;
        const unsigned long long um = NT >= 64 ? ~0ull : ((1ull << NT) - 1ull);
        for (int mp = 0; mp < 2; ++mp) {
            if (tid < 128) bt[tid] = (rel_bias[t5_bucket(tid) * 16 + h * 2 + mp] - rel_bias[31 * 16 + h * 2 + mp]) * LOG2E;
            LAS char* Qs = lds + ATT_IMP + wid * 4096;
            { const bf16_t* qp = QKV + (rowbase + qpos) * 1024 + h * 128 + mp * 64 + hh * 8;
#pragma unroll
              for (int kk = 0; kk < 4; ++kk) *(LAS bf16x8*)(Qs + kk * 1024 + lane * 16) = *(const bf16x8*)(qp + kk * 16); }
            f32x16 o[4]; o[0] = f32x16{}; o[1] = f32x16{}; o[2] = f32x16{}; o[3] = f32x16{};
            float m = -1e30f, l = 0.f;
            const bf16_t* Kg = QKV + (size_t)M * 1024 + (size_t)((b * 8 + h) * 2 + mp) * T * 64;
            const bf16_t* Vg = QKV + (size_t)2 * M * 1024 + (size_t)(b * 8 + h) * T * 128;
            bf16x8 P[4];
            PP_BEGIN(2, 3, um, Kg, Vg, pq_, pv2_)
                const int k0 = kt * 64;
                if (k0 <= qw + 31) {
                    f32x16 sa, sb; qk_tile_sw<false>(sa, sb, nullptr, Qs, st, lane);
                    if (qw - (k0 + 63) < 113) score_elem<true>(sa, sb, qpos - k0 - hh * 4, 1 << 30, bt);
                    softmax_step<4>(sa, sb, m, l, o, P, true);
                    pv_tile_sw<4, 256>(o, P, st + 8192, lane);
                }
            PP_MID(2, 3, Kg, Vg, pq_, pv2_)
            PP_END(3)
            const float lt = pair_sum(l); const float inv = __builtin_amdgcn_rcpf(lt);
            if (mp == 0) {
#pragma unroll
                for (int cc = 0; cc < 4; ++cc)
#pragma unroll
                    for (int g4 = 0; g4 < 4; ++g4) mystash[cc * 4 + g4] = (f32x4){o[cc][g4 * 4] * inv, o[cc][g4 * 4 + 1] * inv, o[cc][g4 * 4 + 2] * inv, o[cc][g4 * 4 + 3] * inv};
            } else {
                float ss = 0.f;
#pragma unroll
                for (int cc = 0; cc < 4; ++cc)
#pragma unroll
                    for (int g4 = 0; g4 < 4; ++g4) { const f32x4 a = mystash[cc * 4 + g4];
#pragma unroll
                        for (int e = 0; e < 4; ++e) { const float v = a[e] - lam * (o[cc][g4 * 4 + e] * inv); o[cc][g4 * 4 + e] = v; ss += v * v; }
                        if (g4 == 3) __builtin_amdgcn_sched_barrier(0); }
                ss = pair_sum(ss);
                const float rs = rsqrtf(ss * (1.f / 128.f) + NORM_EPS) * (1.f - lam_init);
                bf16_t* op = O + (rowbase + qpos) * D + h * 128 + hh * 4;
#pragma unroll
                for (int cc = 0; cc < 4; ++cc)
#pragma unroll
                    for (int g4 = 0; g4 < 4; ++g4) { const int dv = cc * 32 + g4 * 8; const f32x4 sg = *(const f32x4*)(subln + dv + hh * 4);
                        u32x2 w; w.x = cvtpk(o[cc][g4 * 4] * rs * sg[0], o[cc][g4 * 4 + 1] * rs * sg[1]); w.y = cvtpk(o[cc][g4 * 4 + 2] * rs * sg[2], o[cc][g4 * 4 + 3] * rs * sg[3]);
                        *(u32x2*)(op + dv) = w; if (g4 == 3) __builtin_amdgcn_sched_barrier(0); }
            }
        }
    }
    __builtin_amdgcn_s_setprio(0);
}

__device__ __forceinline__ void nsa_phase(LAS char* lds, const bf16_t* PROJ, const bf16_t* KVB, const bf16_t* CMP, bf16_t* O, const float* rel_bias, int G, int c) {
    constexpr int ATT_ST = 16384, ATT_STP = ATT_STAGE_NSA;
    int tid_ = threadIdx.x; asm volatile("" : "+v"(tid_));
    const int tid0_ = tid_; const int tid = tid_, lane = tid & 63, wid = __builtin_amdgcn_readfirstlane(tid >> 6), r32 = lane & 31, hh = lane >> 5;
    const int r = wid & 3, qh = wid >> 2;
    if (wid >= 4) __builtin_amdgcn_s_setprio(1);
    LAS float* btall = (LAS float*)(lds + ATT_BT);
    size_t pkv_ = 64, pc_ = 64; asm volatile("" : "+s"(pkv_), "+s"(pc_));
    LAS float* bt = btall + r * 128;
    LAS unsigned long long* SEL = (LAS unsigned long long*)(lds + ATT_SEL);
    LAS unsigned* UM = (LAS unsigned*)(lds + ATT_UM);
    LAS float* IMP = (LAS float*)(lds + ATT_IMP);
    for (int it = 0;; ++it) {
        int bg, qblk;
        if (G == 256) { if (it >= 8) break; const int j = c >> 5; bg = c & 31; qblk = (it & 1) ? (56 - 8 * it + j) : (63 - 8 * it - j); }
        else { const int id = it * G + c; if (id >= 2048) break; bg = id & 31; qblk = 63 - (id >> 5); }
        const int b = bg >> 2, g = bg & 3, t0 = qblk * 64, hq = g * 4 + r; const size_t rowbase = (size_t)b * T;
        const int qw = t0 + qh * 32, qpos = qw + r32;
        btall[tid] = (rel_bias[t5_bucket(tid & 127) * 16 + g * 4 + (tid >> 7)] - rel_bias[31 * 16 + g * 4 + (tid >> 7)]) * LOG2E;
        LAS float* impr = IMP + (r * 64 + qh * 32 + r32) * 65;
        for (int jj = 0; jj < 33; ++jj) { const int idx = 2 * jj + hh; if (idx < 65) impr[idx] = 0.f; }
        if (tid < 2) UM[tid] = 0u;
        bf16x8 qf[4]; float gate[3];
        { const bf16_t* pp = PROJ + (rowbase + qpos) * NBINP;
#pragma unroll
          for (int kk = 0; kk < 4; ++kk) qf[kk] = *(const bf16x8*)(pp + hq * 64 + kk * 16 + hh * 8);
#pragma unroll
          for (int e = 0; e < 3; ++e) gate[e] = __builtin_amdgcn_rcpf(1.f + __expf(-bf2f(pp[1024 + hq * 3 + e]))); }
        f32x16 ot[2]; ot[0] = f32x16{}; ot[1] = f32x16{};
        const int nmaxb = (t0 + 32) >> 4; const int nct = min(4, (nmaxb >> 6) + 1);
        const unsigned long long umc = (1ull << nct) - 1ull;
        const bf16_t* Kc = CMP + (size_t)((0 * 8 + b) * 4 + g) * 256 * 64;
        const bf16_t* Vc = CMP + (size_t)((1 * 8 + b) * 4 + g) * 256 * 64;
        const int nlim = min((qpos - 31) >> 4, 254);
        float mc = -1e30f, lc = 0.f;
        { int tid = tid0_; asm volatile("" : "+v"(tid)); const int lane = tid & 63, r32 = lane & 31, hh = lane >> 5; (void)r32; (void)hh;
        TILE_LOOP_BEGIN(1, umc, Kc, Vc, pc_, pc_)
            f32x16 sa, sb; qk_tile(sa, sb, qf, st + ATT_K0, lane);
            score_elem<false>(sa, sb, nlim - kt * 64 - hh * 4, 1 << 30, bt);
            const float mx = row_max32(sa, sb); const float mn = fmaxf(mc, mx);
            lc *= __builtin_amdgcn_exp2f(mc - mn); mc = mn;
            float sum = 0.f;
#pragma unroll
            for (int i = 0; i < 16; ++i) sum += __builtin_amdgcn_exp2f(sa[i] - mc) + __builtin_amdgcn_exp2f(sb[i] - mc);
            lc += sum;
        TILE_LOOP_END(1) }
        {
            const float lt = pair_sum(lc); const float invl = lt > 0.f ? __builtin_amdgcn_rcpf(lt) : 0.f;
            f32x16 oc[2]; oc[0] = f32x16{}; oc[1] = f32x16{};
            int tid = tid0_; asm volatile("" : "+v"(tid)); const int lane = tid & 63, r32 = lane & 31, hh = lane >> 5; (void)r32; (void)hh;
            LAS float* impr = IMP + (r * 64 + qh * 32 + r32) * 65;
            TILE_LOOP_BEGIN(1, umc, Kc, Vc, pc_, pc_)
                f32x16 sa, sb; qk_tile(sa, sb, qf, st + ATT_K0, lane);
                score_elem<false>(sa, sb, nlim - kt * 64 - hh * 4, 1 << 30, bt);
#pragma unroll
                for (int i = 0; i < 16; ++i) { sa[i] = __builtin_amdgcn_exp2f(sa[i] - mc) * invl; sb[i] = __builtin_amdgcn_exp2f(sb[i] - mc) * invl; }
#pragma unroll
                for (int kb = 0; kb < 2; ++kb)
#pragma unroll
                    for (int ig = 0; ig < 4; ++ig) { const int j = kt * 16 + kb * 8 + ig * 2 + hh;
                        const float g4 = kb ? ((sb[ig * 4] + sb[ig * 4 + 1]) + (sb[ig * 4 + 2] + sb[ig * 4 + 3])) : ((sa[ig * 4] + sa[ig * 4 + 1]) + (sa[ig * 4 + 2] + sa[ig * 4 + 3]));
                        impr[j] += g4; }
                asm volatile("s_waitcnt lgkmcnt(0)" ::: "memory");
#pragma unroll
                for (int kb = 0; kb < 2; ++kb)
#pragma unroll
                    for (int ig = 0; ig < 4; ++ig) { const int j = kt * 16 + kb * 8 + ig * 2 + hh;
                        impr[j + 1] += kb ? sb[ig * 4 + 3] : sa[ig * 4 + 3]; }
                asm volatile("s_waitcnt lgkmcnt(0)" ::: "memory");
                bf16x8 P[4];
                { u32x4 w0 = {cvtpk(sa[0], sa[1]), cvtpk(sa[2], sa[3]), cvtpk(sa[4], sa[5]), cvtpk(sa[6], sa[7])};
                  u32x4 w1 = {cvtpk(sa[8], sa[9]), cvtpk(sa[10], sa[11]), cvtpk(sa[12], sa[13]), cvtpk(sa[14], sa[15])};
                  u32x4 w2 = {cvtpk(sb[0], sb[1]), cvtpk(sb[2], sb[3]), cvtpk(sb[4], sb[5]), cvtpk(sb[6], sb[7])};
                  u32x4 w3 = {cvtpk(sb[8], sb[9]), cvtpk(sb[10], sb[11]), cvtpk(sb[12], sb[13]), cvtpk(sb[14], sb[15])};
                  P[0] = __builtin_bit_cast(bf16x8, w0); P[1] = __builtin_bit_cast(bf16x8, w1); P[2] = __builtin_bit_cast(bf16x8, w2); P[3] = __builtin_bit_cast(bf16x8, w3); }
                pv_tile<2, VP64>(oc, P, st + ATT_V0, lane);
            TILE_LOOP_END(1)
            ot[0] = oc[0] * gate[0]; ot[1] = oc[1] * gate[0];
        }
        {
            unsigned long long wun = 0ull;
            int tid = tid0_; asm volatile("" : "+v"(tid)); const int lane = tid & 63, r32 = lane & 31, hh = lane >> 5; (void)r32; (void)hh;
            if (qblk < 16) {
                const unsigned long long mk = (2ull << qblk) - 1ull;
                if (lane < 8) SEL[wid * 8 + lane] = mk;
                wun = mk;
            } else
#pragma unroll 1
            for (int k = 0; k < 8; ++k) {
                const int q = wid * 8 + k;
                float v = ((IMP[(0 * 64 + q) * 65 + lane] + IMP[(1 * 64 + q) * 65 + lane]) + IMP[(2 * 64 + q) * 65 + lane]) + IMP[(3 * 64 + q) * 65 + lane];
                if (lane == 0 || lane == qblk || lane == qblk - 1) v = 1e4f;
                if (lane > qblk) v = -1e30f;
                int rank = 0; const int vi = __builtin_bit_cast(int, v);
#pragma unroll 8
                for (int jj = 0; jj < 64; ++jj) { const float vj = __builtin_bit_cast(float, __builtin_amdgcn_readlane(vi, jj)); rank += (vj > v || (vj == v && jj < lane)) ? 1 : 0; }
                const unsigned long long mk = __builtin_amdgcn_ballot_w64(rank < 16 && lane <= qblk);
                if (lane == 0) SEL[q] = mk;
                wun |= mk;
            }
            if (lane == 0) { atomicOr((unsigned*)&UM[0], (unsigned)wun); atomicOr((unsigned*)&UM[1], (unsigned)(wun >> 32)); }
            __syncthreads();
        }
        {
            int tid = tid0_; asm volatile("" : "+v"(tid)); const int lane = tid & 63, r32 = lane & 31, hh = lane >> 5; (void)r32; (void)hh;
            const unsigned long long ums = (unsigned long long)UM[0] | ((unsigned long long)UM[1] << 32);
            const unsigned long long mysel = SEL[qh * 32 + r32];
            f32x16 o[2]; o[0] = f32x16{}; o[1] = f32x16{};
            float m = -1e30f, l = 0.f;
            const bf16_t* Kg = KVB + (size_t)((2 * 8 + b) * 4 + g) * T * 64;
            const bf16_t* Vg = KVB + (size_t)((3 * 8 + b) * 4 + g) * T * 64;
            bf16x8 P[4];
            PP_BEGIN(1, 2, ums, Kg, Vg, pkv_, pkv_)
                const bool sel = (mysel >> kt) & 1ull;
                const int k0 = kt * 64;
                f32x16 sa, sb; qk_tile_sw<true>(sa, sb, qf, nullptr, st, lane);
                if (qw - (k0 + 63) < 113) score_elem<true>(sa, sb, qpos - k0 - hh * 4, 1 << 30, bt);
                softmax_step<2>(sa, sb, m, l, o, P, sel);
            PP_MID(1, 2, Kg, Vg, pkv_, pkv_)
                pv_tile_sw<2, 128>(o, P, st + 8192, lane);
            PP_END(2)
            const float lt = pair_sum(l); const float sc = gate[1] * __builtin_amdgcn_rcpf(lt);
            ot[0] += o[0] * sc; ot[1] += o[1] * sc;
        }
        {
            int tid = tid0_; asm volatile("" : "+v"(tid)); const int lane = tid & 63, r32 = lane & 31, hh = lane >> 5; (void)r32; (void)hh;
            const int lo = max(0, qblk - 8);
            const unsigned long long hiM = qblk >= 63 ? ~0ull : ((1ull << (qblk + 1)) - 1ull);
            const unsigned long long umw = hiM & ~((1ull << lo) - 1ull);
            f32x16 o[2]; o[0] = f32x16{}; o[1] = f32x16{};
            float m = -1e30f, l = 0.f;
            const bf16_t* Kg = KVB + (size_t)((4 * 8 + b) * 4 + g) * T * 64;
            const bf16_t* Vg = KVB + (size_t)((5 * 8 + b) * 4 + g) * T * 64;
            bf16x8 P[4];
            PP_BEGIN(1, 2, umw, Kg, Vg, pkv_, pkv_)
                const int k0 = kt * 64;
                f32x16 sa, sb; qk_tile_sw<true>(sa, sb, qf, nullptr, st, lane);
                if (qw - (k0 + 63) < 113 || qw + 31 - k0 >= 512) score_elem<true>(sa, sb, qpos - k0 - hh * 4, 512, bt);
                softmax_step<2>(sa, sb, m, l, o, P, true);
            PP_MID(1, 2, Kg, Vg, pkv_, pkv_)
                pv_tile_sw<2, 128>(o, P, st + 8192, lane);
            PP_END(2)
            const float lt = pair_sum(l); const float sc = gate[2] * __builtin_amdgcn_rcpf(lt);
            ot[0] += o[0] * sc; ot[1] += o[1] * sc;
        }
        { int tid = tid0_; asm volatile("" : "+v"(tid)); const int lane = tid & 63, r32 = lane & 31, hh = lane >> 5; (void)r32; (void)hh;
          bf16_t* op = O + (rowbase + qpos) * D + hq * 64 + hh * 4;
#pragma unroll
          for (int cc = 0; cc < 2; ++cc)
#pragma unroll
              for (int g4 = 0; g4 < 4; ++g4) { u32x2 w; w.x = cvtpk(ot[cc][g4 * 4], ot[cc][g4 * 4 + 1]); w.y = cvtpk(ot[cc][g4 * 4 + 2], ot[cc][g4 * 4 + 3]);
                  *(u32x2*)(op + cc * 32 + g4 * 8) = w; } }
    }
    __builtin_amdgcn_s_setprio(0);
}

#define XB_TMO      128
#define XB_XCNT(j)  (256  + 64 * (j))
#define XB_XSUB(j)  (1280 + 64 * (j))
#define XB_XGEN(j)  (2304 + 64 * (j))
#define XB_TOP      3328
#define XB_TOPGEN   3392
#define XCD_BAR_WORDS 3456
#define XB_SPIN_CAP (1u << 18)

__device__ __forceinline__ unsigned xb_ld(unsigned* p)              { return __hip_atomic_load(p, __ATOMIC_RELAXED, __HIP_MEMORY_SCOPE_AGENT); }
__device__ __forceinline__ unsigned xb_add(unsigned* p, unsigned v) { return __hip_atomic_fetch_add(p, v, __ATOMIC_RELAXED, __HIP_MEMORY_SCOPE_AGENT); }
__device__ __forceinline__ unsigned xb_xcc_id() { return (unsigned)__builtin_amdgcn_s_getreg((3 << 11) | 20) & 0xFu; }
#define XB_SPIN(cond, bar) do { unsigned _sp = 0; while (cond) { __builtin_amdgcn_s_sleep(1); \
    if ((++_sp & 255u) == 0u) { if (xb_ld(&(bar)[XB_TMO])) break; if (_sp > XB_SPIN_CAP) { atomicAdd(&(bar)[XB_TMO], 1u); break; } } } } while (0)

struct XcdBarrier {
    unsigned* bar; unsigned x;
    volatile LAS unsigned* st;
};

__device__ __forceinline__ XcdBarrier xcd_barrier_post(unsigned* bar, volatile LAS unsigned* st) {
    XcdBarrier b; b.bar = bar; b.x = xb_xcc_id(); b.st = st;
    if (threadIdx.x == 0) (void)xb_add(&bar[XB_XCNT(b.x)], 1u);
    return b;
}
__device__ __forceinline__ void xcd_barrier_complete(unsigned* bar, unsigned x, unsigned& nloc, unsigned& nx) {
    const unsigned G = gridDim.x * gridDim.y * gridDim.z;
    unsigned sum, cnt, mine, sp = 0u;
    for (;;) {
        sum = 0u; cnt = 0u; mine = 0u;
#pragma unroll
        for (unsigned j = 0; j < 16; ++j) { const unsigned c = xb_ld(&bar[XB_XCNT(j)]); sum += c; cnt += (c > 0u) ? 1u : 0u; mine = (j == x) ? c : mine; }
        if (sum == G) break;
        __builtin_amdgcn_s_sleep(1);
        if ((++sp & 255u) == 0u) { if (xb_ld(&bar[XB_TMO])) break; if (sp > XB_SPIN_CAP) { atomicAdd(&bar[XB_TMO], 1u); break; } }
    }
    nloc = mine > 0u ? mine : 1u; nx = cnt > 0u ? cnt : 1u;
}

__device__ __forceinline__ void xcd_barrier(const XcdBarrier& b) {
    asm volatile("s_waitcnt vmcnt(0)" ::: "memory");
    __syncthreads();
    if (threadIdx.x == 0) {
        unsigned* bar = b.bar;
        __builtin_amdgcn_s_waitcnt(0);
        unsigned nloc = b.st[0], nx = b.st[1];
        if (nloc == 0u) { xcd_barrier_complete(bar, b.x, nloc, nx); b.st[0] = nloc; b.st[1] = nx; }
        const unsigned old = xb_add(&bar[XB_XSUB(b.x)], 1u);
        const unsigned gen = old / nloc;
        if (old + 1u == (gen + 1u) * nloc) {
            __builtin_amdgcn_fence(__ATOMIC_RELEASE, "agent");
            asm volatile("s_waitcnt vmcnt(0)" ::: "memory");
            const unsigned og = xb_add(&bar[XB_TOP], 1u);
            const unsigned tg = og / nx;
            if (og + 1u == (tg + 1u) * nx) xb_add(&bar[XB_TOPGEN], 1u);
            else XB_SPIN(xb_ld(&bar[XB_TOPGEN]) == tg, bar);
            __builtin_amdgcn_fence(__ATOMIC_ACQUIRE, "agent");
            xb_add(&bar[XB_XGEN(b.x)], 1u);
            asm volatile("s_waitcnt vmcnt(0)" ::: "memory");
        } else {
            XB_SPIN(xb_ld(&bar[XB_XGEN(b.x)]) == gen, bar);
            __builtin_amdgcn_fence(__ATOMIC_ACQUIRE, "agent");
            asm volatile("s_waitcnt vmcnt(0)" ::: "memory");
        }
    }
    __syncthreads();
}

__global__ void __launch_bounds__(512, 2) mk_fwd(Params p) {
    extern __shared__ __attribute__((aligned(16))) unsigned char lds_raw[];
    LAS unsigned char* lds = (LAS unsigned char*)lds_raw;
    volatile LAS unsigned* bar_st = (volatile LAS unsigned*)(lds + LDS_BARST);
    if (threadIdx.x < 2) bar_st[threadIdx.x] = 0u;
    __syncthreads();
    (void)xcd_barrier_post((unsigned*)(p.ws + WS_BAR), bar_st);
    typedef const char __attribute__((address_space(4)))* kaptr_t;
    for (int step = p.step_lo; step < p.step_hi; ++step) {
        kaptr_t ka = (kaptr_t)__builtin_amdgcn_kernarg_segment_ptr();
        asm volatile("" : "+s"(ka));
        int tid_ = threadIdx.x; asm volatile("" : "+v"(tid_));
        int c_ = blockIdx.x; asm volatile("" : "+s"(c_));
        int G_ = gridDim.x; asm volatile("" : "+s"(G_));
        const int tid = tid_, lane = tid & 63, wave = __builtin_amdgcn_readfirstlane(tid >> 6);
        const int G = G_, c = c_;
        const int gw = c * 8 + wave, NGW = G * 8;
#define PIN(i) (*(const float* const __attribute__((address_space(4)))*)(ka + 8 * (i)))
        unsigned char* ws = *(unsigned char* const __attribute__((address_space(4)))*)(ka + 8 * 24);
        const float* x_in = PIN(0);
        float* xres = *(float* const __attribute__((address_space(4)))*)(ka + 8 * 23);
        float* mod = (float*)(ws + WS_MOD);
        float* kvmod = (float*)(ws + WS_KVMOD);
        bf16_t* XN = (bf16_t*)(ws + WS_XN);
        bf16_t* BIG = (bf16_t*)(ws + WS_BIG);
        bf16_t* HID = (bf16_t*)(ws + WS_HID);
        bf16_t* KVB = (bf16_t*)(ws + WS_KV);
        bf16_t* CMP = (bf16_t*)(ws + WS_CMP);
        int kind, layer = 0, sub = 0;
        int es = step;
#ifdef DUP_CLASS
        {
            int s = 0, e = 0;
            for (e = 0; e < 43; ++e) {
                int k2, l2 = 0, s2 = 0;
                if (e == 0) k2 = 0; else if (e <= 18) { k2 = 1; l2 = (e - 1) / 9; s2 = (e - 1) % 9; } else if (e <= 23) { k2 = 2; s2 = e - 19; } else if (e <= 41) { k2 = 1; l2 = 2 + (e - 24) / 9; s2 = (e - 24) % 9; } else k2 = 3;
                const bool d = (DUP_CLASS == 1 && k2 == 1 && s2 == 2 && l2 < 2) || (DUP_CLASS == 2 && k2 == 1 && s2 == 2 && l2 >= 2) ||
                               (DUP_CLASS == 3 && k2 == 1 && (s2 == 5 || s2 == 7)) || (DUP_CLASS == 4 && ((k2 == 1 && (s2 == 0 || s2 == 4)) || (k2 == 2 && s2 == 0))) ||
                               (DUP_CLASS == 5 && k2 == 1 && s2 == 1) || (DUP_CLASS == 6 && k2 == 0) || (DUP_CLASS == 7 && k2 == 2);
                if (s == step) break; ++s; if (d) { if (s == step) break; ++s; }
            }
            es = e;
        }
#endif
        if (es == 0) kind = 0;
        else if (es <= 18) { kind = 1; layer = (es - 1) / 9; sub = (es - 1) % 9; }
        else if (es <= 23) { kind = 2; sub = es - 19; }
        else if (es <= 41) { kind = 1; layer = 2 + (es - 24) / 9; sub = (es - 24) % 9; }
        else kind = 3;

        int gwn = gw, ngwn = NGW;
        if (G > 128) {
            if (kind == 1 && layer == 2 && sub == 0) continue;
            if (kind == 2 && sub == 3 && c >= 64) { kind = 1; layer = 2; sub = 0; gwn = (c - 64) * 8 + wave; ngwn = (G - 64) * 8; }
        }
        if (kind == 0) {
            {
                LAS float* scr = (LAS float*)(lds + wave * 16384);
                for (int it = gw;; it += NGW) {
                    int rr = it; const float* src; bf16_t* dst; int K, Ns;
                    if (rr < 2 * 1536) { const int l = rr / 1536; rr %= 1536; src = PIN(9) + (size_t)l * D * NQKV; dst = (bf16_t*)(ws + WS_WQKV) + (size_t)l * NQKV * D; K = D; Ns = NQKV; }
                    else if ((rr -= 3072) < 2 * 512) { const int l = rr / 512; rr %= 512; src = PIN(10) + (size_t)l * D * D; dst = (bf16_t*)(ws + WS_WAO) + (size_t)l * D * D; K = D; Ns = D; }
                    else if ((rr -= 1024) < 4 * 2048) { const int l = rr / 2048; rr %= 2048; src = PIN(7) + (size_t)l * D * FF; dst = (bf16_t*)(ws + WS_W1) + (size_t)l * D * FF; K = D; Ns = FF; }
                    else if ((rr -= 8192) < 4 * 2048) { const int l = rr / 2048; rr %= 2048; src = PIN(8) + (size_t)l * D * FF; dst = (bf16_t*)(ws + WS_W2) + (size_t)l * D * FF; K = FF; Ns = D; }
                    else if ((rr -= 8192) < 768) { src = PIN(16); dst = (bf16_t*)(ws + WS_WKV); K = D; Ns = NKV; }
                    else if ((rr -= 768) < 2 * 544) { const int l = rr / 544; rr %= 544; src = PIN(20) + (size_t)l * D * NBIN; dst = (bf16_t*)(ws + WS_WBIN) + (size_t)l * NBINP * D; K = D; Ns = NBIN; }
                    else if ((rr -= 1088) < 2 * 512) { const int l = rr / 512; rr %= 512; src = PIN(21) + (size_t)l * D * D; dst = (bf16_t*)(ws + WS_WBO) + (size_t)l * D * D; K = D; Ns = D; }
                    else if ((rr -= 1024) < 2 * 256) { const int l = rr / 256; rr %= 256; src = PIN(18) + (size_t)l * 2048 * 256; dst = (bf16_t*)(ws + WS_WC1) + (size_t)l * 256 * 2048; K = 2048; Ns = 256; }
                    else break;
                    transpose_item(src, K, Ns, dst, scr, rr, lane);
                }
                { unsigned z_ = 0u; asm volatile("" : "+v"(z_));
                for (int i = c * 512 + tid; i < 2 * 192 * 1024 / 8; i += G * 512) { const int l = i / (192 * 128), rem = i % (192 * 128);
                    *(u32x4*)((bf16_t*)(ws + WS_WBIN) + (size_t)l * NBINP * D + (size_t)1088 * D + (size_t)rem * 8) = (u32x4){z_, z_, z_, z_}; } }
            }
            __syncthreads();
            {
                LAS float* cact = (LAS float*)lds;
                LAS float* red = (LAS float*)(lds + 32768);
                for (int i = tid; i < 8192; i += 512) { const float v = PIN(1)[i]; cact[i] = v * __builtin_amdgcn_rcpf(1.f + __expf(-v)); }
                __syncthreads();
                for (int cgi = c; cgi < 416; cgi += G) {
                    const float* W; const float* bias; float* outp; int N, col0, ostride;
                    if (cgi < 384) { const int l = cgi / 96; col0 = (cgi % 96) * 64; W = PIN(3) + (size_t)l * D * 6144; N = 6144; bias = PIN(4) + l * 6144; outp = mod + (size_t)l * 8 * 6144; ostride = 6144; }
                    else { col0 = (cgi - 384) * 64; W = PIN(13); N = 2048; bias = PIN(14); outp = kvmod; ostride = 2048; }
                    float acc[8];
#pragma unroll
                    for (int b = 0; b < 8; ++b) acc[b] = 0.f;
                    const float* wp = W + (size_t)(wave * 128) * N + col0 + lane;
#pragma unroll 32
                    for (int k = 0; k < 128; ++k) { const float wv = wp[(size_t)k * N];
#pragma unroll
                        for (int b = 0; b < 8; ++b) acc[b] += cact[b * 1024 + wave * 128 + k] * wv; }
#pragma unroll
                    for (int b = 0; b < 8; ++b) red[(wave * 8 + b) * 64 + lane] = acc[b];
                    __syncthreads();
                    { const int b = tid >> 6; float s = 0.f;
#pragma unroll
                      for (int w = 0; w < 8; ++w) s += red[(w * 8 + b) * 64 + lane];
                      outp[(size_t)b * ostride + col0 + lane] = s + bias[col0 + lane]; }
                    __syncthreads();
                }
            }
        } else if (kind == 3 || (kind == 1 && (sub == 0 || sub == 4)) || (kind == 2 && sub == 0)) {
            const float* src = (kind == 1 && layer == 0 && sub == 0) ? x_in : xres;
            const float* gamma; const float* shift = nullptr; const float* scale = nullptr; int bstride = 0;
            if (kind == 3) gamma = PIN(22);
            else if (kind == 2) { gamma = PIN(15); shift = kvmod; scale = kvmod + 1024; bstride = 2048; }
            else if (sub == 0) { gamma = PIN(5) + layer * D; shift = mod + (size_t)layer * 8 * 6144; scale = shift + 1024; bstride = 6144; }
            else { gamma = PIN(6) + layer * D; shift = mod + (size_t)layer * 8 * 6144 + 3072; scale = shift + 1024; bstride = 6144; }
            int tid = tid_; asm volatile("" : "+v"(tid)); const int lane = tid & 63; (void)lane;
            for (int chunk = gwn; chunk < M / 16; chunk += ngwn) {
                const int row0 = chunk * 16, b = row0 / T;
                f32x4 A[4], Bv[4];
#pragma unroll
                for (int j = 0; j < 4; ++j) { const int col = 4 * lane + 256 * j; const f32x4 gm = *(const f32x4*)(gamma + col);
                    if (scale) { const f32x4 sc = *(const f32x4*)(scale + (size_t)b * bstride + col); A[j] = gm * (sc + 1.0f); Bv[j] = *(const f32x4*)(shift + (size_t)b * bstride + col); }
                    else { A[j] = gm; Bv[j] = (f32x4){0.f, 0.f, 0.f, 0.f}; } }
#pragma unroll 1
                for (int rq = 0; rq < 16; rq += 4) {
                    f32x4 v[4][4];
#pragma unroll
                    for (int r4 = 0; r4 < 4; ++r4)
#pragma unroll
                        for (int j = 0; j < 4; ++j) v[r4][j] = *(const f32x4*)(src + (size_t)(row0 + rq + r4) * D + 4 * lane + 256 * j);
#pragma unroll
                    for (int r4 = 0; r4 < 4; ++r4) {
                        const size_t ro = (size_t)(row0 + rq + r4) * D; float ss = 0.f;
#pragma unroll
                        for (int j = 0; j < 4; ++j) ss += (v[r4][j].x * v[r4][j].x + v[r4][j].y * v[r4][j].y) + (v[r4][j].z * v[r4][j].z + v[r4][j].w * v[r4][j].w);
                        const float rstd = rsqrtf(wave_sum(ss, lane) * (1.f / D) + NORM_EPS);
#pragma unroll
                        for (int j = 0; j < 4; ++j) { const f32x4 y = v[r4][j] * rstd * A[j] + Bv[j];
                            if (kind == 3) *(f32x4*)(xres + ro + 4 * lane + 256 * j) = y;
                            else { u32x2 w; w.x = cvtpk(y.x, y.y); w.y = cvtpk(y.z, y.w); *(u32x2*)(XN + ro + 4 * lane + 256 * j) = w; } }
                    }
                }
            }
        } else if (kind == 1 && sub == 2) {
#ifndef NO_DIFF
            if (layer < 2) diff_attn_phase((LAS char*)lds, BIG, XN, PIN(2), PIN(11) + layer * 256, PIN(12) + layer * 128, layer, (float*)(ws + WS_O1) + (size_t)c * 32768, G, c);
#endif
#ifndef NO_NSA
            if (layer >= 2) nsa_phase((LAS char*)lds, BIG, KVB, CMP, XN, PIN(2), G, c);
#endif
        } else if (kind == 2 && sub == 2) {
            int tid = tid_; asm volatile("" : "+v"(tid)); const int lane = tid & 63; (void)lane;
            for (size_t idx = (size_t)c * 512 + tid; idx < (size_t)16384 * 256; idx += (size_t)G * 512) {
                const int row = (int)(idx >> 8), c8 = (int)(idx & 255), l = c8 >> 3, d0 = (c8 & 7) * 8;
                const int n = row & 255, g = (row >> 8) & 3, b = (row >> 10) & 7, s = row >> 13;
                const int t = 16 * n + l;
                unsigned z_ = 0u; asm volatile("" : "+v"(z_));
                u32x4 o = {z_, z_, z_, z_};
                if (t < T) {
                    const u32x4 kv = *(const u32x4*)(KVB + ((size_t)((s * 8 + b) * 4 + g) * T + t) * 64 + d0);
                    const float* pp = PIN(17) + (s * 32 + l) * 64 + d0;
                    const f32x4 p0 = *(const f32x4*)pp, p1 = *(const f32x4*)(pp + 4);
                    o.x = cvtpk(bf2f((bf16_t)(kv.x & 0xffff)) + p0.x, bf2f((bf16_t)(kv.x >> 16)) + p0.y);
                    o.y = cvtpk(bf2f((bf16_t)(kv.y & 0xffff)) + p0.z, bf2f((bf16_t)(kv.y >> 16)) + p0.w);
                    o.z = cvtpk(bf2f((bf16_t)(kv.z & 0xffff)) + p1.x, bf2f((bf16_t)(kv.z >> 16)) + p1.y);
                    o.w = cvtpk(bf2f((bf16_t)(kv.w & 0xffff)) + p1.z, bf2f((bf16_t)(kv.w >> 16)) + p1.w);
                }
                *(u32x4*)(BIG + (size_t)row * 2048 + c8 * 8) = o;
            }
        } else if (kind == 2 && sub == 4) {
            int tid = tid_; asm volatile("" : "+v"(tid)); const int lane = tid & 63; (void)lane;
            for (int rg = gw; rg < 16384 / 8; rg += NGW) {
                const int row0 = rg * 8, s = row0 >> 13;
                const float* w2 = PIN(19) + (size_t)s * 256 * 64 + lane;
                float acc[8];
#pragma unroll
                for (int i = 0; i < 8; ++i) acc[i] = 0.f;
                for (int h = 0; h < 256; h += 2) {
                    const float wa = w2[(size_t)h * 64], wb = w2[(size_t)(h + 1) * 64];
#pragma unroll
                    for (int i = 0; i < 8; ++i) { const unsigned hv = *(const unsigned*)(HID + (size_t)(row0 + i) * 256 + h);
                        acc[i] += bf2f((bf16_t)(hv & 0xffff)) * wa + bf2f((bf16_t)(hv >> 16)) * wb; }
                }
#pragma unroll
                for (int i = 0; i < 8; ++i) CMP[(size_t)(row0 + i) * 64 + lane] = (bf16_t)f2bf(acc[i]);
            }
        } else {
            pg8::Gemm g; pg8::Sched S;
            bool resid = false; pg8::EpiStore ES{nullptr, 0, 0, 0, 0, 0}; pg8::EpiResid ER{nullptr, nullptr, nullptr, 0};
            if (kind == 2 && sub == 1) { g = pg8::Gemm{XN, (const bf16_t*)(ws + WS_WKV), M, NKV, D}; S.init(M, NKV, G, c, 0); ES = pg8::EpiStore{KVB, NKV, 0, 0, 0, 2}; }
            else if (kind == 2) { g = pg8::Gemm{BIG, (const bf16_t*)(ws + WS_WC1), 16384, 512, 2048}; S.init(16384, 512, G, c, 1); ES = pg8::EpiStore{HID, 256, 2, 1, 0, 0}; }
            else if (sub == 1) {
                if (layer < 2) { g = pg8::Gemm{XN, (const bf16_t*)(ws + WS_WQKV) + (size_t)layer * NQKV * D, M, NQKV, D}; S.init(M, NQKV, G, c, 0); ES = pg8::EpiStore{BIG, 1024, 0, 0, 1024, 1}; }
                else { g = pg8::Gemm{XN, (const bf16_t*)(ws + WS_WBIN) + (size_t)(layer - 2) * NBINP * D, M, NBINP, D}; S.init(M, NBINP, G, c, 0); ES = pg8::EpiStore{BIG, NBINP, 0, 0, 1024, 0}; }
            } else if (sub == 3) {
                const bf16_t* W = layer < 2 ? (const bf16_t*)(ws + WS_WAO) + (size_t)layer * D * D : (const bf16_t*)(ws + WS_WBO) + (size_t)(layer - 2) * D * D;
                g = pg8::Gemm{XN, W, M, D, D}; S.init(M, D, G, c, 0); resid = true;
                ER = pg8::EpiResid{layer == 0 ? x_in : xres, xres, mod + (size_t)layer * 8 * 6144 + 2048, 0};
            } else if (sub == 5 || sub == 7) {
                const int half = (sub - 5) / 2;
                g = pg8::Gemm{XN + (size_t)half * 16384 * D, (const bf16_t*)(ws + WS_W1) + (size_t)layer * D * FF, 16384, FF, D}; S.init(16384, FF, G, c, 0); ES = pg8::EpiStore{BIG, FF, 1, 0, 0, 0};
            } else {
                const int half = (sub - 6) / 2;
                g = pg8::Gemm{BIG, (const bf16_t*)(ws + WS_W2) + (size_t)layer * D * FF, 16384, D, FF}; S.init(16384, D, G, c, 0); resid = true;
                ER = pg8::EpiResid{xres, xres, mod + (size_t)layer * 8 * 6144 + 5120, half * 16384};
            }
#ifndef NO_GEMM
            if (resid) pg8::gemm_phase<pg8::EpiResid, pg8::Sched, true, true>(lds, g, S, ER);
            else pg8::gemm_phase<pg8::EpiStore, pg8::Sched, true, true>(lds, g, S, ES);
#endif
        }
        if (step + 1 < p.step_hi) {
#if USE_XCD_BAR
            if (step == p.step_lo) cg::this_grid().sync();
            else { XcdBarrier xb; xb.bar = (unsigned*)(ws + WS_BAR); xb.x = xb_xcc_id(); xb.st = (volatile LAS unsigned*)(lds + LDS_BARST); xcd_barrier(xb); }
#else
            cg::this_grid().sync();
#endif
        }
    }
}

extern "C" void kernel_launch(void* const* d_in, const int* in_sizes, int n_in, void* d_out, int out_size, void* d_ws, size_t ws_size, hipStream_t stream) {
    static int grid = 0;
    if (grid == 0) {
        if (n_in != 23 || out_size != M * D || ws_size < WS_END) { fprintf(stderr, "kernel_launch: unexpected shapes (n_in %d out %d ws %zu)\n", n_in, out_size, ws_size); grid = -1; return; }
        int dev = 0, cus = 0, per_cu = 0;
        hipGetDevice(&dev);
        hipDeviceGetAttribute(&cus, hipDeviceAttributeMultiprocessorCount, dev);
        hipFuncSetAttribute((const void*)mk_fwd, hipFuncAttributeMaxDynamicSharedMemorySize, LDS_BYTES);
        if (hipOccupancyMaxActiveBlocksPerMultiprocessor(&per_cu, (const void*)mk_fwd, 512, LDS_BYTES) != hipSuccess || per_cu < 1) { fprintf(stderr, "kernel_launch: occupancy query says %d\n", per_cu); per_cu = 1; }
        (void)hipGetLastError();
        grid = cus;
    }
    if (grid < 0) return;
    hipMemsetAsync((char*)d_ws + WS_BAR, 0, 16384, stream);
    Params p{};
    for (int i = 0; i < 23; ++i) p.in[i] = (const float*)d_in[i];
    p.out = (float*)d_out; p.ws = (unsigned char*)d_ws; p.step_lo = 0; p.step_hi = 43 + NDUP;
    void* args[] = {&p};
    hipError_t e = hipLaunchCooperativeKernel((const void*)mk_fwd, dim3(grid), dim3(512), args, LDS_BYTES, stream);
    if (e != hipSuccess) fprintf(stderr, "cooperative launch failed: %s (grid %d)\n", hipGetErrorString(e), grid);
}
```

```cpp
#include <hip/hip_runtime.h>
#include <hip/hip_cooperative_groups.h>
#include <cstdio>
#include <cstdint>
namespace cg = cooperative_groups;

#ifndef NDUP
#define NDUP 0
#endif
#ifndef USE_XCD_BAR
#define USE_XCD_BAR 1
#endif

#define LAS __attribute__((address_space(3)))
typedef unsigned short bf16_t;
typedef short bf16x8 __attribute__((ext_vector_type(8)));
typedef short s16x4 __attribute__((ext_vector_type(4)));
typedef float f32x4 __attribute__((ext_vector_type(4)));
typedef float f32x16 __attribute__((ext_vector_type(16)));
typedef unsigned u32x4 __attribute__((ext_vector_type(4)));
typedef unsigned u32x2 __attribute__((ext_vector_type(2)));
typedef float f32x2_t __attribute__((ext_vector_type(2)));
typedef __bf16 bf16x2_t __attribute__((ext_vector_type(2)));

__device__ __forceinline__ unsigned cvtpk(float lo, float hi) { f32x2_t v = {lo, hi}; bf16x2_t b = __builtin_convertvector(v, bf16x2_t); return __builtin_bit_cast(unsigned, b); }
__device__ __forceinline__ float bf2f(bf16_t v) { return __builtin_bit_cast(float, (unsigned)v << 16); }

constexpr int BATCH = 8, T = 4096, D = 1024, M = BATCH * T, FF = 4096;
constexpr int NQKV = 3072, NKV = 1536, NBIN = 1072, NBINP = 1280;
constexpr float NORM_EPS = 1e-6f;
constexpr float LOG2E = 1.4426950408889634f;
constexpr float SC2 = 0.125f * LOG2E;

constexpr size_t MiB = 1u << 20;
constexpr size_t WS_MOD = 0;
constexpr size_t WS_KVMOD = 4 * 8 * 6144 * 4;
constexpr size_t WS_BAR = 1 * MiB;
constexpr size_t WS_WQKV = 2 * MiB;
constexpr size_t WS_WAO = 14 * MiB;
constexpr size_t WS_W1 = 18 * MiB;
constexpr size_t WS_W2 = 50 * MiB;
constexpr size_t WS_WKV = 82 * MiB;
constexpr size_t WS_WBIN = 85 * MiB;
constexpr size_t WS_WBO = 90 * MiB;
constexpr size_t WS_WC1 = 94 * MiB;
constexpr size_t WS_XN = 96 * MiB;
constexpr size_t WS_BIG = 160 * MiB;
constexpr size_t WS_HID = 224 * MiB;
constexpr size_t WS_KV = 352 * MiB;
constexpr size_t WS_CMP = 448 * MiB;
constexpr size_t WS_O1 = 450 * MiB;
constexpr size_t WS_END = 482 * MiB;

namespace pg8 {
#define PG8_LAS __attribute__((address_space(3)))
constexpr int BM = 256, BK = 64, HALF = 128, HTB = HALF * BK * 2, STAGE_BYTES = 8 * HTB, NXCD = 8, WGM = 8;
__host__ __device__ __forceinline__ int lds_byte(int r, int c) { const int st = (r >> 4) * 2 + (c >> 5), rr = r & 15, cc = c & 31, ob = rr * 64 + cc * 2; return st * 1024 + (ob ^ (((ob >> 9) & 1) << 5)); }
__host__ __device__ __forceinline__ void stage_rc(int b, int& R, int& C) { const int st = b / 1024, sb = b % 1024, swz = sb ^ (((sb >> 9) & 1) << 5); R = (st >> 1) * 16 + swz / 64; C = (st & 1) * 32 + (swz % 64) / 2; }
__host__ __device__ __forceinline__ int perm32(int rho) { const int n = rho >> 4, i = rho & 15; return 8 * (i >> 2) + 4 * n + (i & 3); }

struct Unit { int pm, pn; };
struct Gemm { const bf16_t* A; const bf16_t* Bt; int M, N, K; };

struct Sched {
    int nM, nN, nwg, G, c, mode;
    __device__ void init(int M_, int N_, int G_, int c_, int mode_) { nM = M_ / BM; nN = N_ / BM; nwg = mode_ ? nM : nM * nN; G = G_; c = c_; mode = mode_; }
    __device__ bool next(int i, Unit& u) const {
        const long L = (long)i * G + c; if (L >= nwg) return false;
        if (mode == 1) { u.pm = (int)L; u.pn = (int)L >> 5; return true; }
        int wgid = (int)L; { const int q = nwg / NXCD, r = nwg % NXCD, xcd = wgid % NXCD, off = wgid / NXCD; wgid = (xcd < r ? xcd * (q + 1) : r * (q + 1) + (xcd - r) * q) + off; }
        const int nig = WGM * nN, gid = wgid / nig, fm = gid * WGM, gsz = (nM - fm) < WGM ? (nM - fm) : WGM;
        u.pm = fm + ((wgid % nig) % gsz); u.pn = (wgid % nig) / gsz; return true;
    }
    __device__ __forceinline__ void a_ready(const Unit&) const {}
    __device__ __forceinline__ void done(const Unit&) const {}
};

__device__ __forceinline__ float act_fn(float v, int act) {
    if (act == 1) { const float r = fmaxf(v, 0.f); return r * r; }
    if (act == 2) { const float u = 0.7978845608028654f * (v + 0.044715f * v * v * v); return v * __builtin_amdgcn_rcpf(1.f + __expf(-2.f * u)); }
    return v;
}
struct EpiStore {
    static constexpr bool PERM = true, AFTER_DRAIN = false;
    bf16_t* O; int ldc; int act; int fold; int qcols; int mode;
    __device__ __forceinline__ void operator()(const f32x4 (&acc)[2][2][4][2], const Unit& u, int wr, int wc, int fr, int fq) const {
        const int row0 = u.pm * BM + wr * 64 + fr; const int colt = fold ? 0 : u.pn * BM; const int cw = wc * 32 + 8 * fq;
        const float qs = (u.pn * BM < qcols) ? 0.18033688011112042f : 1.0f;
        const int b = (u.pm * BM) / T, t0 = (u.pm * BM) % T + wr * 64 + fr;
        size_t base[2]; size_t rstride;
        if (mode == 1 && colt >= 1024) {
            if (colt < 2048) { rstride = 64;
#pragma unroll
                for (int bj = 0; bj < 2; ++bj) { const int hd = (colt - 1024) / 128 + bj; base[bj] = (size_t)M * 1024 + ((size_t)((b * 8 + hd) * 2 + (cw >> 6)) * T + t0) * 64 + (cw & 63); } }
            else { rstride = 128;
#pragma unroll
                for (int bj = 0; bj < 2; ++bj) { const int hd = (colt - 2048) / 128 + bj; base[bj] = (size_t)2 * M * 1024 + ((size_t)(b * 8 + hd) * T + t0) * 128 + cw; } }
        } else if (mode == 2) { rstride = 64;
#pragma unroll
            for (int bj = 0; bj < 2; ++bj) { const int c2 = bj * 128 + cw; base[bj] = ((size_t)((u.pn * 8 + b) * 4 + (c2 >> 6)) * T + t0) * 64 + (c2 & 63); }
        } else { rstride = (size_t)ldc;
#pragma unroll
            for (int bj = 0; bj < 2; ++bj) base[bj] = (size_t)row0 * ldc + colt + cw + bj * HALF;
        }
#pragma unroll
        for (int ai = 0; ai < 2; ++ai)
#pragma unroll
            for (int m = 0; m < 4; ++m) { const size_t ro = (size_t)(ai * HALF + m * 16) * rstride;
#pragma unroll
                for (int bj = 0; bj < 2; ++bj) { f32x4 v0 = acc[ai][bj][m][0], v1 = acc[ai][bj][m][1];
                    if (act) {
#pragma unroll
                        for (int e = 0; e < 4; ++e) { v0[e] = act_fn(v0[e], act); v1[e] = act_fn(v1[e], act); } }
                    v0 = v0 * qs; v1 = v1 * qs;
                    u32x4 w; w.x = cvtpk(v0[0], v0[1]); w.y = cvtpk(v0[2], v0[3]); w.z = cvtpk(v1[0], v1[1]); w.w = cvtpk(v1[2], v1[3]);
                    *(u32x4*)(O + base[bj] + ro) = w; } }
    }
};
struct EpiResid {
    static constexpr bool PERM = false, AFTER_DRAIN = false;
    const float* base; float* out; const float* gate; int row_off;
    __device__ __forceinline__ void operator()(const f32x4 (&acc)[2][2][4][2], const Unit& u, int wr, int wc, int fr, int fq) const {
        const int rt = row_off + u.pm * BM; const int b = rt / T; const int row0 = rt + wr * 64 + fr; const int col0 = u.pn * BM + wc * 32 + 4 * fq;
        f32x4 gv[2][2];
#pragma unroll
        for (int bj = 0; bj < 2; ++bj)
#pragma unroll
            for (int n = 0; n < 2; ++n) gv[bj][n] = *(const f32x4*)(gate + (size_t)b * 6144 + col0 + bj * HALF + n * 16);
#pragma unroll
        for (int aim = 0; aim < 4; ++aim) { const int ai = aim >> 1, m0 = (aim & 1) * 2;
            f32x4 xin[2][2][2];
#pragma unroll
            for (int mm = 0; mm < 2; ++mm) { const size_t off = (size_t)(row0 + ai * HALF + (m0 + mm) * 16) * D + col0;
#pragma unroll
                for (int bj = 0; bj < 2; ++bj)
#pragma unroll
                    for (int n = 0; n < 2; ++n) xin[mm][bj][n] = *(const f32x4*)(base + off + bj * HALF + n * 16); }
            asm volatile("" ::: "memory");
#pragma unroll
            for (int mm = 0; mm < 2; ++mm) { const int m = m0 + mm; const size_t off = (size_t)(row0 + ai * HALF + m * 16) * D + col0;
#pragma unroll
                for (int bj = 0; bj < 2; ++bj)
#pragma unroll
                    for (int n = 0; n < 2; ++n) *(f32x4*)(out + off + bj * HALF + n * 16) = xin[mm][bj][n] + gv[bj][n] * acc[ai][bj][m][n]; }
            asm volatile("" ::: "memory");
        }
    }
};

template <class Epi, class SchedT, bool ALIGN_EPI = false, bool SP2 = false>
__device__ __forceinline__ void gemm_phase(PG8_LAS unsigned char* lds, const Gemm g, const SchedT& S, const Epi& E) {
    int tid_ = threadIdx.x; asm volatile("" : "+v"(tid_));
    const int tid = tid_, wid = __builtin_amdgcn_readfirstlane(tid >> 6), lane = tid & 63, wr = wid >> 2, wc = wid & 3, fr = lane & 15, fq = lane >> 4;
    const int K = g.K, nt = K / BK;
    unsigned voffA[2], voffB[2];
#pragma unroll
    for (int i = 0; i < 2; ++i) { int R, C; stage_rc(tid * 16 + i * 8192, R, C); const int Rb = Epi::PERM ? ((R & ~31) + perm32(R & 31)) : R;
        voffA[i] = (unsigned)(R * K + C) * 2u; voffB[i] = (unsigned)(Rb * K + C) * 2u; }
    const size_t kstep = (size_t)(BK * 2);
    const size_t hstep = (size_t)HALF * K * 2;
    const size_t tstep = 2 * hstep;
    const unsigned ldsw = (unsigned)wid * 1024u;
    const int aoff = lds_byte(wr * 64 + fr, fq * 8), boff = lds_byte(wc * 32 + fr, fq * 8);
#define PG8_SA(b, h) (((b) * 2 + (h)) * HTB)
#define PG8_SB(b, h) ((4 + (b) * 2 + (h)) * HTB)
#define PG8_STAGE(bufoff, gbase, voff) do { _Pragma("unroll") for (int _i = 0; _i < 2; ++_i) \
        __builtin_amdgcn_global_load_lds((const unsigned*)((const char*)(gbase) + (voff)[_i]), (PG8_LAS unsigned*)(lds + (bufoff) + ldsw + _i * 8192), 16, 0, 0); } while (0)
#define PG8_LDA(dst, b, h) do { _Pragma("unroll") for (int m = 0; m < 4; ++m) _Pragma("unroll") for (int k = 0; k < 2; ++k) dst[m][k] = *(const PG8_LAS bf16x8*)(lds + PG8_SA(b, h) + aoff + m * 2048 + k * 1024); } while (0)
#define PG8_LDB(dst, b, h) do { _Pragma("unroll") for (int n = 0; n < 2; ++n) _Pragma("unroll") for (int k = 0; k < 2; ++k) dst[n][k] = *(const PG8_LAS bf16x8*)(lds + PG8_SB(b, h) + boff + n * 2048 + k * 1024); } while (0)
#define PG8_MMA(ai, bj, At, Bt) do { __builtin_amdgcn_s_setprio(1); _Pragma("unroll") for (int m = 0; m < 4; ++m) _Pragma("unroll") for (int n = 0; n < 2; ++n) _Pragma("unroll") for (int k = 0; k < 2; ++k) \
        acc[ai][bj][m][n] = __builtin_amdgcn_mfma_f32_16x16x32_bf16(Bt[n][k], At[m][k], acc[ai][bj][m][n], 0, 0, 0); __builtin_amdgcn_s_setprio(0); } while (0)
#define PG8_WAIT_V(n) asm volatile("s_waitcnt vmcnt(" #n ")" ::: "memory")
#define PG8_WAIT_L(n) asm volatile("s_waitcnt lgkmcnt(" #n ")" ::: "memory")
#define PG8_BAR __builtin_amdgcn_s_barrier()
#define PG8_SCHED __builtin_amdgcn_sched_barrier(0)
    Unit cur, nxt; int ui = 0;
    if (!S.next(0, cur)) return;
    f32x4 acc[2][2][4][2];
#pragma unroll
    for (int a = 0; a < 2; ++a)
#pragma unroll
        for (int b = 0; b < 2; ++b)
#pragma unroll
            for (int m = 0; m < 4; ++m)
#pragma unroll
                for (int n = 0; n < 2; ++n) acc[a][b][m][n] = (f32x4){0.f, 0.f, 0.f, 0.f};
    bf16x8 At[4][2], B0[2][2], B1[2][2];
    const char* cA = (const char*)g.A + (size_t)cur.pm * tstep; const char* cB = (const char*)g.Bt + (size_t)cur.pn * tstep;
    S.a_ready(cur);
    if constexpr (SP2) {
        PG8_STAGE(PG8_SB(0, 0), cB, voffB); PG8_STAGE(PG8_SB(0, 1), cB + hstep, voffB); PG8_STAGE(PG8_SA(0, 0), cA, voffA); PG8_STAGE(PG8_SA(0, 1), cA + hstep, voffA);
        if (wr == 1) PG8_BAR;
        PG8_WAIT_V(2); PG8_BAR;
        PG8_STAGE(PG8_SB(1, 0), cB + kstep, voffB); PG8_STAGE(PG8_SA(1, 0), cA + kstep, voffA); PG8_STAGE(PG8_SB(1, 1), cB + hstep + kstep, voffB);
        PG8_WAIT_V(6); PG8_BAR;
    } else {
        PG8_STAGE(PG8_SB(0, 0), cB, voffB); PG8_STAGE(PG8_SA(0, 0), cA, voffA); PG8_STAGE(PG8_SB(0, 1), cB + hstep, voffB); PG8_STAGE(PG8_SA(0, 1), cA + hstep, voffA);
        if (wr == 1) PG8_BAR;
        PG8_WAIT_V(4); PG8_BAR;
        PG8_STAGE(PG8_SB(1, 0), cB + kstep, voffB); PG8_STAGE(PG8_SA(1, 0), cA + kstep, voffA); PG8_STAGE(PG8_SB(1, 1), cB + hstep + kstep, voffB);
        PG8_WAIT_V(6); PG8_BAR;
    }
    for (;;) {
        const bool has_next = S.next(ui + 1, nxt);
        const char* nA = has_next ? (const char*)g.A + (size_t)nxt.pm * tstep : cA; const char* nB = has_next ? (const char*)g.Bt + (size_t)nxt.pn * tstep : cB;
        for (int t = 0; t < nt; t += 2) {
            const bool last = (t == nt - 2);
            const char* a1 = cA + (size_t)(t + 1) * kstep;
            const char* a2 = last ? nA : cA + (size_t)(t + 2) * kstep; const char* b2 = last ? nB : cB + (size_t)(t + 2) * kstep;
            const char* a3 = a2 + kstep; const char* b3 = b2 + kstep;
            if (last && has_next) S.a_ready(nxt);
            if constexpr (SP2) {
            PG8_LDB(B0, 0, 0); PG8_LDB(B1, 0, 1); PG8_SCHED; PG8_LDA(At, 0, 0); PG8_STAGE(PG8_SA(1, 1), a1 + hstep, voffA);
            PG8_WAIT_V(8); PG8_WAIT_L(0); PG8_BAR; PG8_MMA(0, 0, At, B0); PG8_MMA(0, 1, At, B1); PG8_BAR; PG8_SCHED;
            PG8_LDA(At, 0, 1); PG8_STAGE(PG8_SB(0, 0), b2, voffB); PG8_STAGE(PG8_SB(0, 1), b2 + hstep, voffB); PG8_STAGE(PG8_SA(0, 0), a2, voffA);
            PG8_WAIT_V(8); PG8_WAIT_L(0); PG8_BAR; PG8_MMA(1, 0, At, B0); PG8_MMA(1, 1, At, B1); PG8_BAR; PG8_SCHED;
            PG8_LDB(B0, 1, 0); PG8_LDB(B1, 1, 1); PG8_SCHED; PG8_LDA(At, 1, 0); PG8_STAGE(PG8_SA(0, 1), a2 + hstep, voffA);
            PG8_WAIT_V(8); PG8_WAIT_L(0); PG8_BAR; PG8_MMA(0, 0, At, B0); PG8_MMA(0, 1, At, B1); PG8_BAR; PG8_SCHED;
            PG8_LDA(At, 1, 1); PG8_STAGE(PG8_SB(1, 0), b3, voffB); PG8_STAGE(PG8_SB(1, 1), b3 + hstep, voffB); PG8_STAGE(PG8_SA(1, 0), a3, voffA);
            PG8_WAIT_V(8); PG8_WAIT_L(0); PG8_BAR; PG8_MMA(1, 0, At, B0); PG8_MMA(1, 1, At, B1); PG8_BAR; PG8_SCHED;
            } else {
            PG8_LDB(B0, 0, 0); PG8_SCHED; PG8_LDA(At, 0, 0); PG8_STAGE(PG8_SA(1, 1), a1 + hstep, voffA);
            PG8_WAIT_L(8); PG8_BAR; PG8_WAIT_L(0); PG8_MMA(0, 0, At, B0); PG8_BAR; PG8_SCHED;
            PG8_LDB(B1, 0, 1); PG8_STAGE(PG8_SB(0, 0), b2, voffB);
            PG8_BAR; PG8_WAIT_L(0); PG8_MMA(0, 1, At, B1); PG8_BAR;
            PG8_LDA(At, 0, 1); PG8_STAGE(PG8_SA(0, 0), a2, voffA);
            PG8_BAR; PG8_WAIT_L(0); PG8_MMA(1, 0, At, B0); PG8_BAR; PG8_SCHED;
            PG8_STAGE(PG8_SB(0, 1), b2 + hstep, voffB);
            PG8_WAIT_V(6); PG8_BAR; PG8_MMA(1, 1, At, B1); PG8_BAR;
            PG8_LDB(B0, 1, 0); PG8_SCHED; PG8_LDA(At, 1, 0); PG8_STAGE(PG8_SA(0, 1), a2 + hstep, voffA);
            PG8_WAIT_L(8); PG8_BAR; PG8_WAIT_L(0); PG8_MMA(0, 0, At, B0); PG8_BAR; PG8_SCHED;
            PG8_LDB(B1, 1, 1); PG8_STAGE(PG8_SB(1, 0), b3, voffB);
            PG8_BAR; PG8_WAIT_L(0); PG8_MMA(0, 1, At, B1); PG8_BAR;
            PG8_LDA(At, 1, 1); PG8_STAGE(PG8_SA(1, 0), a3, voffA);
            PG8_BAR; PG8_WAIT_L(0); PG8_MMA(1, 0, At, B0); PG8_BAR; PG8_SCHED;
            PG8_STAGE(PG8_SB(1, 1), b3 + hstep, voffB);
            PG8_WAIT_V(6); PG8_BAR; PG8_MMA(1, 1, At, B1); PG8_BAR;
            }
        }
        if constexpr (ALIGN_EPI) { if (wr == 0) PG8_BAR; }
        if constexpr (!Epi::AFTER_DRAIN) { E(acc, cur, wr, wc, fr, fq); S.done(cur); }
        if (!has_next) break;
#pragma unroll
        for (int a = 0; a < 2; ++a)
#pragma unroll
            for (int b = 0; b < 2; ++b)
#pragma unroll
                for (int m = 0; m < 4; ++m)
#pragma unroll
                    for (int n = 0; n < 2; ++n) acc[a][b][m][n] = (f32x4){0.f, 0.f, 0.f, 0.f};
        cur = nxt; cA = nA; cB = nB; ++ui;
        if constexpr (ALIGN_EPI) { if (wr == 1) PG8_BAR; }
    }
    PG8_WAIT_V(0);
    if constexpr (!ALIGN_EPI) { if (wr == 0) PG8_BAR; }
    PG8_BAR;
#undef PG8_SA
#undef PG8_SB
#undef PG8_STAGE
#undef PG8_LDA
#undef PG8_LDB
#undef PG8_MMA
#undef PG8_WAIT_V
#undef PG8_WAIT_L
#undef PG8_BAR
#undef PG8_SCHED
}
}

__device__ __forceinline__ float wave_sum(float v, int lane) {
#pragma unroll
    for (int o = 1; o < 64; o <<= 1) v += __builtin_bit_cast(float, __builtin_amdgcn_ds_bpermute((lane ^ o) << 2, __builtin_bit_cast(int, v)));
    return v;
}
__device__ __forceinline__ int t5_bucket(int n) { if (n < 16) return n; const int v = 16 + (int)(__log2f((float)n * 0.0625f) * (16.0f / 3.0f)); return v > 31 ? 31 : v; }
__device__ __forceinline__ unsigned f2bf(float f) { unsigned u = __builtin_bit_cast(unsigned, f); return (u + 0x7fffu + ((u >> 16) & 1u)) >> 16; }
__device__ __forceinline__ unsigned pk2(float lo, float hi) { return f2bf(lo) | (f2bf(hi) << 16); }

__device__ __forceinline__ void transpose_item(const float* W, int K, int Nsrc, bf16_t* WT, LAS float* scr, int item, int lane) {
    const int nblk = (Nsrc + 31) / 32, kb = item / nblk, nb = item % nblk, k0 = 64 * kb, n0 = 32 * nb;
    const int ncol = n0 + (lane & 31); const bool okc = ncol < Nsrc;
    float tv[32];
#pragma unroll
    for (int i = 0; i < 32; ++i) { const int kk = 2 * i + (lane >> 5); tv[i] = okc ? W[(size_t)(k0 + kk) * Nsrc + ncol] : 0.f; }
#pragma unroll
    for (int i = 0; i < 32; ++i) { const int kk = 2 * i + (lane >> 5); scr[kk * 33 + (lane & 31)] = tv[i]; }
    asm volatile("s_waitcnt lgkmcnt(0)" ::: "memory");
    const int c = lane & 7;
#pragma unroll
    for (int j = 0; j < 4; ++j) { const int n = (lane >> 3) + 8 * j; const LAS float* s = scr + (8 * c) * 33 + n;
        u32x4 o; o.x = pk2(s[0 * 33], s[1 * 33]); o.y = pk2(s[2 * 33], s[3 * 33]); o.z = pk2(s[4 * 33], s[5 * 33]); o.w = pk2(s[6 * 33], s[7 * 33]);
        *(u32x4*)(WT + (size_t)(n0 + n) * K + k0 + 8 * c) = o; }
    asm volatile("s_waitcnt lgkmcnt(0)" ::: "memory");
}

struct Params {
    const float* in[23];
    float* out;
    unsigned char* ws;
    int step_lo, step_hi;
};

constexpr int KP = 144;
constexpr int VP128 = 320, VP64 = 192;
constexpr int ATT_K0 = 0, ATT_V0 = 64 * KP, ATT_STAGE_DIFF = 64 * KP + 64 * VP128;
constexpr int ATT_STAGE_NSA = 64 * KP + 64 * VP64;
#define ATT_BT (4 * ATT_ST)
#define ATT_SEL (ATT_BT + 2048)
#define ATT_UM (ATT_SEL + 512)
#define ATT_IMP (ATT_UM + 64)
constexpr int LDS_BYTES = 139264;
constexpr int LDS_BARST = 139264 - 64;
static_assert(4 * 24576 + 2624 + 32768 <= LDS_BARST && 4 * 16384 + 2624 + 4 * 64 * 65 * 4 <= LDS_BARST && 2 * ATT_STAGE_NSA <= 4 * 16384, "attention LDS map");

__device__ __forceinline__ s16x4 vtr(LAS const char* p) { typedef short v4i16_t __attribute__((ext_vector_type(4))); return __builtin_bit_cast(s16x4, __builtin_amdgcn_ds_read_tr16_b64_v4i16((LAS v4i16_t*)p)); }

__device__ __forceinline__ float pair_max(float v) { float a = v, b = v; asm volatile("s_nop 1\n\tv_permlane32_swap_b32 %0, %1" : "+v"(a), "+v"(b)); return fmaxf(a, b); }
__device__ __forceinline__ float pair_sum(float v) { float a = v, b = v; asm volatile("s_nop 1\n\tv_permlane32_swap_b32 %0, %1" : "+v"(a), "+v"(b)); return a + b; }
__device__ __forceinline__ void qk_tile(f32x16& s0, f32x16& s1, const bf16x8 (&qf)[4], LAS const char* Kb, int lane) {
    LAS const char* kp = Kb + (lane & 31) * KP + (lane >> 5) * 16;
    f32x16 a = {}, b = {};
#pragma unroll
    for (int kk = 0; kk < 4; ++kk) {
        const bf16x8 k0 = *(LAS const bf16x8*)(kp + kk * 32);
        const bf16x8 k1 = *(LAS const bf16x8*)(kp + 32 * KP + kk * 32);
        a = __builtin_amdgcn_mfma_f32_32x32x16_bf16(k0, qf[kk], a, 0, 0, 0);
        b = __builtin_amdgcn_mfma_f32_32x32x16_bf16(k1, qf[kk], b, 0, 0, 0);
    }
    s0 = a; s1 = b;
}
__device__ __forceinline__ void qk_tile_lq(f32x16& s0, f32x16& s1, LAS const char* Qs, LAS const char* Kb, int lane) {
    LAS const char* kp = Kb + (lane & 31) * KP + (lane >> 5) * 16;
    f32x16 a = {}, b = {};
#pragma unroll
    for (int kk = 0; kk < 4; ++kk) {
        const bf16x8 q = *(LAS const bf16x8*)(Qs + kk * 1024 + lane * 16);
        const bf16x8 k0 = *(LAS const bf16x8*)(kp + kk * 32);
        const bf16x8 k1 = *(LAS const bf16x8*)(kp + 32 * KP + kk * 32);
        a = __builtin_amdgcn_mfma_f32_32x32x16_bf16(k0, q, a, 0, 0, 0);
        b = __builtin_amdgcn_mfma_f32_32x32x16_bf16(k1, q, b, 0, 0, 0);
    }
    s0 = a; s1 = b;
}
template <int DVB, int VP>
__device__ __forceinline__ void pv_tile(f32x16 (&o)[DVB], const bf16x8 (&P)[4], LAS const char* Vb, int lane) {
    const int i = lane & 15, gidx = lane >> 4, hh = gidx >> 1, dvh = gidx & 1;
    LAS const char* vp = Vb + (hh * 4 + (i >> 2)) * VP + (16 * dvh + 4 * (i & 3)) * 2;
    s16x4 lo[DVB], hi[DVB];
#pragma unroll
    for (int c = 0; c < DVB; ++c) { lo[c] = vtr(vp + c * 64); hi[c] = vtr(vp + 8 * VP + c * 64); }
#pragma unroll
    for (int ks = 0; ks < 4; ++ks) {
        s16x4 nlo[DVB], nhi[DVB];
        if (ks < 3) {
#pragma unroll
            for (int c = 0; c < DVB; ++c) { nlo[c] = vtr(vp + (16 * (ks + 1)) * VP + c * 64); nhi[c] = vtr(vp + (16 * (ks + 1) + 8) * VP + c * 64); }
        }
#pragma unroll
        for (int c = 0; c < DVB; ++c) {
            const bf16x8 a = (bf16x8){lo[c][0], lo[c][1], lo[c][2], lo[c][3], hi[c][0], hi[c][1], hi[c][2], hi[c][3]};
            o[c] = __builtin_amdgcn_mfma_f32_32x32x16_bf16(a, P[ks], o[c], 0, 0, 0);
        }
        __builtin_amdgcn_sched_barrier(0);
        if (ks < 3) {
#pragma unroll
            for (int c = 0; c < DVB; ++c) { lo[c] = nlo[c]; hi[c] = nhi[c]; }
        }
    }
}
template <bool BIAS>
__device__ __forceinline__ void score_elem(f32x16& s0, f32x16& s1, int base, int win, LAS const float* bt) {
#pragma unroll
    for (int i = 0; i < 16; ++i) {
        const int off = (i >> 2) * 8 + (i & 3);
        const int d0 = base - off, d1 = d0 - 32;
        float b0 = 0.f, b1 = 0.f;
        if (BIAS) { b0 = bt[min(max(d0, 0), 127)]; b1 = bt[min(max(d1, 0), 127)]; }
        s0[i] = ((unsigned)d0 < (unsigned)win) ? s0[i] + b0 : -INFINITY;
        s1[i] = ((unsigned)d1 < (unsigned)win) ? s1[i] + b1 : -INFINITY;
        if (BIAS && (i & 3) == 3) __builtin_amdgcn_sched_barrier(0);
    }
}
__device__ __forceinline__ float row_max32(const f32x16& s0, const f32x16& s1) {
    float a = fmaxf(s0[0], s1[0]);
#pragma unroll
    for (int i = 1; i < 16; ++i) a = fmaxf(a, fmaxf(s0[i], s1[i]));
    return pair_max(a);
}
template <int DVB>
__device__ __forceinline__ void softmax_step(f32x16& s0, f32x16& s1, float& m, float& l, f32x16 (&o)[DVB], bf16x8 (&P)[4], bool sel) {
    float mx = row_max32(s0, s1); mx = sel ? mx : -INFINITY;
    const float mn = fmaxf(m, mx);
    {
        const float a = __builtin_amdgcn_exp2f(m - mn); l *= a;
#pragma unroll
        for (int c = 0; c < DVB; ++c) o[c] *= a;
        m = mn;
    }
    const float ms = sel ? m : INFINITY;
    float sum = 0.f;
#pragma unroll
    for (int i = 0; i < 16; ++i) { s0[i] = __builtin_amdgcn_exp2f(s0[i] - ms); s1[i] = __builtin_amdgcn_exp2f(s1[i] - ms); sum += s0[i] + s1[i]; }
    l += sum;
    u32x4 w0 = {cvtpk(s0[0], s0[1]), cvtpk(s0[2], s0[3]), cvtpk(s0[4], s0[5]), cvtpk(s0[6], s0[7])};
    u32x4 w1 = {cvtpk(s0[8], s0[9]), cvtpk(s0[10], s0[11]), cvtpk(s0[12], s0[13]), cvtpk(s0[14], s0[15])};
    u32x4 w2 = {cvtpk(s1[0], s1[1]), cvtpk(s1[2], s1[3]), cvtpk(s1[4], s1[5]), cvtpk(s1[6], s1[7])};
    u32x4 w3 = {cvtpk(s1[8], s1[9]), cvtpk(s1[10], s1[11]), cvtpk(s1[12], s1[13]), cvtpk(s1[14], s1[15])};
    P[0] = __builtin_bit_cast(bf16x8, w0); P[1] = __builtin_bit_cast(bf16x8, w1); P[2] = __builtin_bit_cast(bf16x8, w2); P[3] = __builtin_bit_cast(bf16x8, w3);
}

__device__ __forceinline__ void glds16(const void* gsrc, unsigned lds_dst) { unsigned keep;
    asm volatile("s_mov_b32 %0, m0\n\ts_mov_b32 m0, %2\n\ts_nop 0\n\tglobal_load_lds_dwordx4 %1, off\n\ts_mov_b32 m0, %0" : "=&s"(keep) : "v"(gsrc), "s"(lds_dst) : "memory"); }
template <int VW>
__device__ __forceinline__ void dma_tile(LAS char* stage, const bf16_t* Kg, const bf16_t* Vg, size_t pitchK, size_t pitchV, int k0, int lane, int wid) {
    const bf16_t* kb = Kg + (size_t)k0 * pitchK; const bf16_t* vb = Vg + (size_t)k0 * pitchV;
    const unsigned sb = (unsigned)__builtin_amdgcn_readfirstlane((int)(unsigned)(uintptr_t)stage);
    { const int r = 8 * wid + (lane >> 3), c = (lane & 7) ^ ((r >> 1) & 7);
      glds16(kb + (unsigned)(r * (unsigned)pitchK + c * 8), sb + wid * 1024); }
    if (VW == 2) {
#pragma unroll
        for (int h = 0; h < 2; ++h) { const int pc = 2 * wid + h, r = 4 * pc + (lane >> 4), c = (lane & 15) ^ ((r & 3) << 2);
            glds16(vb + (unsigned)(r * (unsigned)pitchV + c * 8), sb + 8192 + pc * 1024); }
    } else {
        const int r = 8 * wid + (lane >> 3), c = (lane & 7) ^ (((r >> 1) & 1) << 2);
        glds16(vb + (unsigned)(r * (unsigned)pitchV + c * 8), sb + 8192 + wid * 1024);
    }
}
template <bool QREG>
__device__ __forceinline__ void qk_tile_sw(f32x16& s0, f32x16& s1, const bf16x8* qf, LAS const char* Qs, LAS const char* Kb, int lane) {
    const int r = lane & 31, hh = lane >> 5, sw = (r >> 1) & 7;
    LAS const char* kp = Kb + r * 128 + ((hh ^ (sw & 1)) << 4); const int t = sw >> 1;
    f32x16 a = {}, b = {};
#pragma unroll
    for (int kk = 0; kk < 4; ++kk) {
        const bf16x8 q = QREG ? qf[kk] : *(LAS const bf16x8*)(Qs + kk * 1024 + lane * 16);
        const bf16x8 k0 = *(LAS const bf16x8*)(kp + ((kk ^ t) << 5));
        const bf16x8 k1 = *(LAS const bf16x8*)(kp + ((kk ^ t) << 5) + 32 * 128);
        a = __builtin_amdgcn_mfma_f32_32x32x16_bf16(k0, q, a, 0, 0, 0);
        b = __builtin_amdgcn_mfma_f32_32x32x16_bf16(k1, q, b, 0, 0, 0);
    }
    s0 = a; s1 = b;
}
template <int DVB, int ROWB>
__device__ __forceinline__ void pv_tile_sw(f32x16 (&o)[DVB], const bf16x8 (&P)[4], LAS const char* Vb, int lane) {
    const int i = lane & 15, gidx = lane >> 4, hh = gidx >> 1, dvh = gidx & 1;
    const int q = ROWB == 256 ? ((i >> 2) & 3) : ((i >> 3) & 1);
    LAS const char* vp = Vb + (4 * hh + (i >> 2)) * ROWB + dvh * 32 + ((i & 3) >> 1) * 16 + (i & 1) * 8;
    s16x4 lo[DVB], hi[DVB];
#pragma unroll
    for (int c = 0; c < DVB; ++c) { lo[c] = vtr(vp + ((c ^ q) << 6)); hi[c] = vtr(vp + ((c ^ q) << 6) + 8 * ROWB); }
#pragma unroll
    for (int ks = 0; ks < 4; ++ks) {
        s16x4 nlo[DVB], nhi[DVB];
        if (ks < 3) {
#pragma unroll
            for (int c = 0; c < DVB; ++c) { nlo[c] = vtr(vp + ((c ^ q) << 6) + (16 * (ks + 1)) * ROWB); nhi[c] = vtr(vp + ((c ^ q) << 6) + (16 * (ks + 1) + 8) * ROWB); }
        }
#pragma unroll
        for (int c = 0; c < DVB; ++c) {
            const bf16x8 a = (bf16x8){lo[c][0], lo[c][1], lo[c][2], lo[c][3], hi[c][0], hi[c][1], hi[c][2], hi[c][3]};
            o[c] = __builtin_amdgcn_mfma_f32_32x32x16_bf16(a, P[ks], o[c], 0, 0, 0);
        }
        __builtin_amdgcn_sched_barrier(0);
        if (ks < 3) {
#pragma unroll
            for (int c = 0; c < DVB; ++c) { lo[c] = nlo[c]; hi[c] = nhi[c]; }
        }
    }
}

template <int VW> struct TileRegs { u32x4 k; u32x4 v[VW]; };
template <int VW>
__device__ __forceinline__ void tile_issue(TileRegs<VW>& r, const bf16_t* Kg, const bf16_t* Vg, size_t pitchK, size_t pitchV, int k0, int tid) {
    const bf16_t* kb = Kg + (size_t)k0 * pitchK;
    const bf16_t* vb = Vg + (size_t)k0 * pitchV;
    r.k = *(const u32x4*)(kb + (unsigned)((tid >> 3) * (unsigned)pitchK + (tid & 7) * 8));
    if (VW == 2) {
#pragma unroll
        for (int i = 0; i < 2; ++i) { const int idx = tid + 512 * i; r.v[i] = *(const u32x4*)(vb + (unsigned)((idx >> 4) * (unsigned)pitchV + (idx & 15) * 8)); }
    } else r.v[0] = *(const u32x4*)(vb + (unsigned)((tid >> 3) * (unsigned)pitchV + (tid & 7) * 8));
}
template <int VW>
__device__ __forceinline__ void tile_commit(const TileRegs<VW>& r, LAS char* st, int tid) {
    *(LAS u32x4*)(st + ATT_K0 + (tid >> 3) * KP + (tid & 7) * 16) = r.k;
    if (VW == 2) {
#pragma unroll
        for (int i = 0; i < 2; ++i) { const int idx = tid + 512 * i; *(LAS u32x4*)(st + ATT_V0 + (idx >> 4) * VP128 + (idx & 15) * 16) = r.v[i]; }
    } else *(LAS u32x4*)(st + ATT_V0 + (tid >> 3) * VP64 + (tid & 7) * 16) = r.v[0];
}
#define TILE_LOOP_BEGIN(VW, UMASK, KG, VG, PK, PV) { \
    unsigned long long rem_ = (UMASK); int cur_ = __builtin_ctzll(rem_); rem_ &= rem_ - 1ull; int bufi_ = 0; \
    TileRegs<VW> tr_; tile_issue<VW>(tr_, KG, VG, PK, PV, cur_ * 64, tid); tile_commit<VW>(tr_, lds, tid); __syncthreads(); \
    for (;;) { const int nxt_ = rem_ ? __builtin_ctzll(rem_) : -1; if (rem_) rem_ &= rem_ - 1ull; \
        if (nxt_ >= 0) tile_issue<VW>(tr_, KG, VG, PK, PV, nxt_ * 64, tid); \
        { const int kt = cur_; LAS char* st = lds + bufi_ * ATT_STP;
#define TILE_LOOP_END(VW) } \
        if (nxt_ >= 0) tile_commit<VW>(tr_, lds + (bufi_ ^ 1) * ATT_STP, tid); \
        __syncthreads(); if (nxt_ < 0) break; cur_ = nxt_; bufi_ ^= 1; } }

#define PP_BAR() do { asm volatile("s_waitcnt lgkmcnt(0)" ::: "memory"); __builtin_amdgcn_s_barrier(); asm volatile("" ::: "memory"); } while (0)
#define PP_NEXT(t) do { if (rem_) { t = __builtin_ctzll(rem_); rem_ &= rem_ - 1ull; } else t = -1; } while (0)
#define PP_WAITV(NI, c2, c3) do { if ((c2) && (c3)) { if (NI == 3) asm volatile("s_waitcnt vmcnt(6)" ::: "memory"); else asm volatile("s_waitcnt vmcnt(4)" ::: "memory"); } \
    else if ((c2) || (c3)) { if (NI == 3) asm volatile("s_waitcnt vmcnt(3)" ::: "memory"); else asm volatile("s_waitcnt vmcnt(2)" ::: "memory"); } \
    else asm volatile("s_waitcnt vmcnt(0)" ::: "memory"); } while (0)
#define PP_BEGIN(VW, NI, UMASK, KG, VG, PK, PV) { \
    unsigned long long rem_ = (UMASK); int ta_, tb_, tc_, td_ = -1; PP_NEXT(ta_); PP_NEXT(tb_); PP_NEXT(tc_); int sj_ = 0; \
    dma_tile<VW>(lds, KG, VG, PK, PV, ta_ * 64, lane, wid); \
    if (tb_ >= 0) dma_tile<VW>(lds + ATT_ST, KG, VG, PK, PV, tb_ * 64, lane, wid); \
    if (tc_ >= 0) dma_tile<VW>(lds + 2 * ATT_ST, KG, VG, PK, PV, tc_ * 64, lane, wid); \
    PP_WAITV(NI, tb_ >= 0, tc_ >= 0); PP_BAR(); \
    for (;;) { const int kt = ta_; LAS char* st = lds + sj_ * ATT_ST; \
        if (false) { PP_NEXT(td_); if (td_ >= 0) dma_tile<VW>(lds + ((sj_ + 3) & 3) * ATT_ST, KG, VG, PK, PV, td_ * 64, lane, wid); } {
#define PP_MID(VW, NI, KG, VG, PK, PV) } \
        if (true) { PP_NEXT(td_); if (td_ >= 0) dma_tile<VW>(lds + ((sj_ + 3) & 3) * ATT_ST, KG, VG, PK, PV, td_ * 64, lane, wid); } {
#define PP_END(NI) } if (true) PP_WAITV(NI, tc_ >= 0, td_ >= 0); PP_BAR(); \
        if (tb_ < 0) break; ta_ = tb_; tb_ = tc_; tc_ = td_; td_ = -1; sj_ = (sj_ + 1) & 3; } \
    }

__device__ __forceinline__ void diff_attn_phase(LAS char* lds, const bf16_t* QKV, bf16_t* O, const float* rel_bias, const float* lam_p, const float* subln, int layer, float* stash, int G, int c) {
    constexpr int ATT_ST = 24576;
    int tid_ = threadIdx.x; asm volatile("" : "+v"(tid_));
    const int tid = tid_, lane = tid & 63, wid = __builtin_amdgcn_readfirstlane(tid >> 6), r32 = lane & 31, hh = lane >> 5;
    if (wid >= 4) __builtin_amdgcn_s_setprio(1);
    float s1 = 0.f, s2 = 0.f;
    for (int i = 0; i < 64; ++i) { s1 += lam_p[i] * lam_p[64 + i]; s2 += lam_p[128 + i] * lam_p[192 + i]; }
    const float lam_init = 0.8f - 0.6f * expf(-0.3f * (float)layer);
    const float lam = expf(s1) - expf(s2) + lam_init;
    LAS float* bt = (LAS float*)(lds + ATT_BT);
    size_t pq_ = 64, pv2_ = 128; asm volatile("" : "+s"(pq_), "+s"(pv2_));
    f32x4* mystash = (f32x4*)stash + (size_t)(wid * 64 + lane) * 16;
    for (int it = 0;; ++it) {
        int bh, qb;
        if (G == 256) { if (it >= 4) break; const int j = c >> 6; bh = c & 63; qb = it == 0 ? 15 - j : it == 1 ? 8 + j : it == 2 ? 7 - j : j; }
        else { const int id = it * G + c; if (id >= 1024) break; bh = id & 63; qb = 15 - (id >> 6); }
        const int b = bh >> 3, h = bh & 7, q0 = qb * 256; const size_t rowbase = (size_t)b * T;
        const int qw = q0 + wid * 32, qpos = qw + r32;
        const int NT = (q0 + 256) / 64;
        const unsigned long long um = NT >= 64 ? ~0ull : ((1ull << NT) - 1ull);
        for (int mp = 0; mp < 2; ++mp) {
            if (tid < 128) bt[tid] = (rel_bias[t5_bucket(tid) * 16 + h * 2 + mp] - rel_bias[31 * 16 + h * 2 + mp]) * LOG2E;
            LAS char* Qs = lds + ATT_IMP + wid * 4096;
            { const bf16_t* qp = QKV + (rowbase + qpos) * 1024 + h * 128 + mp * 64 + hh * 8;
#pragma unroll
              for (int kk = 0; kk < 4; ++kk) *(LAS bf16x8*)(Qs + kk * 1024 + lane * 16) = *(const bf16x8*)(qp + kk * 16); }
            f32x16 o[4]; o[0] = f32x16{}; o[1] = f32x16{}; o[2] = f32x16{}; o[3] = f32x16{};
            float m = -1e30f, l = 0.f;
            const bf16_t* Kg = QKV + (size_t)M * 1024 + (size_t)((b * 8 + h) * 2 + mp) * T * 64;
            const bf16_t* Vg = QKV + (size_t)2 * M * 1024 + (size_t)(b * 8 + h) * T * 128;
            bf16x8 P[4];
            PP_BEGIN(2, 3, um, Kg, Vg, pq_, pv2_)
                const int k0 = kt * 64;
                if (k0 <= qw + 31) {
                    f32x16 sa, sb; qk_tile_sw<false>(sa, sb, nullptr, Qs, st, lane);
                    if (qw - (k0 + 63) < 113) score_elem<true>(sa, sb, qpos - k0 - hh * 4, 1 << 30, bt);
                    softmax_step<4>(sa, sb, m, l, o, P, true);
                    pv_tile_sw<4, 256>(o, P, st + 8192, lane);
                }
            PP_MID(2, 3, Kg, Vg, pq_, pv2_)
            PP_END(3)
            const float lt = pair_sum(l); const float inv = __builtin_amdgcn_rcpf(lt);
            if (mp == 0) {
#pragma unroll
                for (int cc = 0; cc < 4; ++cc)
#pragma unroll
                    for (int g4 = 0; g4 < 4; ++g4) mystash[cc * 4 + g4] = (f32x4){o[cc][g4 * 4] * inv, o[cc][g4 * 4 + 1] * inv, o[cc][g4 * 4 + 2] * inv, o[cc][g4 * 4 + 3] * inv};
            } else {
                float ss = 0.f;
#pragma unroll
                for (int cc = 0; cc < 4; ++cc)
#pragma unroll
                    for (int g4 = 0; g4 < 4; ++g4) { const f32x4 a = mystash[cc * 4 + g4];
#pragma unroll
                        for (int e = 0; e < 4; ++e) { const float v = a[e] - lam * (o[cc][g4 * 4 + e] * inv); o[cc][g4 * 4 + e] = v; ss += v * v; }
                        if (g4 == 3) __builtin_amdgcn_sched_barrier(0); }
                ss = pair_sum(ss);
                const float rs = rsqrtf(ss * (1.f / 128.f) + NORM_EPS) * (1.f - lam_init);
                bf16_t* op = O + (rowbase + qpos) * D + h * 128 + hh * 4;
#pragma unroll
                for (int cc = 0; cc < 4; ++cc)
#pragma unroll
                    for (int g4 = 0; g4 < 4; ++g4) { const int dv = cc * 32 + g4 * 8; const f32x4 sg = *(const f32x4*)(subln + dv + hh * 4);
                        u32x2 w; w.x = cvtpk(o[cc][g4 * 4] * rs * sg[0], o[cc][g4 * 4 + 1] * rs * sg[1]); w.y = cvtpk(o[cc][g4 * 4 + 2] * rs * sg[2], o[cc][g4 * 4 + 3] * rs * sg[3]);
                        *(u32x2*)(op + dv) = w; if (g4 == 3) __builtin_amdgcn_sched_barrier(0); }
            }
        }
    }
    __builtin_amdgcn_s_setprio(0);
}

__device__ __forceinline__ void nsa_phase(LAS char* lds, const bf16_t* PROJ, const bf16_t* KVB, const bf16_t* CMP, bf16_t* O, const float* rel_bias, int G, int c) {
    constexpr int ATT_ST = 16384, ATT_STP = ATT_STAGE_NSA;
    int tid_ = threadIdx.x; asm volatile("" : "+v"(tid_));
    const int tid0_ = tid_; const int tid = tid_, lane = tid & 63, wid = __builtin_amdgcn_readfirstlane(tid >> 6), r32 = lane & 31, hh = lane >> 5;
    const int r = wid & 3, qh = wid >> 2;
    if (wid >= 4) __builtin_amdgcn_s_setprio(1);
    LAS float* btall = (LAS float*)(lds + ATT_BT);
    size_t pkv_ = 64, pc_ = 64; asm volatile("" : "+s"(pkv_), "+s"(pc_));
    LAS float* bt = btall + r * 128;
    LAS unsigned long long* SEL = (LAS unsigned long long*)(lds + ATT_SEL);
    LAS unsigned* UM = (LAS unsigned*)(lds + ATT_UM);
    LAS float* IMP = (LAS float*)(lds + ATT_IMP);
    for (int it = 0;; ++it) {
        int bg, qblk;
        if (G == 256) { if (it >= 8) break; const int j = c >> 5; bg = c & 31; qblk = (it & 1) ? (56 - 8 * it + j) : (63 - 8 * it - j); }
        else { const int id = it * G + c; if (id >= 2048) break; bg = id & 31; qblk = 63 - (id >> 5); }
        const int b = bg >> 2, g = bg & 3, t0 = qblk * 64, hq = g * 4 + r; const size_t rowbase = (size_t)b * T;
        const int qw = t0 + qh * 32, qpos = qw + r32;
        btall[tid] = (rel_bias[t5_bucket(tid & 127) * 16 + g * 4 + (tid >> 7)] - rel_bias[31 * 16 + g * 4 + (tid >> 7)]) * LOG2E;
        LAS float* impr = IMP + (r * 64 + qh * 32 + r32) * 65;
        for (int jj = 0; jj < 33; ++jj) { const int idx = 2 * jj + hh; if (idx < 65) impr[idx] = 0.f; }
        if (tid < 2) UM[tid] = 0u;
        bf16x8 qf[4]; float gate[3];
        { const bf16_t* pp = PROJ + (rowbase + qpos) * NBINP;
#pragma unroll
          for (int kk = 0; kk < 4; ++kk) qf[kk] = *(const bf16x8*)(pp + hq * 64 + kk * 16 + hh * 8);
#pragma unroll
          for (int e = 0; e < 3; ++e) gate[e] = __builtin_amdgcn_rcpf(1.f + __expf(-bf2f(pp[1024 + hq * 3 + e]))); }
        f32x16 ot[2]; ot[0] = f32x16{}; ot[1] = f32x16{};
        const int nmaxb = (t0 + 32) >> 4; const int nct = min(4, (nmaxb >> 6) + 1);
        const unsigned long long umc = (1ull << nct) - 1ull;
        const bf16_t* Kc = CMP + (size_t)((0 * 8 + b) * 4 + g) * 256 * 64;
        const bf16_t* Vc = CMP + (size_t)((1 * 8 + b) * 4 + g) * 256 * 64;
        const int nlim = min((qpos - 31) >> 4, 254);
        float mc = -1e30f, lc = 0.f;
        { int tid = tid0_; asm volatile("" : "+v"(tid)); const int lane = tid & 63, r32 = lane & 31, hh = lane >> 5; (void)r32; (void)hh;
        TILE_LOOP_BEGIN(1, umc, Kc, Vc, pc_, pc_)
            f32x16 sa, sb; qk_tile(sa, sb, qf, st + ATT_K0, lane);
            score_elem<false>(sa, sb, nlim - kt * 64 - hh * 4, 1 << 30, bt);
            const float mx = row_max32(sa, sb); const float mn = fmaxf(mc, mx);
            lc *= __builtin_amdgcn_exp2f(mc - mn); mc = mn;
            float sum = 0.f;
#pragma unroll
            for (int i = 0; i < 16; ++i) sum += __builtin_amdgcn_exp2f(sa[i] - mc) + __builtin_amdgcn_exp2f(sb[i] - mc);
            lc += sum;
        TILE_LOOP_END(1) }
        {
            const float lt = pair_sum(lc); const float invl = lt > 0.f ? __builtin_amdgcn_rcpf(lt) : 0.f;
            f32x16 oc[2]; oc[0] = f32x16{}; oc[1] = f32x16{};
            int tid = tid0_; asm volatile("" : "+v"(tid)); const int lane = tid & 63, r32 = lane & 31, hh = lane >> 5; (void)r32; (void)hh;
            LAS float* impr = IMP + (r * 64 + qh * 32 + r32) * 65;
            TILE_LOOP_BEGIN(1, umc, Kc, Vc, pc_, pc_)
                f32x16 sa, sb; qk_tile(sa, sb, qf, st + ATT_K0, lane);
                score_elem<false>(sa, sb, nlim - kt * 64 - hh * 4, 1 << 30, bt);
#pragma unroll
                for (int i = 0; i < 16; ++i) { sa[i] = __builtin_amdgcn_exp2f(sa[i] - mc) * invl; sb[i] = __builtin_amdgcn_exp2f(sb[i] - mc) * invl; }
#pragma unroll
                for (int kb = 0; kb < 2; ++kb)
#pragma unroll
                    for (int ig = 0; ig < 4; ++ig) { const int j = kt * 16 + kb * 8 + ig * 2 + hh;
                        const float g4 = kb ? ((sb[ig * 4] + sb[ig * 4 + 1]) + (sb[ig * 4 + 2] + sb[ig * 4 + 3])) : ((sa[ig * 4] + sa[ig * 4 + 1]) + (sa[ig * 4 + 2] + sa[ig * 4 + 3]));
                        impr[j] += g4; }
                asm volatile("s_waitcnt lgkmcnt(0)" ::: "memory");
#pragma unroll
                for (int kb = 0; kb < 2; ++kb)
#pragma unroll
                    for (int ig = 0; ig < 4; ++ig) { const int j = kt * 16 + kb * 8 + ig * 2 + hh;
                        impr[j + 1] += kb ? sb[ig * 4 + 3] : sa[ig * 4 + 3]; }
                asm volatile("s_waitcnt lgkmcnt(0)" ::: "memory");
                bf16x8 P[4];
                { u32x4 w0 = {cvtpk(sa[0], sa[1]), cvtpk(sa[2], sa[3]), cvtpk(sa[4], sa[5]), cvtpk(sa[6], sa[7])};
                  u32x4 w1 = {cvtpk(sa[8], sa[9]), cvtpk(sa[10], sa[11]), cvtpk(sa[12], sa[13]), cvtpk(sa[14], sa[15])};
                  u32x4 w2 = {cvtpk(sb[0], sb[1]), cvtpk(sb[2], sb[3]), cvtpk(sb[4], sb[5]), cvtpk(sb[6], sb[7])};
                  u32x4 w3 = {cvtpk(sb[8], sb[9]), cvtpk(sb[10], sb[11]), cvtpk(sb[12], sb[13]), cvtpk(sb[14], sb[15])};
                  P[0] = __builtin_bit_cast(bf16x8, w0); P[1] = __builtin_bit_cast(bf16x8, w1); P[2] = __builtin_bit_cast(bf16x8, w2); P[3] = __builtin_bit_cast(bf16x8, w3); }
                pv_tile<2, VP64>(oc, P, st + ATT_V0, lane);
            TILE_LOOP_END(1)
            ot[0] = oc[0] * gate[0]; ot[1] = oc[1] * gate[0];
        }
        {
            unsigned long long wun = 0ull;
            int tid = tid0_; asm volatile("" : "+v"(tid)); const int lane = tid & 63, r32 = lane & 31, hh = lane >> 5; (void)r32; (void)hh;
            if (qblk < 16) {
                const unsigned long long mk = (2ull << qblk) - 1ull;
                if (lane < 8) SEL[wid * 8 + lane] = mk;
                wun = mk;
            } else
#pragma unroll 1
            for (int k = 0; k < 8; ++k) {
                const int q = wid * 8 + k;
                float v = ((IMP[(0 * 64 + q) * 65 + lane] + IMP[(1 * 64 + q) * 65 + lane]) + IMP[(2 * 64 + q) * 65 + lane]) + IMP[(3 * 64 + q) * 65 + lane];
                if (lane == 0 || lane == qblk || lane == qblk - 1) v = 1e4f;
                if (lane > qblk) v = -1e30f;
                int rank = 0; const int vi = __builtin_bit_cast(int, v);
#pragma unroll 8
                for (int jj = 0; jj < 64; ++jj) { const float vj = __builtin_bit_cast(float, __builtin_amdgcn_readlane(vi, jj)); rank += (vj > v || (vj == v && jj < lane)) ? 1 : 0; }
                const unsigned long long mk = __builtin_amdgcn_ballot_w64(rank < 16 && lane <= qblk);
                if (lane == 0) SEL[q] = mk;
                wun |= mk;
            }
            if (lane == 0) { atomicOr((unsigned*)&UM[0], (unsigned)wun); atomicOr((unsigned*)&UM[1], (unsigned)(wun >> 32)); }
            __syncthreads();
        }
        {
            int tid = tid0_; asm volatile("" : "+v"(tid)); const int lane = tid & 63, r32 = lane & 31, hh = lane >> 5; (void)r32; (void)hh;
            const unsigned long long ums = (unsigned long long)UM[0] | ((unsigned long long)UM[1] << 32);
            const unsigned long long mysel = SEL[qh * 32 + r32];
            f32x16 o[2]; o[0] = f32x16{}; o[1] = f32x16{};
            float m = -1e30f, l = 0.f;
            const bf16_t* Kg = KVB + (size_t)((2 * 8 + b) * 4 + g) * T * 64;
            const bf16_t* Vg = KVB + (size_t)((3 * 8 + b) * 4 + g) * T * 64;
            bf16x8 P[4];
            PP_BEGIN(1, 2, ums, Kg, Vg, pkv_, pkv_)
                const bool sel = (mysel >> kt) & 1ull;
                const int k0 = kt * 64;
                f32x16 sa, sb; qk_tile_sw<true>(sa, sb, qf, nullptr, st, lane);
                if (qw - (k0 + 63) < 113) score_elem<true>(sa, sb, qpos - k0 - hh * 4, 1 << 30, bt);
                softmax_step<2>(sa, sb, m, l, o, P, sel);
            PP_MID(1, 2, Kg, Vg, pkv_, pkv_)
                pv_tile_sw<2, 128>(o, P, st + 8192, lane);
            PP_END(2)
            const float lt = pair_sum(l); const float sc = gate[1] * __builtin_amdgcn_rcpf(lt);
            ot[0] += o[0] * sc; ot[1] += o[1] * sc;
        }
        {
            int tid = tid0_; asm volatile("" : "+v"(tid)); const int lane = tid & 63, r32 = lane & 31, hh = lane >> 5; (void)r32; (void)hh;
            const int lo = max(0, qblk - 8);
            const unsigned long long hiM = qblk >= 63 ? ~0ull : ((1ull << (qblk + 1)) - 1ull);
            const unsigned long long umw = hiM & ~((1ull << lo) - 1ull);
            f32x16 o[2]; o[0] = f32x16{}; o[1] = f32x16{};
            float m = -1e30f, l = 0.f;
            const bf16_t* Kg = KVB + (size_t)((4 * 8 + b) * 4 + g) * T * 64;
            const bf16_t* Vg = KVB + (size_t)((5 * 8 + b) * 4 + g) * T * 64;
            bf16x8 P[4];
            PP_BEGIN(1, 2, umw, Kg, Vg, pkv_, pkv_)
                const int k0 = kt * 64;
                f32x16 sa, sb; qk_tile_sw<true>(sa, sb, qf, nullptr, st, lane);
                if (qw - (k0 + 63) < 113 || qw + 31 - k0 >= 512) score_elem<true>(sa, sb, qpos - k0 - hh * 4, 512, bt);
                softmax_step<2>(sa, sb, m, l, o, P, true);
            PP_MID(1, 2, Kg, Vg, pkv_, pkv_)
                pv_tile_sw<2, 128>(o, P, st + 8192, lane);
            PP_END(2)
            const float lt = pair_sum(l); const float sc = gate[2] * __builtin_amdgcn_rcpf(lt);
            ot[0] += o[0] * sc; ot[1] += o[1] * sc;
        }
        { int tid = tid0_; asm volatile("" : "+v"(tid)); const int lane = tid & 63, r32 = lane & 31, hh = lane >> 5; (void)r32; (void)hh;
          bf16_t* op = O + (rowbase + qpos) * D + hq * 64 + hh * 4;
#pragma unroll
          for (int cc = 0; cc < 2; ++cc)
#pragma unroll
              for (int g4 = 0; g4 < 4; ++g4) { u32x2 w; w.x = cvtpk(ot[cc][g4 * 4], ot[cc][g4 * 4 + 1]); w.y = cvtpk(ot[cc][g4 * 4 + 2], ot[cc][g4 * 4 + 3]);
                  *(u32x2*)(op + cc * 32 + g4 * 8) = w; } }
    }
    __builtin_amdgcn_s_setprio(0);
}

#define XB_TMO      128
#define XB_XCNT(j)  (256  + 64 * (j))
#define XB_XSUB(j)  (1280 + 64 * (j))
#define XB_XGEN(j)  (2304 + 64 * (j))
#define XB_TOP      3328
#define XB_TOPGEN   3392
#define XCD_BAR_WORDS 3456
#define XB_SPIN_CAP (1u << 18)

__device__ __forceinline__ unsigned xb_ld(unsigned* p)              { return __hip_atomic_load(p, __ATOMIC_RELAXED, __HIP_MEMORY_SCOPE_AGENT); }
__device__ __forceinline__ unsigned xb_add(unsigned* p, unsigned v) { return __hip_atomic_fetch_add(p, v, __ATOMIC_RELAXED, __HIP_MEMORY_SCOPE_AGENT); }
__device__ __forceinline__ unsigned xb_xcc_id() { return (unsigned)__builtin_amdgcn_s_getreg((3 << 11) | 20) & 0xFu; }
#define XB_SPIN(cond, bar) do { unsigned _sp = 0; while (cond) { __builtin_amdgcn_s_sleep(1); \
    if ((++_sp & 255u) == 0u) { if (xb_ld(&(bar)[XB_TMO])) break; if (_sp > XB_SPIN_CAP) { atomicAdd(&(bar)[XB_TMO], 1u); break; } } } } while (0)

struct XcdBarrier {
    unsigned* bar; unsigned x;
    volatile LAS unsigned* st;
};

__device__ __forceinline__ XcdBarrier xcd_barrier_post(unsigned* bar, volatile LAS unsigned* st) {
    XcdBarrier b; b.bar = bar; b.x = xb_xcc_id(); b.st = st;
    if (threadIdx.x == 0) (void)xb_add(&bar[XB_XCNT(b.x)], 1u);
    return b;
}
__device__ __forceinline__ void xcd_barrier_complete(unsigned* bar, unsigned x, unsigned& nloc, unsigned& nx) {
    const unsigned G = gridDim.x * gridDim.y * gridDim.z;
    unsigned sum, cnt, mine, sp = 0u;
    for (;;) {
        sum = 0u; cnt = 0u; mine = 0u;
#pragma unroll
        for (unsigned j = 0; j < 16; ++j) { const unsigned c = xb_ld(&bar[XB_XCNT(j)]); sum += c; cnt += (c > 0u) ? 1u : 0u; mine = (j == x) ? c : mine; }
        if (sum == G) break;
        __builtin_amdgcn_s_sleep(1);
        if ((++sp & 255u) == 0u) { if (xb_ld(&bar[XB_TMO])) break; if (sp > XB_SPIN_CAP) { atomicAdd(&bar[XB_TMO], 1u); break; } }
    }
    nloc = mine > 0u ? mine : 1u; nx = cnt > 0u ? cnt : 1u;
}

__device__ __forceinline__ void xcd_barrier(const XcdBarrier& b) {
    asm volatile("s_waitcnt vmcnt(0)" ::: "memory");
    __syncthreads();
    if (threadIdx.x == 0) {
        unsigned* bar = b.bar;
        __builtin_amdgcn_s_waitcnt(0);
        unsigned nloc = b.st[0], nx = b.st[1];
        if (nloc == 0u) { xcd_barrier_complete(bar, b.x, nloc, nx); b.st[0] = nloc; b.st[1] = nx; }
        const unsigned old = xb_add(&bar[XB_XSUB(b.x)], 1u);
        const unsigned gen = old / nloc;
        if (old + 1u == (gen + 1u) * nloc) {
            __builtin_amdgcn_fence(__ATOMIC_RELEASE, "agent");
            asm volatile("s_waitcnt vmcnt(0)" ::: "memory");
            const unsigned og = xb_add(&bar[XB_TOP], 1u);
            const unsigned tg = og / nx;
            if (og + 1u == (tg + 1u) * nx) xb_add(&bar[XB_TOPGEN], 1u);
            else XB_SPIN(xb_ld(&bar[XB_TOPGEN]) == tg, bar);
            __builtin_amdgcn_fence(__ATOMIC_ACQUIRE, "agent");
            xb_add(&bar[XB_XGEN(b.x)], 1u);
            asm volatile("s_waitcnt vmcnt(0)" ::: "memory");
        } else {
            XB_SPIN(xb_ld(&bar[XB_XGEN(b.x)]) == gen, bar);
            __builtin_amdgcn_fence(__ATOMIC_ACQUIRE, "agent");
            asm volatile("s_waitcnt vmcnt(0)" ::: "memory");
        }
    }
    __syncthreads();
}

__global__ void __launch_bounds__(512, 2) mk_fwd(Params p) {
    extern __shared__ __attribute__((aligned(16))) unsigned char lds_raw[];
    LAS unsigned char* lds = (LAS unsigned char*)lds_raw;
    volatile LAS unsigned* bar_st = (volatile LAS unsigned*)(lds + LDS_BARST);
    if (threadIdx.x < 2) bar_st[threadIdx.x] = 0u;
    __syncthreads();
    (void)xcd_barrier_post((unsigned*)(p.ws + WS_BAR), bar_st);
    typedef const char __attribute__((address_space(4)))* kaptr_t;
    for (int step = p.step_lo; step < p.step_hi; ++step) {
        kaptr_t ka = (kaptr_t)__builtin_amdgcn_kernarg_segment_ptr();
        asm volatile("" : "+s"(ka));
        int tid_ = threadIdx.x; asm volatile("" : "+v"(tid_));
        int c_ = blockIdx.x; asm volatile("" : "+s"(c_));
        int G_ = gridDim.x; asm volatile("" : "+s"(G_));
        const int tid = tid_, lane = tid & 63, wave = __builtin_amdgcn_readfirstlane(tid >> 6);
        const int G = G_, c = c_;
        const int gw = c * 8 + wave, NGW = G * 8;
#define PIN(i) (*(const float* const __attribute__((address_space(4)))*)(ka + 8 * (i)))
        unsigned char* ws = *(unsigned char* const __attribute__((address_space(4)))*)(ka + 8 * 24);
        const float* x_in = PIN(0);
        float* xres = *(float* const __attribute__((address_space(4)))*)(ka + 8 * 23);
        float* mod = (float*)(ws + WS_MOD);
        float* kvmod = (float*)(ws + WS_KVMOD);
        bf16_t* XN = (bf16_t*)(ws + WS_XN);
        bf16_t* BIG = (bf16_t*)(ws + WS_BIG);
        bf16_t* HID = (bf16_t*)(ws + WS_HID);
        bf16_t* KVB = (bf16_t*)(ws + WS_KV);
        bf16_t* CMP = (bf16_t*)(ws + WS_CMP);
        int kind, layer = 0, sub = 0;
        int es = step;
#ifdef DUP_CLASS
        {
            int s = 0, e = 0;
            for (e = 0; e < 43; ++e) {
                int k2, l2 = 0, s2 = 0;
                if (e == 0) k2 = 0; else if (e <= 18) { k2 = 1; l2 = (e - 1) / 9; s2 = (e - 1) % 9; } else if (e <= 23) { k2 = 2; s2 = e - 19; } else if (e <= 41) { k2 = 1; l2 = 2 + (e - 24) / 9; s2 = (e - 24) % 9; } else k2 = 3;
                const bool d = (DUP_CLASS == 1 && k2 == 1 && s2 == 2 && l2 < 2) || (DUP_CLASS == 2 && k2 == 1 && s2 == 2 && l2 >= 2) ||
                               (DUP_CLASS == 3 && k2 == 1 && (s2 == 5 || s2 == 7)) || (DUP_CLASS == 4 && ((k2 == 1 && (s2 == 0 || s2 == 4)) || (k2 == 2 && s2 == 0))) ||
                               (DUP_CLASS == 5 && k2 == 1 && s2 == 1) || (DUP_CLASS == 6 && k2 == 0) || (DUP_CLASS == 7 && k2 == 2);
                if (s == step) break; ++s; if (d) { if (s == step) break; ++s; }
            }
            es = e;
        }
#endif
        if (es == 0) kind = 0;
        else if (es <= 18) { kind = 1; layer = (es - 1) / 9; sub = (es - 1) % 9; }
        else if (es <= 23) { kind = 2; sub = es - 19; }
        else if (es <= 41) { kind = 1; layer = 2 + (es - 24) / 9; sub = (es - 24) % 9; }
        else kind = 3;

        int gwn = gw, ngwn = NGW;
        if (G > 128) {
            if (kind == 1 && layer == 2 && sub == 0) continue;
            if (kind == 2 && sub == 3 && c >= 64) { kind = 1; layer = 2; sub = 0; gwn = (c - 64) * 8 + wave; ngwn = (G - 64) * 8; }
        }
        if (kind == 0) {
            {
                LAS float* scr = (LAS float*)(lds + wave * 16384);
                for (int it = gw;; it += NGW) {
                    int rr = it; const float* src; bf16_t* dst; int K, Ns;
                    if (rr < 2 * 1536) { const int l = rr / 1536; rr %= 1536; src = PIN(9) + (size_t)l * D * NQKV; dst = (bf16_t*)(ws + WS_WQKV) + (size_t)l * NQKV * D; K = D; Ns = NQKV; }
                    else if ((rr -= 3072) < 2 * 512) { const int l = rr / 512; rr %= 512; src = PIN(10) + (size_t)l * D * D; dst = (bf16_t*)(ws + WS_WAO) + (size_t)l * D * D; K = D; Ns = D; }
                    else if ((rr -= 1024) < 4 * 2048) { const int l = rr / 2048; rr %= 2048; src = PIN(7) + (size_t)l * D * FF; dst = (bf16_t*)(ws + WS_W1) + (size_t)l * D * FF; K = D; Ns = FF; }
                    else if ((rr -= 8192) < 4 * 2048) { const int l = rr / 2048; rr %= 2048; src = PIN(8) + (size_t)l * D * FF; dst = (bf16_t*)(ws + WS_W2) + (size_t)l * D * FF; K = FF; Ns = D; }
                    else if ((rr -= 8192) < 768) { src = PIN(16); dst = (bf16_t*)(ws + WS_WKV); K = D; Ns = NKV; }
                    else if ((rr -= 768) < 2 * 544) { const int l = rr / 544; rr %= 544; src = PIN(20) + (size_t)l * D * NBIN; dst = (bf16_t*)(ws + WS_WBIN) + (size_t)l * NBINP * D; K = D; Ns = NBIN; }
                    else if ((rr -= 1088) < 2 * 512) { const int l = rr / 512; rr %= 512; src = PIN(21) + (size_t)l * D * D; dst = (bf16_t*)(ws + WS_WBO) + (size_t)l * D * D; K = D; Ns = D; }
                    else if ((rr -= 1024) < 2 * 256) { const int l = rr / 256; rr %= 256; src = PIN(18) + (size_t)l * 2048 * 256; dst = (bf16_t*)(ws + WS_WC1) + (size_t)l * 256 * 2048; K = 2048; Ns = 256; }
                    else break;
                    transpose_item(src, K, Ns, dst, scr, rr, lane);
                }
                { unsigned z_ = 0u; asm volatile("" : "+v"(z_));
                for (int i = c * 512 + tid; i < 2 * 192 * 1024 / 8; i += G * 512) { const int l = i / (192 * 128), rem = i % (192 * 128);
                    *(u32x4*)((bf16_t*)(ws + WS_WBIN) + (size_t)l * NBINP * D + (size_t)1088 * D + (size_t)rem * 8) = (u32x4){z_, z_, z_, z_}; } }
            }
            __syncthreads();
            {
                LAS float* cact = (LAS float*)lds;
                LAS float* red = (LAS float*)(lds + 32768);
                for (int i = tid; i < 8192; i += 512) { const float v = PIN(1)[i]; cact[i] = v * __builtin_amdgcn_rcpf(1.f + __expf(-v)); }
                __syncthreads();
                for (int cgi = c; cgi < 416; cgi += G) {
                    const float* W; const float* bias; float* outp; int N, col0, ostride;
                    if (cgi < 384) { const int l = cgi / 96; col0 = (cgi % 96) * 64; W = PIN(3) + (size_t)l * D * 6144; N = 6144; bias = PIN(4) + l * 6144; outp = mod + (size_t)l * 8 * 6144; ostride = 6144; }
                    else { col0 = (cgi - 384) * 64; W = PIN(13); N = 2048; bias = PIN(14); outp = kvmod; ostride = 2048; }
                    float acc[8];
#pragma unroll
                    for (int b = 0; b < 8; ++b) acc[b] = 0.f;
                    const float* wp = W + (size_t)(wave * 128) * N + col0 + lane;
#pragma unroll 32
                    for (int k = 0; k < 128; ++k) { const float wv = wp[(size_t)k * N];
#pragma unroll
                        for (int b = 0; b < 8; ++b) acc[b] += cact[b * 1024 + wave * 128 + k] * wv; }
#pragma unroll
                    for (int b = 0; b < 8; ++b) red[(wave * 8 + b) * 64 + lane] = acc[b];
                    __syncthreads();
                    { const int b = tid >> 6; float s = 0.f;
#pragma unroll
                      for (int w = 0; w < 8; ++w) s += red[(w * 8 + b) * 64 + lane];
                      outp[(size_t)b * ostride + col0 + lane] = s + bias[col0 + lane]; }
                    __syncthreads();
                }
            }
        } else if (kind == 3 || (kind == 1 && (sub == 0 || sub == 4)) || (kind == 2 && sub == 0)) {
            const float* src = (kind == 1 && layer == 0 && sub == 0) ? x_in : xres;
            const float* gamma; const float* shift = nullptr; const float* scale = nullptr; int bstride = 0;
            if (kind == 3) gamma = PIN(22);
            else if (kind == 2) { gamma = PIN(15); shift = kvmod; scale = kvmod + 1024; bstride = 2048; }
            else if (sub == 0) { gamma = PIN(5) + layer * D; shift = mod + (size_t)layer * 8 * 6144; scale = shift + 1024; bstride = 6144; }
            else { gamma = PIN(6) + layer * D; shift = mod + (size_t)layer * 8 * 6144 + 3072; scale = shift + 1024; bstride = 6144; }
            int tid = tid_; asm volatile("" : "+v"(tid)); const int lane = tid & 63; (void)lane;
            for (int chunk = gwn; chunk < M / 16; chunk += ngwn) {
                const int row0 = chunk * 16, b = row0 / T;
                f32x4 A[4], Bv[4];
#pragma unroll
                for (int j = 0; j < 4; ++j) { const int col = 4 * lane + 256 * j; const f32x4 gm = *(const f32x4*)(gamma + col);
                    if (scale) { const f32x4 sc = *(const f32x4*)(scale + (size_t)b * bstride + col); A[j] = gm * (sc + 1.0f); Bv[j] = *(const f32x4*)(shift + (size_t)b * bstride + col); }
                    else { A[j] = gm; Bv[j] = (f32x4){0.f, 0.f, 0.f, 0.f}; } }
#pragma unroll 1
                for (int rq = 0; rq < 16; rq += 4) {
                    f32x4 v[4][4];
#pragma unroll
                    for (int r4 = 0; r4 < 4; ++r4)
#pragma unroll
                        for (int j = 0; j < 4; ++j) v[r4][j] = *(const f32x4*)(src + (size_t)(row0 + rq + r4) * D + 4 * lane + 256 * j);
#pragma unroll
                    for (int r4 = 0; r4 < 4; ++r4) {
                        const size_t ro = (size_t)(row0 + rq + r4) * D; float ss = 0.f;
#pragma unroll
                        for (int j = 0; j < 4; ++j) ss += (v[r4][j].x * v[r4][j].x + v[r4][j].y * v[r4][j].y) + (v[r4][j].z * v[r4][j].z + v[r4][j].w * v[r4][j].w);
                        const float rstd = rsqrtf(wave_sum(ss, lane) * (1.f / D) + NORM_EPS);
#pragma unroll
                        for (int j = 0; j < 4; ++j) { const f32x4 y = v[r4][j] * rstd * A[j] + Bv[j];
                            if (kind == 3) *(f32x4*)(xres + ro + 4 * lane + 256 * j) = y;
                            else { u32x2 w; w.x = cvtpk(y.x, y.y); w.y = cvtpk(y.z, y.w); *(u32x2*)(XN + ro + 4 * lane + 256 * j) = w; } }
                    }
                }
            }
        } else if (kind == 1 && sub == 2) {
#ifndef NO_DIFF
            if (layer < 2) diff_attn_phase((LAS char*)lds, BIG, XN, PIN(2), PIN(11) + layer * 256, PIN(12) + layer * 128, layer, (float*)(ws + WS_O1) + (size_t)c * 32768, G, c);
#endif
#ifndef NO_NSA
            if (layer >= 2) nsa_phase((LAS char*)lds, BIG, KVB, CMP, XN, PIN(2), G, c);
#endif
        } else if (kind == 2 && sub == 2) {
            int tid = tid_; asm volatile("" : "+v"(tid)); const int lane = tid & 63; (void)lane;
            for (size_t idx = (size_t)c * 512 + tid; idx < (size_t)16384 * 256; idx += (size_t)G * 512) {
                const int row = (int)(idx >> 8), c8 = (int)(idx & 255), l = c8 >> 3, d0 = (c8 & 7) * 8;
                const int n = row & 255, g = (row >> 8) & 3, b = (row >> 10) & 7, s = row >> 13;
                const int t = 16 * n + l;
                unsigned z_ = 0u; asm volatile("" : "+v"(z_));
                u32x4 o = {z_, z_, z_, z_};
                if (t < T) {
                    const u32x4 kv = *(const u32x4*)(KVB + ((size_t)((s * 8 + b) * 4 + g) * T + t) * 64 + d0);
                    const float* pp = PIN(17) + (s * 32 + l) * 64 + d0;
                    const f32x4 p0 = *(const f32x4*)pp, p1 = *(const f32x4*)(pp + 4);
                    o.x = cvtpk(bf2f((bf16_t)(kv.x & 0xffff)) + p0.x, bf2f((bf16_t)(kv.x >> 16)) + p0.y);
                    o.y = cvtpk(bf2f((bf16_t)(kv.y & 0xffff)) + p0.z, bf2f((bf16_t)(kv.y >> 16)) + p0.w);
                    o.z = cvtpk(bf2f((bf16_t)(kv.z & 0xffff)) + p1.x, bf2f((bf16_t)(kv.z >> 16)) + p1.y);
                    o.w = cvtpk(bf2f((bf16_t)(kv.w & 0xffff)) + p1.z, bf2f((bf16_t)(kv.w >> 16)) + p1.w);
                }
                *(u32x4*)(BIG + (size_t)row * 2048 + c8 * 8) = o;
            }
        } else if (kind == 2 && sub == 4) {
            int tid = tid_; asm volatile("" : "+v"(tid)); const int lane = tid & 63; (void)lane;
            for (int rg = gw; rg < 16384 / 8; rg += NGW) {
                const int row0 = rg * 8, s = row0 >> 13;
                const float* w2 = PIN(19) + (size_t)s * 256 * 64 + lane;
                float acc[8];
#pragma unroll
                for (int i = 0; i < 8; ++i) acc[i] = 0.f;
                for (int h = 0; h < 256; h += 2) {
                    const float wa = w2[(size_t)h * 64], wb = w2[(size_t)(h + 1) * 64];
#pragma unroll
                    for (int i = 0; i < 8; ++i) { const unsigned hv = *(const unsigned*)(HID + (size_t)(row0 + i) * 256 + h);
                        acc[i] += bf2f((bf16_t)(hv & 0xffff)) * wa + bf2f((bf16_t)(hv >> 16)) * wb; }
                }
#pragma unroll
                for (int i = 0; i < 8; ++i) CMP[(size_t)(row0 + i) * 64 + lane] = (bf16_t)f2bf(acc[i]);
            }
        } else {
            pg8::Gemm g; pg8::Sched S;
            bool resid = false; pg8::EpiStore ES{nullptr, 0, 0, 0, 0, 0}; pg8::EpiResid ER{nullptr, nullptr, nullptr, 0};
            if (kind == 2 && sub == 1) { g = pg8::Gemm{XN, (const bf16_t*)(ws + WS_WKV), M, NKV, D}; S.init(M, NKV, G, c, 0); ES = pg8::EpiStore{KVB, NKV, 0, 0, 0, 2}; }
            else if (kind == 2) { g = pg8::Gemm{BIG, (const bf16_t*)(ws + WS_WC1), 16384, 512, 2048}; S.init(16384, 512, G, c, 1); ES = pg8::EpiStore{HID, 256, 2, 1, 0, 0}; }
            else if (sub == 1) {
                if (layer < 2) { g = pg8::Gemm{XN, (const bf16_t*)(ws + WS_WQKV) + (size_t)layer * NQKV * D, M, NQKV, D}; S.init(M, NQKV, G, c, 0); ES = pg8::EpiStore{BIG, 1024, 0, 0, 1024, 1}; }
                else { g = pg8::Gemm{XN, (const bf16_t*)(ws + WS_WBIN) + (size_t)(layer - 2) * NBINP * D, M, NBINP, D}; S.init(M, NBINP, G, c, 0); ES = pg8::EpiStore{BIG, NBINP, 0, 0, 1024, 0}; }
            } else if (sub == 3) {
                const bf16_t* W = layer < 2 ? (const bf16_t*)(ws + WS_WAO) + (size_t)layer * D * D : (const bf16_t*)(ws + WS_WBO) + (size_t)(layer - 2) * D * D;
                g = pg8::Gemm{XN, W, M, D, D}; S.init(M, D, G, c, 0); resid = true;
                ER = pg8::EpiResid{layer == 0 ? x_in : xres, xres, mod + (size_t)layer * 8 * 6144 + 2048, 0};
            } else if (sub == 5 || sub == 7) {
                const int half = (sub - 5) / 2;
                g = pg8::Gemm{XN + (size_t)half * 16384 * D, (const bf16_t*)(ws + WS_W1) + (size_t)layer * D * FF, 16384, FF, D}; S.init(16384, FF, G, c, 0); ES = pg8::EpiStore{BIG, FF, 1, 0, 0, 0};
            } else {
                const int half = (sub - 6) / 2;
                g = pg8::Gemm{BIG, (const bf16_t*)(ws + WS_W2) + (size_t)layer * D * FF, 16384, D, FF}; S.init(16384, D, G, c, 0); resid = true;
                ER = pg8::EpiResid{xres, xres, mod + (size_t)layer * 8 * 6144 + 5120, half * 16384};
            }
#ifndef NO_GEMM
            if (resid) pg8::gemm_phase<pg8::EpiResid, pg8::Sched, true, true>(lds, g, S, ER);
            else pg8::gemm_phase<pg8::EpiStore, pg8::Sched, true, true>(lds, g, S, ES);
#endif
        }
        if (step + 1 < p.step_hi) {
#if USE_XCD_BAR
            if (p.step_hi < 0) cg::this_grid().sync();
            else { XcdBarrier xb; xb.bar = (unsigned*)(ws + WS_BAR); xb.x = xb_xcc_id(); xb.st = (volatile LAS unsigned*)(lds + LDS_BARST); xcd_barrier(xb); }
#else
            cg::this_grid().sync();
#endif
        }
    }
}

extern "C" void kernel_launch(void* const* d_in, const int* in_sizes, int n_in, void* d_out, int out_size, void* d_ws, size_t ws_size, hipStream_t stream) {
    static int grid = 0;
    if (grid == 0) {
        if (n_in != 23 || out_size != M * D || ws_size < WS_END) { fprintf(stderr, "kernel_launch: unexpected shapes (n_in %d out %d ws %zu)\n", n_in, out_size, ws_size); grid = -1; return; }
        int dev = 0, cus = 0, per_cu = 0;
        hipGetDevice(&dev);
        hipDeviceGetAttribute(&cus, hipDeviceAttributeMultiprocessorCount, dev);
        hipFuncSetAttribute((const void*)mk_fwd, hipFuncAttributeMaxDynamicSharedMemorySize, LDS_BYTES);
        if (hipOccupancyMaxActiveBlocksPerMultiprocessor(&per_cu, (const void*)mk_fwd, 512, LDS_BYTES) != hipSuccess || per_cu < 1) { fprintf(stderr, "kernel_launch: occupancy query says %d\n", per_cu); per_cu = 1; }
        (void)hipGetLastError();
        grid = cus;
    }
    if (grid < 0) return;
    hipMemsetAsync((char*)d_ws + WS_BAR, 0, 16384, stream);
    Params p{};
    for (int i = 0; i < 23; ++i) p.in[i] = (const float*)d_in[i];
    p.out = (float*)d_out; p.ws = (unsigned char*)d_ws; p.step_lo = 0; p.step_hi = 43 + NDUP;
    void* args[] = {&p};
    hipError_t e = hipLaunchCooperativeKernel((const void*)mk_fwd, dim3(grid), dim3(512), args, LDS_BYTES, stream);
    if (e != hipSuccess) fprintf(stderr, "cooperative launch failed: %s (grid %d)\n", hipGetErrorString(e), grid);
}
```

```cpp
#include <hip/hip_runtime.h>
#include <hip/hip_cooperative_groups.h>
#include <cstdio>
#include <cstdint>
namespace cg = cooperative_groups;

#ifndef NDUP
#define NDUP 0
#endif
#ifndef USE_XCD_BAR
#define USE_XCD_BAR 1
#endif

#define LAS __attribute__((address_space(3)))
typedef unsigned short bf16_t;
typedef short bf16x8 __attribute__((ext_vector_type(8)));
typedef short s16x4 __attribute__((ext_vector_type(4)));
typedef float f32x4 __attribute__((ext_vector_type(4)));
typedef float f32x16 __attribute__((ext_vector_type(16)));
typedef unsigned u32x4 __attribute__((ext_vector_type(4)));
typedef unsigned u32x2 __attribute__((ext_vector_type(2)));
typedef float f32x2_t __attribute__((ext_vector_type(2)));
typedef __bf16 bf16x2_t __attribute__((ext_vector_type(2)));

__device__ __forceinline__ unsigned cvtpk(float lo, float hi) { f32x2_t v = {lo, hi}; bf16x2_t b = __builtin_convertvector(v, bf16x2_t); return __builtin_bit_cast(unsigned, b); }
__device__ __forceinline__ float bf2f(bf16_t v) { return __builtin_bit_cast(float, (unsigned)v << 16); }

constexpr int BATCH = 8, T = 4096, D = 1024, M = BATCH * T, FF = 4096;
constexpr int NQKV = 3072, NKV = 1536, NBIN = 1072, NBINP = 1280;
constexpr float NORM_EPS = 1e-6f;
constexpr float LOG2E = 1.4426950408889634f;
constexpr float SC2 = 0.125f * LOG2E;

constexpr size_t MiB = 1u << 20;
constexpr size_t WS_MOD = 0;
constexpr size_t WS_KVMOD = 4 * 8 * 6144 * 4;
constexpr size_t WS_BAR = 1 * MiB;
constexpr size_t WS_WQKV = 2 * MiB;
constexpr size_t WS_WAO = 14 * MiB;
constexpr size_t WS_W1 = 18 * MiB;
constexpr size_t WS_W2 = 50 * MiB;
constexpr size_t WS_WKV = 82 * MiB;
constexpr size_t WS_WBIN = 85 * MiB;
constexpr size_t WS_WBO = 90 * MiB;
constexpr size_t WS_WC1 = 94 * MiB;
constexpr size_t WS_XN = 96 * MiB;
constexpr size_t WS_BIG = 160 * MiB;
constexpr size_t WS_HID = 224 * MiB;
constexpr size_t WS_KV = 416 * MiB;
constexpr size_t WS_CMP = 94 * MiB;
constexpr size_t WS_O1 = 416 * MiB;
constexpr size_t WS_KV01 = 288 * MiB;
constexpr size_t WS_END = 480 * MiB;

namespace pg8 {
#define PG8_LAS __attribute__((address_space(3)))
constexpr int BM = 256, BK = 64, HALF = 128, HTB = HALF * BK * 2, STAGE_BYTES = 8 * HTB, NXCD = 8, WGM = 8;
__host__ __device__ __forceinline__ int lds_byte(int r, int c) { const int st = (r >> 4) * 2 + (c >> 5), rr = r & 15, cc = c & 31, ob = rr * 64 + cc * 2; return st * 1024 + (ob ^ (((ob >> 9) & 1) << 5)); }
__host__ __device__ __forceinline__ void stage_rc(int b, int& R, int& C) { const int st = b / 1024, sb = b % 1024, swz = sb ^ (((sb >> 9) & 1) << 5); R = (st >> 1) * 16 + swz / 64; C = (st & 1) * 32 + (swz % 64) / 2; }
__host__ __device__ __forceinline__ int perm32(int rho) { const int n = rho >> 4, i = rho & 15; return 8 * (i >> 2) + 4 * n + (i & 3); }

struct Unit { int pm, pn; };
struct Gemm { const bf16_t* A; const bf16_t* Bt; int M, N, K; };

struct Sched {
    int nM, nN, nwg, G, c, mode;
    __device__ void init(int M_, int N_, int G_, int c_, int mode_) { nM = M_ / BM; nN = N_ / BM; nwg = mode_ ? nM : nM * nN; G = G_; c = c_; mode = mode_; }
    __device__ bool next(int i, Unit& u) const {
        const long L = (long)i * G + c; if (L >= nwg) return false;
        if (mode == 1) { u.pm = (int)L; u.pn = (int)L >> 5; return true; }
        int wgid = (int)L; { const int q = nwg / NXCD, r = nwg % NXCD, xcd = wgid % NXCD, off = wgid / NXCD; wgid = (xcd < r ? xcd * (q + 1) : r * (q + 1) + (xcd - r) * q) + off; }
        const int nig = WGM * nN, gid = wgid / nig, fm = gid * WGM, gsz = (nM - fm) < WGM ? (nM - fm) : WGM;
        u.pm = fm + ((wgid % nig) % gsz); u.pn = (wgid % nig) / gsz; return true;
    }
    __device__ __forceinline__ void a_ready(const Unit&) const {}
    __device__ __forceinline__ void done(const Unit&) const {}
};

__device__ __forceinline__ float act_fn(float v, int act) {
    if (act == 1) { const float r = fmaxf(v, 0.f); return r * r; }
    if (act == 2) { const float u = 0.7978845608028654f * (v + 0.044715f * v * v * v); return v * __builtin_amdgcn_rcpf(1.f + __expf(-2.f * u)); }
    return v;
}
struct EpiStore {
    static constexpr bool PERM = true, AFTER_DRAIN = false;
    bf16_t* O; int ldc; int act; int fold; int qcols; int mode; long alt;
    __device__ __forceinline__ void operator()(const f32x4 (&acc)[2][2][4][2], const Unit& u, int wr, int wc, int fr, int fq) const {
        const int row0 = u.pm * BM + wr * 64 + fr; const int colt = fold ? 0 : u.pn * BM; const int cw = wc * 32 + 8 * fq;
        const float qs = (u.pn * BM < qcols) ? 0.18033688011112042f : 1.0f;
        const int b = (u.pm * BM) / T, t0 = (u.pm * BM) % T + wr * 64 + fr;
        size_t base[2]; size_t rstride;
        if (mode == 1 && colt >= 1024) {
            if (colt < 2048) { rstride = 64;
#pragma unroll
                for (int bj = 0; bj < 2; ++bj) { const int hd = (colt - 1024) / 128 + bj; base[bj] = (size_t)M * 1024 + ((size_t)((b * 8 + hd) * 2 + (cw >> 6)) * T + t0) * 64 + (cw & 63); } }
            else { rstride = 128;
#pragma unroll
                for (int bj = 0; bj < 2; ++bj) { const int hd = (colt - 2048) / 128 + bj; base[bj] = (size_t)2 * M * 1024 + ((size_t)(b * 8 + hd) * T + t0) * 128 + cw; } }
        } else if (mode == 2) { rstride = 64;
#pragma unroll
            for (int bj = 0; bj < 2; ++bj) { const int c2 = bj * 128 + cw; const int s4 = u.pn < 2 ? u.pn : u.pn - 2;
                base[bj] = (size_t)((long)(((size_t)((s4 * 8 + b) * 4 + (c2 >> 6)) * T + t0) * 64 + (c2 & 63)) + (u.pn < 2 ? alt : 0l)); }
        } else { rstride = (size_t)ldc;
#pragma unroll
            for (int bj = 0; bj < 2; ++bj) base[bj] = (size_t)row0 * ldc + colt + cw + bj * HALF;
        }
#pragma unroll
        for (int ai = 0; ai < 2; ++ai)
#pragma unroll
            for (int m = 0; m < 4; ++m) { const size_t ro = (size_t)(ai * HALF + m * 16) * rstride;
#pragma unroll
                for (int bj = 0; bj < 2; ++bj) { f32x4 v0 = acc[ai][bj][m][0], v1 = acc[ai][bj][m][1];
                    if (act) {
#pragma unroll
                        for (int e = 0; e < 4; ++e) { v0[e] = act_fn(v0[e], act); v1[e] = act_fn(v1[e], act); } }
                    v0 = v0 * qs; v1 = v1 * qs;
                    u32x4 w; w.x = cvtpk(v0[0], v0[1]); w.y = cvtpk(v0[2], v0[3]); w.z = cvtpk(v1[0], v1[1]); w.w = cvtpk(v1[2], v1[3]);
                    *(u32x4*)(O + base[bj] + ro) = w; } }
    }
};
struct EpiResid {
    static constexpr bool PERM = false, AFTER_DRAIN = false;
    const float* base; float* out; const float* gate; int row_off;
    __device__ __forceinline__ void operator()(const f32x4 (&acc)[2][2][4][2], const Unit& u, int wr, int wc, int fr, int fq) const {
        const int rt = row_off + u.pm * BM; const int b = rt / T; const int row0 = rt + wr * 64 + fr; const int col0 = u.pn * BM + wc * 32 + 4 * fq;
        f32x4 gv[2][2];
#pragma unroll
        for (int bj = 0; bj < 2; ++bj)
#pragma unroll
            for (int n = 0; n < 2; ++n) gv[bj][n] = *(const f32x4*)(gate + (size_t)b * 6144 + col0 + bj * HALF + n * 16);
#pragma unroll
        for (int aim = 0; aim < 4; ++aim) { const int ai = aim >> 1, m0 = (aim & 1) * 2;
            f32x4 xin[2][2][2];
#pragma unroll
            for (int mm = 0; mm < 2; ++mm) { const size_t off = (size_t)(row0 + ai * HALF + (m0 + mm) * 16) * D + col0;
#pragma unroll
                for (int bj = 0; bj < 2; ++bj)
#pragma unroll
                    for (int n = 0; n < 2; ++n) xin[mm][bj][n] = *(const f32x4*)(base + off + bj * HALF + n * 16); }
            asm volatile("" ::: "memory");
#pragma unroll
            for (int mm = 0; mm < 2; ++mm) { const int m = m0 + mm; const size_t off = (size_t)(row0 + ai * HALF + m * 16) * D + col0;
#pragma unroll
                for (int bj = 0; bj < 2; ++bj)
#pragma unroll
                    for (int n = 0; n < 2; ++n) *(f32x4*)(out + off + bj * HALF + n * 16) = xin[mm][bj][n] + gv[bj][n] * acc[ai][bj][m][n]; }
            asm volatile("" ::: "memory");
        }
    }
};

template <class Epi, class SchedT, bool ALIGN_EPI = false, bool SP2 = false>
__device__ __forceinline__ void gemm_phase(PG8_LAS unsigned char* lds, const Gemm g, const SchedT& S, const Epi& E) {
    int tid_ = threadIdx.x; asm volatile("" : "+v"(tid_));
    const int tid = tid_, wid = __builtin_amdgcn_readfirstlane(tid >> 6), lane = tid & 63, wr = wid >> 2, wc = wid & 3, fr = lane & 15, fq = lane >> 4;
    const int K = g.K, nt = K / BK;
    unsigned voffA[2], voffB[2];
#pragma unroll
    for (int i = 0; i < 2; ++i) { int R, C; stage_rc(tid * 16 + i * 8192, R, C); const int Rb = Epi::PERM ? ((R & ~31) + perm32(R & 31)) : R;
        voffA[i] = (unsigned)(R * K + C) * 2u; voffB[i] = (unsigned)(Rb * K + C) * 2u; }
    const size_t kstep = (size_t)(BK * 2);
    const size_t hstep = (size_t)HALF * K * 2;
    const size_t tstep = 2 * hstep;
    const unsigned ldsw = (unsigned)wid * 1024u;
    const int aoff = lds_byte(wr * 64 + fr, fq * 8), boff = lds_byte(wc * 32 + fr, fq * 8);
#define PG8_SA(b, h) (((b) * 2 + (h)) * HTB)
#define PG8_SB(b, h) ((4 + (b) * 2 + (h)) * HTB)
#define PG8_STAGE(bufoff, gbase, voff) do { _Pragma("unroll") for (int _i = 0; _i < 2; ++_i) \
        __builtin_amdgcn_global_load_lds((const unsigned*)((const char*)(gbase) + (voff)[_i]), (PG8_LAS unsigned*)(lds + (bufoff) + ldsw + _i * 8192), 16, 0, 0); } while (0)
#define PG8_LDA(dst, b, h) do { _Pragma("unroll") for (int m = 0; m < 4; ++m) _Pragma("unroll") for (int k = 0; k < 2; ++k) dst[m][k] = *(const PG8_LAS bf16x8*)(lds + PG8_SA(b, h) + aoff + m * 2048 + k * 1024); } while (0)
#define PG8_LDB(dst, b, h) do { _Pragma("unroll") for (int n = 0; n < 2; ++n) _Pragma("unroll") for (int k = 0; k < 2; ++k) dst[n][k] = *(const PG8_LAS bf16x8*)(lds + PG8_SB(b, h) + boff + n * 2048 + k * 1024); } while (0)
#define PG8_MMA(ai, bj, At, Bt) do { __builtin_amdgcn_s_setprio(1); _Pragma("unroll") for (int m = 0; m < 4; ++m) _Pragma("unroll") for (int n = 0; n < 2; ++n) _Pragma("unroll") for (int k = 0; k < 2; ++k) \
        acc[ai][bj][m][n] = __builtin_amdgcn_mfma_f32_16x16x32_bf16(Bt[n][k], At[m][k], acc[ai][bj][m][n], 0, 0, 0); __builtin_amdgcn_s_setprio(0); } while (0)
#define PG8_WAIT_V(n) asm volatile("s_waitcnt vmcnt(" #n ")" ::: "memory")
#define PG8_WAIT_L(n) asm volatile("s_waitcnt lgkmcnt(" #n ")" ::: "memory")
#define PG8_BAR __builtin_amdgcn_s_barrier()
#define PG8_SCHED __builtin_amdgcn_sched_barrier(0)
    Unit cur, nxt; int ui = 0;
    if (!S.next(0, cur)) return;
    f32x4 acc[2][2][4][2];
#pragma unroll
    for (int a = 0; a < 2; ++a)
#pragma unroll
        for (int b = 0; b < 2; ++b)
#pragma unroll
            for (int m = 0; m < 4; ++m)
#pragma unroll
                for (int n = 0; n < 2; ++n) acc[a][b][m][n] = (f32x4){0.f, 0.f, 0.f, 0.f};
    bf16x8 At[4][2], B0[2][2], B1[2][2];
    const char* cA = (const char*)g.A + (size_t)cur.pm * tstep; const char* cB = (const char*)g.Bt + (size_t)cur.pn * tstep;
    S.a_ready(cur);
    if constexpr (SP2) {
        PG8_STAGE(PG8_SB(0, 0), cB, voffB); PG8_STAGE(PG8_SB(0, 1), cB + hstep, voffB); PG8_STAGE(PG8_SA(0, 0), cA, voffA); PG8_STAGE(PG8_SA(0, 1), cA + hstep, voffA);
        if (wr == 1) PG8_BAR;
        PG8_WAIT_V(2); PG8_BAR;
        PG8_STAGE(PG8_SB(1, 0), cB + kstep, voffB); PG8_STAGE(PG8_SA(1, 0), cA + kstep, voffA); PG8_STAGE(PG8_SB(1, 1), cB + hstep + kstep, voffB);
        PG8_WAIT_V(6); PG8_BAR;
    } else {
        PG8_STAGE(PG8_SB(0, 0), cB, voffB); PG8_STAGE(PG8_SA(0, 0), cA, voffA); PG8_STAGE(PG8_SB(0, 1), cB + hstep, voffB); PG8_STAGE(PG8_SA(0, 1), cA + hstep, voffA);
        if (wr == 1) PG8_BAR;
        PG8_WAIT_V(4); PG8_BAR;
        PG8_STAGE(PG8_SB(1, 0), cB + kstep, voffB); PG8_STAGE(PG8_SA(1, 0), cA + kstep, voffA); PG8_STAGE(PG8_SB(1, 1), cB + hstep + kstep, voffB);
        PG8_WAIT_V(6); PG8_BAR;
    }
    for (;;) {
        const bool has_next = S.next(ui + 1, nxt);
        const char* nA = has_next ? (const char*)g.A + (size_t)nxt.pm * tstep : cA; const char* nB = has_next ? (const char*)g.Bt + (size_t)nxt.pn * tstep : cB;
        for (int t = 0; t < nt; t += 2) {
            const bool last = (t == nt - 2);
            const char* a1 = cA + (size_t)(t + 1) * kstep;
            const char* a2 = last ? nA : cA + (size_t)(t + 2) * kstep; const char* b2 = last ? nB : cB + (size_t)(t + 2) * kstep;
            const char* a3 = a2 + kstep; const char* b3 = b2 + kstep;
            if (last && has_next) S.a_ready(nxt);
            if constexpr (SP2) {
            PG8_LDB(B0, 0, 0); PG8_LDB(B1, 0, 1); PG8_SCHED; PG8_LDA(At, 0, 0); PG8_STAGE(PG8_SA(1, 1), a1 + hstep, voffA);
            PG8_WAIT_V(8); PG8_WAIT_L(0); PG8_BAR; PG8_MMA(0, 0, At, B0); PG8_MMA(0, 1, At, B1); PG8_BAR; PG8_SCHED;
            PG8_LDA(At, 0, 1); PG8_STAGE(PG8_SB(0, 0), b2, voffB); PG8_STAGE(PG8_SB(0, 1), b2 + hstep, voffB); PG8_STAGE(PG8_SA(0, 0), a2, voffA);
            PG8_WAIT_V(8); PG8_WAIT_L(0); PG8_BAR; PG8_MMA(1, 0, At, B0); PG8_MMA(1, 1, At, B1); PG8_BAR; PG8_SCHED;
            PG8_LDB(B0, 1, 0); PG8_LDB(B1, 1, 1); PG8_SCHED; PG8_LDA(At, 1, 0); PG8_STAGE(PG8_SA(0, 1), a2 + hstep, voffA);
            PG8_WAIT_V(8); PG8_WAIT_L(0); PG8_BAR; PG8_MMA(0, 0, At, B0); PG8_MMA(0, 1, At, B1); PG8_BAR; PG8_SCHED;
            PG8_LDA(At, 1, 1); PG8_STAGE(PG8_SB(1, 0), b3, voffB); PG8_STAGE(PG8_SB(1, 1), b3 + hstep, voffB); PG8_STAGE(PG8_SA(1, 0), a3, voffA);
            PG8_WAIT_V(8); PG8_WAIT_L(0); PG8_BAR; PG8_MMA(1, 0, At, B0); PG8_MMA(1, 1, At, B1); PG8_BAR; PG8_SCHED;
            } else {
            PG8_LDB(B0, 0, 0); PG8_SCHED; PG8_LDA(At, 0, 0); PG8_STAGE(PG8_SA(1, 1), a1 + hstep, voffA);
            PG8_WAIT_L(8); PG8_BAR; PG8_WAIT_L(0); PG8_MMA(0, 0, At, B0); PG8_BAR; PG8_SCHED;
            PG8_LDB(B1, 0, 1); PG8_STAGE(PG8_SB(0, 0), b2, voffB);
            PG8_BAR; PG8_WAIT_L(0); PG8_MMA(0, 1, At, B1); PG8_BAR;
            PG8_LDA(At, 0, 1); PG8_STAGE(PG8_SA(0, 0), a2, voffA);
            PG8_BAR; PG8_WAIT_L(0); PG8_MMA(1, 0, At, B0); PG8_BAR; PG8_SCHED;
            PG8_STAGE(PG8_SB(0, 1), b2 + hstep, voffB);
            PG8_WAIT_V(6); PG8_BAR; PG8_MMA(1, 1, At, B1); PG8_BAR;
            PG8_LDB(B0, 1, 0); PG8_SCHED; PG8_LDA(At, 1, 0); PG8_STAGE(PG8_SA(0, 1), a2 + hstep, voffA);
            PG8_WAIT_L(8); PG8_BAR; PG8_WAIT_L(0); PG8_MMA(0, 0, At, B0); PG8_BAR; PG8_SCHED;
            PG8_LDB(B1, 1, 1); PG8_STAGE(PG8_SB(1, 0), b3, voffB);
            PG8_BAR; PG8_WAIT_L(0); PG8_MMA(0, 1, At, B1); PG8_BAR;
            PG8_LDA(At, 1, 1); PG8_STAGE(PG8_SA(1, 0), a3, voffA);
            PG8_BAR; PG8_WAIT_L(0); PG8_MMA(1, 0, At, B0); PG8_BAR; PG8_SCHED;
            PG8_STAGE(PG8_SB(1, 1), b3 + hstep, voffB);
            PG8_WAIT_V(6); PG8_BAR; PG8_MMA(1, 1, At, B1); PG8_BAR;
            }
        }
        if constexpr (ALIGN_EPI) { if (wr == 0) PG8_BAR; }
        if constexpr (!Epi::AFTER_DRAIN) { E(acc, cur, wr, wc, fr, fq); S.done(cur); }
        if (!has_next) break;
#pragma unroll
        for (int a = 0; a < 2; ++a)
#pragma unroll
            for (int b = 0; b < 2; ++b)
#pragma unroll
                for (int m = 0; m < 4; ++m)
#pragma unroll
                    for (int n = 0; n < 2; ++n) acc[a][b][m][n] = (f32x4){0.f, 0.f, 0.f, 0.f};
        cur = nxt; cA = nA; cB = nB; ++ui;
        if constexpr (ALIGN_EPI) { if (wr == 1) PG8_BAR; }
    }
    PG8_WAIT_V(0);
    if constexpr (!ALIGN_EPI) { if (wr == 0) PG8_BAR; }
    PG8_BAR;
#undef PG8_SA
#undef PG8_SB
#undef PG8_STAGE
#undef PG8_LDA
#undef PG8_LDB
#undef PG8_MMA
#undef PG8_WAIT_V
#undef PG8_WAIT_L
#undef PG8_BAR
#undef PG8_SCHED
}
}

__device__ __forceinline__ float wave_sum(float v, int lane) {
#pragma unroll
    for (int o = 1; o < 64; o <<= 1) v += __builtin_bit_cast(float, __builtin_amdgcn_ds_bpermute((lane ^ o) << 2, __builtin_bit_cast(int, v)));
    return v;
}
__device__ __forceinline__ int t5_bucket(int n) { if (n < 16) return n; const int v = 16 + (int)(__log2f((float)n * 0.0625f) * (16.0f / 3.0f)); return v > 31 ? 31 : v; }
__device__ __forceinline__ unsigned f2bf(float f) { unsigned u = __builtin_bit_cast(unsigned, f); return (u + 0x7fffu + ((u >> 16) & 1u)) >> 16; }
__device__ __forceinline__ unsigned pk2(float lo, float hi) { return f2bf(lo) | (f2bf(hi) << 16); }

__device__ __forceinline__ void transpose_item(const float* W, int K, int Nsrc, bf16_t* WT, LAS float* scr, int item, int lane) {
    const int nblk = (Nsrc + 31) / 32, kb = item / nblk, nb = item % nblk, k0 = 64 * kb, n0 = 32 * nb;
    const int ncol = n0 + (lane & 31); const bool okc = ncol < Nsrc;
    float tv[32];
#pragma unroll
    for (int i = 0; i < 32; ++i) { const int kk = 2 * i + (lane >> 5); tv[i] = okc ? W[(size_t)(k0 + kk) * Nsrc + ncol] : 0.f; }
#pragma unroll
    for (int i = 0; i < 32; ++i) { const int kk = 2 * i + (lane >> 5); scr[kk * 33 + (lane & 31)] = tv[i]; }
    asm volatile("s_waitcnt lgkmcnt(0)" ::: "memory");
    const int c = lane & 7;
#pragma unroll
    for (int j = 0; j < 4; ++j) { const int n = (lane >> 3) + 8 * j; const LAS float* s = scr + (8 * c) * 33 + n;
        u32x4 o; o.x = pk2(s[0 * 33], s[1 * 33]); o.y = pk2(s[2 * 33], s[3 * 33]); o.z = pk2(s[4 * 33], s[5 * 33]); o.w = pk2(s[6 * 33], s[7 * 33]);
        *(u32x4*)(WT + (size_t)(n0 + n) * K + k0 + 8 * c) = o; }
    asm volatile("s_waitcnt lgkmcnt(0)" ::: "memory");
}

struct Params {
    const float* in[23];
    float* out;
    unsigned char* ws;
    int step_lo, step_hi;
};

constexpr int KP = 144;
constexpr int VP128 = 320, VP64 = 192;
constexpr int ATT_K0 = 0, ATT_V0 = 64 * KP, ATT_STAGE_DIFF = 64 * KP + 64 * VP128;
constexpr int ATT_STAGE_NSA = 64 * KP + 64 * VP64;
#define ATT_BT (4 * ATT_ST)
#define ATT_SEL (ATT_BT + 2048)
#define ATT_UM (ATT_SEL + 512)
#define ATT_IMP (ATT_UM + 64)
constexpr int LDS_BYTES = 139264;
constexpr int LDS_BARST = 139264 - 64;
static_assert(4 * 24576 + 2624 + 32768 <= LDS_BARST && 4 * 16384 + 2624 + 4 * 64 * 65 * 4 <= LDS_BARST && 2 * ATT_STAGE_NSA <= 4 * 16384, "attention LDS map");

__device__ __forceinline__ s16x4 vtr(LAS const char* p) { typedef short v4i16_t __attribute__((ext_vector_type(4))); return __builtin_bit_cast(s16x4, __builtin_amdgcn_ds_read_tr16_b64_v4i16((LAS v4i16_t*)p)); }

__device__ __forceinline__ float pair_max(float v) { float a = v, b = v; asm volatile("s_nop 1\n\tv_permlane32_swap_b32 %0, %1" : "+v"(a), "+v"(b)); return fmaxf(a, b); }
__device__ __forceinline__ float pair_sum(float v) { float a = v, b = v; asm volatile("s_nop 1\n\tv_permlane32_swap_b32 %0, %1" : "+v"(a), "+v"(b)); return a + b; }
__device__ __forceinline__ void qk_tile(f32x16& s0, f32x16& s1, const bf16x8 (&qf)[4], LAS const char* Kb, int lane) {
    LAS const char* kp = Kb + (lane & 31) * KP + (lane >> 5) * 16;
    f32x16 a = {}, b = {};
#pragma unroll
    for (int kk = 0; kk < 4; ++kk) {
        const bf16x8 k0 = *(LAS const bf16x8*)(kp + kk * 32);
        const bf16x8 k1 = *(LAS const bf16x8*)(kp + 32 * KP + kk * 32);
        a = __builtin_amdgcn_mfma_f32_32x32x16_bf16(k0, qf[kk], a, 0, 0, 0);
        b = __builtin_amdgcn_mfma_f32_32x32x16_bf16(k1, qf[kk], b, 0, 0, 0);
    }
    s0 = a; s1 = b;
}
__device__ __forceinline__ void qk_tile_lq(f32x16& s0, f32x16& s1, LAS const char* Qs, LAS const char* Kb, int lane) {
    LAS const char* kp = Kb + (lane & 31) * KP + (lane >> 5) * 16;
    f32x16 a = {}, b = {};
#pragma unroll
    for (int kk = 0; kk < 4; ++kk) {
        const bf16x8 q = *(LAS const bf16x8*)(Qs + kk * 1024 + lane * 16);
        const bf16x8 k0 = *(LAS const bf16x8*)(kp + kk * 32);
        const bf16x8 k1 = *(LAS const bf16x8*)(kp + 32 * KP + kk * 32);
        a = __builtin_amdgcn_mfma_f32_32x32x16_bf16(k0, q, a, 0, 0, 0);
        b = __builtin_amdgcn_mfma_f32_32x32x16_bf16(k1, q, b, 0, 0, 0);
    }
    s0 = a; s1 = b;
}
template <int DVB, int VP>
__device__ __forceinline__ void pv_tile(f32x16 (&o)[DVB], const bf16x8 (&P)[4], LAS const char* Vb, int lane) {
    const int i = lane & 15, gidx = lane >> 4, hh = gidx >> 1, dvh = gidx & 1;
    LAS const char* vp = Vb + (hh * 4 + (i >> 2)) * VP + (16 * dvh + 4 * (i & 3)) * 2;
    s16x4 lo[DVB], hi[DVB];
#pragma unroll
    for (int c = 0; c < DVB; ++c) { lo[c] = vtr(vp + c * 64); hi[c] = vtr(vp + 8 * VP + c * 64); }
#pragma unroll
    for (int ks = 0; ks < 4; ++ks) {
        s16x4 nlo[DVB], nhi[DVB];
        if (ks < 3) {
#pragma unroll
            for (int c = 0; c < DVB; ++c) { nlo[c] = vtr(vp + (16 * (ks + 1)) * VP + c * 64); nhi[c] = vtr(vp + (16 * (ks + 1) + 8) * VP + c * 64); }
        }
#pragma unroll
        for (int c = 0; c < DVB; ++c) {
            const bf16x8 a = (bf16x8){lo[c][0], lo[c][1], lo[c][2], lo[c][3], hi[c][0], hi[c][1], hi[c][2], hi[c][3]};
            o[c] = __builtin_amdgcn_mfma_f32_32x32x16_bf16(a, P[ks], o[c], 0, 0, 0);
        }
        __builtin_amdgcn_sched_barrier(0);
        if (ks < 3) {
#pragma unroll
            for (int c = 0; c < DVB; ++c) { lo[c] = nlo[c]; hi[c] = nhi[c]; }
        }
    }
}
template <bool BIAS>
__device__ __forceinline__ void score_elem(f32x16& s0, f32x16& s1, int base, int win, LAS const float* bt) {
#pragma unroll
    for (int i = 0; i < 16; ++i) {
        const int off = (i >> 2) * 8 + (i & 3);
        const int d0 = base - off, d1 = d0 - 32;
        float b0 = 0.f, b1 = 0.f;
        if (BIAS) { b0 = bt[min(max(d0, 0), 127)]; b1 = bt[min(max(d1, 0), 127)]; }
        s0[i] = ((unsigned)d0 < (unsigned)win) ? s0[i] + b0 : -INFINITY;
        s1[i] = ((unsigned)d1 < (unsigned)win) ? s1[i] + b1 : -INFINITY;
        if (BIAS && (i & 3) == 3) __builtin_amdgcn_sched_barrier(0);
    }
}
__device__ __forceinline__ float row_max32(const f32x16& s0, const f32x16& s1) {
    float a = fmaxf(s0[0], s1[0]);
#pragma unroll
    for (int i = 1; i < 16; ++i) a = fmaxf(a, fmaxf(s0[i], s1[i]));
    return pair_max(a);
}
template <int DVB>
__device__ __forceinline__ void softmax_step(f32x16& s0, f32x16& s1, float& m, float& l, f32x16 (&o)[DVB], bf16x8 (&P)[4], bool sel) {
    float mx = row_max32(s0, s1); mx = sel ? mx : -INFINITY;
    const float mn = fmaxf(m, mx);
    {
        const float a = __builtin_amdgcn_exp2f(m - mn); l *= a;
#pragma unroll
        for (int c = 0; c < DVB; ++c) o[c] *= a;
        m = mn;
    }
    const float ms = sel ? m : INFINITY;
    float sum = 0.f;
#pragma unroll
    for (int i = 0; i < 16; ++i) { s0[i] = __builtin_amdgcn_exp2f(s0[i] - ms); s1[i] = __builtin_amdgcn_exp2f(s1[i] - ms); sum += s0[i] + s1[i]; }
    l += sum;
    u32x4 w0 = {cvtpk(s0[0], s0[1]), cvtpk(s0[2], s0[3]), cvtpk(s0[4], s0[5]), cvtpk(s0[6], s0[7])};
    u32x4 w1 = {cvtpk(s0[8], s0[9]), cvtpk(s0[10], s0[11]), cvtpk(s0[12], s0[13]), cvtpk(s0[14], s0[15])};
    u32x4 w2 = {cvtpk(s1[0], s1[1]), cvtpk(s1[2], s1[3]), cvtpk(s1[4], s1[5]), cvtpk(s1[6], s1[7])};
    u32x4 w3 = {cvtpk(s1[8], s1[9]), cvtpk(s1[10], s1[11]), cvtpk(s1[12], s1[13]), cvtpk(s1[14], s1[15])};
    P[0] = __builtin_bit_cast(bf16x8, w0); P[1] = __builtin_bit_cast(bf16x8, w1); P[2] = __builtin_bit_cast(bf16x8, w2); P[3] = __builtin_bit_cast(bf16x8, w3);
}

__device__ __forceinline__ void glds16(const void* gsrc, unsigned lds_dst) { unsigned keep;
    asm volatile("s_mov_b32 %0, m0\n\ts_mov_b32 m0, %2\n\ts_nop 0\n\tglobal_load_lds_dwordx4 %1, off\n\ts_mov_b32 m0, %0" : "=&s"(keep) : "v"(gsrc), "s"(lds_dst) : "memory"); }
template <int VW>
__device__ __forceinline__ void dma_tile(LAS char* stage, const bf16_t* Kg, const bf16_t* Vg, size_t pitchK, size_t pitchV, int k0, int lane, int wid) {
    const bf16_t* kb = Kg + (size_t)k0 * pitchK; const bf16_t* vb = Vg + (size_t)k0 * pitchV;
    const unsigned sb = (unsigned)__builtin_amdgcn_readfirstlane((int)(unsigned)(uintptr_t)stage);
    { const int r = 8 * wid + (lane >> 3), c = (lane & 7) ^ ((r >> 1) & 7);
      glds16(kb + (unsigned)(r * (unsigned)pitchK + c * 8), sb + wid * 1024); }
    if (VW == 2) {
#pragma unroll
        for (int h = 0; h < 2; ++h) { const int pc = 2 * wid + h, r = 4 * pc + (lane >> 4), c = (lane & 15) ^ ((r & 3) << 2);
            glds16(vb + (unsigned)(r * (unsigned)pitchV + c * 8), sb + 8192 + pc * 1024); }
    } else {
        const int r = 8 * wid + (lane >> 3), c = (lane & 7) ^ (((r >> 1) & 1) << 2);
        glds16(vb + (unsigned)(r * (unsigned)pitchV + c * 8), sb + 8192 + wid * 1024);
    }
}
template <bool QREG>
__device__ __forceinline__ void qk_tile_sw(f32x16& s0, f32x16& s1, const bf16x8* qf, LAS const char* Qs, LAS const char* Kb, int lane) {
    const int r = lane & 31, hh = lane >> 5, sw = (r >> 1) & 7;
    LAS const char* kp = Kb + r * 128 + ((hh ^ (sw & 1)) << 4); const int t = sw >> 1;
    f32x16 a = {}, b = {};
#pragma unroll
    for (int kk = 0; kk < 4; ++kk) {
        const bf16x8 q = QREG ? qf[kk] : *(LAS const bf16x8*)(Qs + kk * 1024 + lane * 16);
        const bf16x8 k0 = *(LAS const bf16x8*)(kp + ((kk ^ t) << 5));
        const bf16x8 k1 = *(LAS const bf16x8*)(kp + ((kk ^ t) << 5) + 32 * 128);
        a = __builtin_amdgcn_mfma_f32_32x32x16_bf16(k0, q, a, 0, 0, 0);
        b = __builtin_amdgcn_mfma_f32_32x32x16_bf16(k1, q, b, 0, 0, 0);
    }
    s0 = a; s1 = b;
}
template <int DVB, int ROWB>
__device__ __forceinline__ void pv_tile_sw(f32x16 (&o)[DVB], const bf16x8 (&P)[4], LAS const char* Vb, int lane) {
    const int i = lane & 15, gidx = lane >> 4, hh = gidx >> 1, dvh = gidx & 1;
    const int q = ROWB == 256 ? ((i >> 2) & 3) : ((i >> 3) & 1);
    LAS const char* vp = Vb + (4 * hh + (i >> 2)) * ROWB + dvh * 32 + ((i & 3) >> 1) * 16 + (i & 1) * 8;
    s16x4 lo[DVB], hi[DVB];
#pragma unroll
    for (int c = 0; c < DVB; ++c) { lo[c] = vtr(vp + ((c ^ q) << 6)); hi[c] = vtr(vp + ((c ^ q) << 6) + 8 * ROWB); }
#pragma unroll
    for (int ks = 0; ks < 4; ++ks) {
        s16x4 nlo[DVB], nhi[DVB];
        if (ks < 3) {
#pragma unroll
            for (int c = 0; c < DVB; ++c) { nlo[c] = vtr(vp + ((c ^ q) << 6) + (16 * (ks + 1)) * ROWB); nhi[c] = vtr(vp + ((c ^ q) << 6) + (16 * (ks + 1) + 8) * ROWB); }
        }
#pragma unroll
        for (int c = 0; c < DVB; ++c) {
            const bf16x8 a = (bf16x8){lo[c][0], lo[c][1], lo[c][2], lo[c][3], hi[c][0], hi[c][1], hi[c][2], hi[c][3]};
            o[c] = __builtin_amdgcn_mfma_f32_32x32x16_bf16(a, P[ks], o[c], 0, 0, 0);
        }
        __builtin_amdgcn_sched_barrier(0);
        if (ks < 3) {
#pragma unroll
            for (int c = 0; c < DVB; ++c) { lo[c] = nlo[c]; hi[c] = nhi[c]; }
        }
    }
}

template <int VW> struct TileRegs { u32x4 k; u32x4 v[VW]; };
template <int VW>
__device__ __forceinline__ void tile_issue(TileRegs<VW>& r, const bf16_t* Kg, const bf16_t* Vg, size_t pitchK, size_t pitchV, int k0, int tid) {
    const bf16_t* kb = Kg + (size_t)k0 * pitchK;
    const bf16_t* vb = Vg + (size_t)k0 * pitchV;
    r.k = *(const u32x4*)(kb + (unsigned)((tid >> 3) * (unsigned)pitchK + (tid & 7) * 8));
    if (VW == 2) {
#pragma unroll
        for (int i = 0; i < 2; ++i) { const int idx = tid + 512 * i; r.v[i] = *(const u32x4*)(vb + (unsigned)((idx >> 4) * (unsigned)pitchV + (idx & 15) * 8)); }
    } else r.v[0] = *(const u32x4*)(vb + (unsigned)((tid >> 3) * (unsigned)pitchV + (tid & 7) * 8));
}
template <int VW>
__device__ __forceinline__ void tile_commit(const TileRegs<VW>& r, LAS char* st, int tid) {
    *(LAS u32x4*)(st + ATT_K0 + (tid >> 3) * KP + (tid & 7) * 16) = r.k;
    if (VW == 2) {
#pragma unroll
        for (int i = 0; i < 2; ++i) { const int idx = tid + 512 * i; *(LAS u32x4*)(st + ATT_V0 + (idx >> 4) * VP128 + (idx & 15) * 16) = r.v[i]; }
    } else *(LAS u32x4*)(st + ATT_V0 + (tid >> 3) * VP64 + (tid & 7) * 16) = r.v[0];
}
#define TILE_LOOP_BEGIN(VW, UMASK, KG, VG, PK, PV) { \
    unsigned long long rem_ = (UMASK); int cur_ = __builtin_ctzll(rem_); rem_ &= rem_ - 1ull; int bufi_ = 0; \
    TileRegs<VW> tr_; tile_issue<VW>(tr_, KG, VG, PK, PV, cur_ * 64, tid); tile_commit<VW>(tr_, lds, tid); __syncthreads(); \
    for (;;) { const int nxt_ = rem_ ? __builtin_ctzll(rem_) : -1; if (rem_) rem_ &= rem_ - 1ull; \
        if (nxt_ >= 0) tile_issue<VW>(tr_, KG, VG, PK, PV, nxt_ * 64, tid); \
        { const int kt = cur_; LAS char* st = lds + bufi_ * ATT_STP;
#define TILE_LOOP_END(VW) } \
        if (nxt_ >= 0) tile_commit<VW>(tr_, lds + (bufi_ ^ 1) * ATT_STP, tid); \
        __syncthreads(); if (nxt_ < 0) break; cur_ = nxt_; bufi_ ^= 1; } }

#define PP_BAR() do { asm volatile("s_waitcnt lgkmcnt(0)" ::: "memory"); __builtin_amdgcn_s_barrier(); asm volatile("" ::: "memory"); } while (0)
#define PP_NEXT(t) do { if (rem_) { t = __builtin_ctzll(rem_); rem_ &= rem_ - 1ull; } else t = -1; } while (0)
#define PP_WAITV(NI, c2, c3) do { if ((c2) && (c3)) { if (NI == 3) asm volatile("s_waitcnt vmcnt(6)" ::: "memory"); else asm volatile("s_waitcnt vmcnt(4)" ::: "memory"); } \
    else if ((c2) || (c3)) { if (NI == 3) asm volatile("s_waitcnt vmcnt(3)" ::: "memory"); else asm volatile("s_waitcnt vmcnt(2)" ::: "memory"); } \
    else asm volatile("s_waitcnt vmcnt(0)" ::: "memory"); } while (0)
#define PP_BEGIN(VW, NI, UMASK, KG, VG, PK, PV) { \
    unsigned long long rem_ = (UMASK); int ta_, tb_, tc_, td_ = -1; PP_NEXT(ta_); PP_NEXT(tb_); PP_NEXT(tc_); int sj_ = 0; \
    dma_tile<VW>(lds, KG, VG, PK, PV, ta_ * 64, lane, wid); \
    if (tb_ >= 0) dma_tile<VW>(lds + ATT_ST, KG, VG, PK, PV, tb_ * 64, lane, wid); \
    if (tc_ >= 0) dma_tile<VW>(lds + 2 * ATT_ST, KG, VG, PK, PV, tc_ * 64, lane, wid); \
    PP_WAITV(NI, tb_ >= 0, tc_ >= 0); PP_BAR(); \
    for (;;) { const int kt = ta_; LAS char* st = lds + sj_ * ATT_ST; \
        if (false) { PP_NEXT(td_); if (td_ >= 0) dma_tile<VW>(lds + ((sj_ + 3) & 3) * ATT_ST, KG, VG, PK, PV, td_ * 64, lane, wid); } {
#define PP_MID(VW, NI, KG, VG, PK, PV) } \
        if (true) { PP_NEXT(td_); if (td_ >= 0) dma_tile<VW>(lds + ((sj_ + 3) & 3) * ATT_ST, KG, VG, PK, PV, td_ * 64, lane, wid); } {
#define PP_END(NI) } if (true) PP_WAITV(NI, tc_ >= 0, td_ >= 0); PP_BAR(); \
        if (tb_ < 0) break; ta_ = tb_; tb_ = tc_; tc_ = td_; td_ = -1; sj_ = (sj_ + 1) & 3; } \
    }

__device__ __forceinline__ void diff_attn_phase(LAS char* lds, const bf16_t* QKV, bf16_t* O, const float* rel_bias, const float* lam_p, const float* subln, int layer, float* stash, int G, int c) {
    constexpr int ATT_ST = 24576;
    int tid_ = threadIdx.x; asm volatile("" : "+v"(tid_));
    const int tid = tid_, lane = tid & 63, wid = __builtin_amdgcn_readfirstlane(tid >> 6), r32 = lane & 31, hh = lane >> 5;
    if (wid >= 4) __builtin_amdgcn_s_setprio(1);
    float s1 = 0.f, s2 = 0.f;
    for (int i = 0; i < 64; ++i) { s1 += lam_p[i] * lam_p[64 + i]; s2 += lam_p[128 + i] * lam_p[192 + i]; }
    const float lam_init = 0.8f - 0.6f * expf(-0.3f * (float)layer);
    const float lam = expf(s1) - expf(s2) + lam_init;
    LAS float* bt = (LAS float*)(lds + ATT_BT);
    size_t pq_ = 64, pv2_ = 128; asm volatile("" : "+s"(pq_), "+s"(pv2_));
    f32x4* mystash = (f32x4*)stash + (size_t)(wid * 64 + lane) * 16;
    for (int it = 0;; ++it) {
        int bh, qb;
        if (G == 256) { if (it >= 4) break; const int j = c >> 6; bh = c & 63; qb = it == 0 ? 15 - j : it == 1 ? 8 + j : it == 2 ? 7 - j : j; }
        else { const int id = it * G + c; if (id >= 1024) break; bh = id & 63; qb = 15 - (id >> 6); }
        const int b = bh >> 3, h = bh & 7, q0 = qb * 256; const size_t rowbase = (size_t)b * T;
        const int qw = q0 + wid * 32, qpos = qw + r32;
        const int NT = (q0 + 256) / 64;
        const unsigned long long um = NT >= 64 ? ~0ull : ((1ull << NT) - 1ull);
        for (int mp = 0; mp < 2; ++mp) {
            if (tid < 128) bt[tid] = (rel_bias[t5_bucket(tid) * 16 + h * 2 + mp] - rel_bias[31 * 16 + h * 2 + mp]) * LOG2E;
            LAS char* Qs = lds + ATT_IMP + wid * 4096;
            { const bf16_t* qp = QKV + (rowbase + qpos) * 1024 + h * 128 + mp * 64 + hh * 8;
#pragma unroll
              for (int kk = 0; kk < 4; ++kk) *(LAS bf16x8*)(Qs + kk * 1024 + lane * 16) = *(const bf16x8*)(qp + kk * 16); }
            f32x16 o[4]; o[0] = f32x16{}; o[1] = f32x16{}; o[2] = f32x16{}; o[3] = f32x16{};
            float m = -1e30f, l = 0.f;
            const bf16_t* Kg = QKV + (size_t)M * 1024 + (size_t)((b * 8 + h) * 2 + mp) * T * 64;
            const bf16_t* Vg = QKV + (size_t)2 * M * 1024 + (size_t)(b * 8 + h) * T * 128;
            bf16x8 P[4];
            PP_BEGIN(2, 3, um, Kg, Vg, pq_, pv2_)
                const int k0 = kt * 64;
                if (k0 <= qw + 31) {
                    f32x16 sa, sb; qk_tile_sw<false>(sa, sb, nullptr, Qs, st, lane);
                    if (qw - (k0 + 63) < 113) score_elem<true>(sa, sb, qpos - k0 - hh * 4, 1 << 30, bt);
                    softmax_step<4>(sa, sb, m, l, o, P, true);
                    pv_tile_sw<4, 256>(o, P, st + 8192, lane);
                }
            PP_MID(2, 3, Kg, Vg, pq_, pv2_)
            PP_END(3)
            const float lt = pair_sum(l); const float inv = __builtin_amdgcn_rcpf(lt);
            if (mp == 0) {
#pragma unroll
                for (int cc = 0; cc < 4; ++cc)
#pragma unroll
                    for (int g4 = 0; g4 < 4; ++g4) mystash[cc * 4 + g4] = (f32x4){o[cc][g4 * 4] * inv, o[cc][g4 * 4 + 1] * inv, o[cc][g4 * 4 + 2] * inv, o[cc][g4 * 4 + 3] * inv};
            } else {
                float ss = 0.f;
#pragma unroll
                for (int cc = 0; cc < 4; ++cc)
#pragma unroll
                    for (int g4 = 0; g4 < 4; ++g4) { const f32x4 a = mystash[cc * 4 + g4];
#pragma unroll
                        for (int e = 0; e < 4; ++e) { const float v = a[e] - lam * (o[cc][g4 * 4 + e] * inv); o[cc][g4 * 4 + e] = v; ss += v * v; }
                        if (g4 == 3) __builtin_amdgcn_sched_barrier(0); }
                ss = pair_sum(ss);
                const float rs = rsqrtf(ss * (1.f / 128.f) + NORM_EPS) * (1.f - lam_init);
                bf16_t* op = O + (rowbase + qpos) * D + h * 128 + hh * 4;
#pragma unroll
                for (int cc = 0; cc < 4; ++cc)
#pragma unroll
                    for (int g4 = 0; g4 < 4; ++g4) { const int dv = cc * 32 + g4 * 8; const f32x4 sg = *(const f32x4*)(subln + dv + hh * 4);
                        u32x2 w; w.x = cvtpk(o[cc][g4 * 4] * rs * sg[0], o[cc][g4 * 4 + 1] * rs * sg[1]); w.y = cvtpk(o[cc][g4 * 4 + 2] * rs * sg[2], o[cc][g4 * 4 + 3] * rs * sg[3]);
                        *(u32x2*)(op + dv) = w; if (g4 == 3) __builtin_amdgcn_sched_barrier(0); }
            }
        }
    }
    __builtin_amdgcn_s_setprio(0);
}

__device__ __forceinline__ void nsa_phase(LAS char* lds, const bf16_t* PROJ, const bf16_t* KVB, const bf16_t* CMP, bf16_t* O, const float* rel_bias, int G, int c) {
    constexpr int ATT_ST = 16384, ATT_STP = ATT_STAGE_NSA;
    int tid_ = threadIdx.x; asm volatile("" : "+v"(tid_));
    const int tid0_ = tid_; const int tid = tid_, lane = tid & 63, wid = __builtin_amdgcn_readfirstlane(tid >> 6), r32 = lane & 31, hh = lane >> 5;
    const int r = wid & 3, qh = wid >> 2;
    if (wid >= 4) __builtin_amdgcn_s_setprio(1);
    LAS float* btall = (LAS float*)(lds + ATT_BT);
    size_t pkv_ = 64, pc_ = 64; asm volatile("" : "+s"(pkv_), "+s"(pc_));
    LAS float* bt = btall + r * 128;
    LAS unsigned long long* SEL = (LAS unsigned long long*)(lds + ATT_SEL);
    LAS unsigned* UM = (LAS unsigned*)(lds + ATT_UM);
    LAS float* IMP = (LAS float*)(lds + ATT_IMP);
    for (int it = 0;; ++it) {
        int bg, qblk;
        if (G == 256) { if (it >= 8) break; const int j = c >> 5; bg = c & 31; qblk = (it & 1) ? (56 - 8 * it + j) : (63 - 8 * it - j); }
        else { const int id = it * G + c; if (id >= 2048) break; bg = id & 31; qblk = 63 - (id >> 5); }
        const int b = bg >> 2, g = bg & 3, t0 = qblk * 64, hq = g * 4 + r; const size_t rowbase = (size_t)b * T;
        const int qw = t0 + qh * 32, qpos = qw + r32;
        btall[tid] = (rel_bias[t5_bucket(tid & 127) * 16 + g * 4 + (tid >> 7)] - rel_bias[31 * 16 + g * 4 + (tid >> 7)]) * LOG2E;
        LAS float* impr = IMP + (r * 64 + qh * 32 + r32) * 65;
        for (int jj = 0; jj < 33; ++jj) { const int idx = 2 * jj + hh; if (idx < 65) impr[idx] = 0.f; }
        if (tid < 2) UM[tid] = 0u;
        bf16x8 qf[4]; float gate[3];
        { const bf16_t* pp = PROJ + (rowbase + qpos) * NBINP;
#pragma unroll
          for (int kk = 0; kk < 4; ++kk) qf[kk] = *(const bf16x8*)(pp + hq * 64 + kk * 16 + hh * 8);
#pragma unroll
          for (int e = 0; e < 3; ++e) gate[e] = __builtin_amdgcn_rcpf(1.f + __expf(-bf2f(pp[1024 + hq * 3 + e]))); }
        f32x16 ot[2]; ot[0] = f32x16{}; ot[1] = f32x16{};
        const int nmaxb = (t0 + 32) >> 4; const int nct = min(4, (nmaxb >> 6) + 1);
        const unsigned long long umc = (1ull << nct) - 1ull;
        const bf16_t* Kc = CMP + (size_t)((0 * 8 + b) * 4 + g) * 256 * 64;
        const bf16_t* Vc = CMP + (size_t)((1 * 8 + b) * 4 + g) * 256 * 64;
        const int nlim = min((qpos - 31) >> 4, 254);
        float mc = -1e30f, lc = 0.f;
        { int tid = tid0_; asm volatile("" : "+v"(tid)); const int lane = tid & 63, r32 = lane & 31, hh = lane >> 5; (void)r32; (void)hh;
        TILE_LOOP_BEGIN(1, umc, Kc, Vc, pc_, pc_)
            f32x16 sa, sb; qk_tile(sa, sb, qf, st + ATT_K0, lane);
            score_elem<false>(sa, sb, nlim - kt * 64 - hh * 4, 1 << 30, bt);
            const float mx = row_max32(sa, sb); const float mn = fmaxf(mc, mx);
            lc *= __builtin_amdgcn_exp2f(mc - mn); mc = mn;
            float sum = 0.f;
#pragma unroll
            for (int i = 0; i < 16; ++i) sum += __builtin_amdgcn_exp2f(sa[i] - mc) + __builtin_amdgcn_exp2f(sb[i] - mc);
            lc += sum;
        TILE_LOOP_END(1) }
        {
            const float lt = pair_sum(lc); const float invl = lt > 0.f ? __builtin_amdgcn_rcpf(lt) : 0.f;
            f32x16 oc[2]; oc[0] = f32x16{}; oc[1] = f32x16{};
            int tid = tid0_; asm volatile("" : "+v"(tid)); const int lane = tid & 63, r32 = lane & 31, hh = lane >> 5; (void)r32; (void)hh;
            LAS float* impr = IMP + (r * 64 + qh * 32 + r32) * 65;
            TILE_LOOP_BEGIN(1, umc, Kc, Vc, pc_, pc_)
                f32x16 sa, sb; qk_tile(sa, sb, qf, st + ATT_K0, lane);
                score_elem<false>(sa, sb, nlim - kt * 64 - hh * 4, 1 << 30, bt);
#pragma unroll
                for (int i = 0; i < 16; ++i) { sa[i] = __builtin_amdgcn_exp2f(sa[i] - mc) * invl; sb[i] = __builtin_amdgcn_exp2f(sb[i] - mc) * invl; }
#pragma unroll
                for (int kb = 0; kb < 2; ++kb)
#pragma unroll
                    for (int ig = 0; ig < 4; ++ig) { const int j = kt * 16 + kb * 8 + ig * 2 + hh;
                        const float g4 = kb ? ((sb[ig * 4] + sb[ig * 4 + 1]) + (sb[ig * 4 + 2] + sb[ig * 4 + 3])) : ((sa[ig * 4] + sa[ig * 4 + 1]) + (sa[ig * 4 + 2] + sa[ig * 4 + 3]));
                        impr[j] += g4; }
                asm volatile("s_waitcnt lgkmcnt(0)" ::: "memory");
#pragma unroll
                for (int kb = 0; kb < 2; ++kb)
#pragma unroll
                    for (int ig = 0; ig < 4; ++ig) { const int j = kt * 16 + kb * 8 + ig * 2 + hh;
                        impr[j + 1] += kb ? sb[ig * 4 + 3] : sa[ig * 4 + 3]; }
                asm volatile("s_waitcnt lgkmcnt(0)" ::: "memory");
                bf16x8 P[4];
                { u32x4 w0 = {cvtpk(sa[0], sa[1]), cvtpk(sa[2], sa[3]), cvtpk(sa[4], sa[5]), cvtpk(sa[6], sa[7])};
                  u32x4 w1 = {cvtpk(sa[8], sa[9]), cvtpk(sa[10], sa[11]), cvtpk(sa[12], sa[13]), cvtpk(sa[14], sa[15])};
                  u32x4 w2 = {cvtpk(sb[0], sb[1]), cvtpk(sb[2], sb[3]), cvtpk(sb[4], sb[5]), cvtpk(sb[6], sb[7])};
                  u32x4 w3 = {cvtpk(sb[8], sb[9]), cvtpk(sb[10], sb[11]), cvtpk(sb[12], sb[13]), cvtpk(sb[14], sb[15])};
                  P[0] = __builtin_bit_cast(bf16x8, w0); P[1] = __builtin_bit_cast(bf16x8, w1); P[2] = __builtin_bit_cast(bf16x8, w2); P[3] = __builtin_bit_cast(bf16x8, w3); }
                pv_tile<2, VP64>(oc, P, st + ATT_V0, lane);
            TILE_LOOP_END(1)
            ot[0] = oc[0] * gate[0]; ot[1] = oc[1] * gate[0];
        }
        {
            unsigned long long wun = 0ull;
            int tid = tid0_; asm volatile("" : "+v"(tid)); const int lane = tid & 63, r32 = lane & 31, hh = lane >> 5; (void)r32; (void)hh;
            if (qblk < 16) {
                const unsigned long long mk = (2ull << qblk) - 1ull;
                if (lane < 8) SEL[wid * 8 + lane] = mk;
                wun = mk;
            } else
#pragma unroll 1
            for (int k = 0; k < 8; ++k) {
                const int q = wid * 8 + k;
                float v = ((IMP[(0 * 64 + q) * 65 + lane] + IMP[(1 * 64 + q) * 65 + lane]) + IMP[(2 * 64 + q) * 65 + lane]) + IMP[(3 * 64 + q) * 65 + lane];
                if (lane == 0 || lane == qblk || lane == qblk - 1) v = 1e4f;
                if (lane > qblk) v = -1e30f;
                int rank = 0; const int vi = __builtin_bit_cast(int, v);
#pragma unroll 8
                for (int jj = 0; jj < 64; ++jj) { const float vj = __builtin_bit_cast(float, __builtin_amdgcn_readlane(vi, jj)); rank += (vj > v || (vj == v && jj < lane)) ? 1 : 0; }
                const unsigned long long mk = __builtin_amdgcn_ballot_w64(rank < 16 && lane <= qblk);
                if (lane == 0) SEL[q] = mk;
                wun |= mk;
            }
            if (lane == 0) { atomicOr((unsigned*)&UM[0], (unsigned)wun); atomicOr((unsigned*)&UM[1], (unsigned)(wun >> 32)); }
            __syncthreads();
        }
        {
            int tid = tid0_; asm volatile("" : "+v"(tid)); const int lane = tid & 63, r32 = lane & 31, hh = lane >> 5; (void)r32; (void)hh;
            const unsigned long long ums = (unsigned long long)UM[0] | ((unsigned long long)UM[1] << 32);
            const unsigned long long mysel = SEL[qh * 32 + r32];
            f32x16 o[2]; o[0] = f32x16{}; o[1] = f32x16{};
            float m = -1e30f, l = 0.f;
            const bf16_t* Kg = KVB + (size_t)((0 * 8 + b) * 4 + g) * T * 64;
            const bf16_t* Vg = KVB + (size_t)((1 * 8 + b) * 4 + g) * T * 64;
            bf16x8 P[4];
            PP_BEGIN(1, 2, ums, Kg, Vg, pkv_, pkv_)
                const bool sel = (mysel >> kt) & 1ull;
                const int k0 = kt * 64;
                f32x16 sa, sb; qk_tile_sw<true>(sa, sb, qf, nullptr, st, lane);
                if (qw - (k0 + 63) < 113) score_elem<true>(sa, sb, qpos - k0 - hh * 4, 1 << 30, bt);
                softmax_step<2>(sa, sb, m, l, o, P, sel);
            PP_MID(1, 2, Kg, Vg, pkv_, pkv_)
                pv_tile_sw<2, 128>(o, P, st + 8192, lane);
            PP_END(2)
            const float lt = pair_sum(l); const float sc = gate[1] * __builtin_amdgcn_rcpf(lt);
            ot[0] += o[0] * sc; ot[1] += o[1] * sc;
        }
        {
            int tid = tid0_; asm volatile("" : "+v"(tid)); const int lane = tid & 63, r32 = lane & 31, hh = lane >> 5; (void)r32; (void)hh;
            const int lo = max(0, qblk - 8);
            const unsigned long long hiM = qblk >= 63 ? ~0ull : ((1ull << (qblk + 1)) - 1ull);
            const unsigned long long umw = hiM & ~((1ull << lo) - 1ull);
            f32x16 o[2]; o[0] = f32x16{}; o[1] = f32x16{};
            float m = -1e30f, l = 0.f;
            const bf16_t* Kg = KVB + (size_t)((2 * 8 + b) * 4 + g) * T * 64;
            const bf16_t* Vg = KVB + (size_t)((3 * 8 + b) * 4 + g) * T * 64;
            bf16x8 P[4];
            PP_BEGIN(1, 2, umw, Kg, Vg, pkv_, pkv_)
                const int k0 = kt * 64;
                f32x16 sa, sb; qk_tile_sw<true>(sa, sb, qf, nullptr, st, lane);
                if (qw - (k0 + 63) < 113 || qw + 31 - k0 >= 512) score_elem<true>(sa, sb, qpos - k0 - hh * 4, 512, bt);
                softmax_step<2>(sa, sb, m, l, o, P, true);
            PP_MID(1, 2, Kg, Vg, pkv_, pkv_)
                pv_tile_sw<2, 128>(o, P, st + 8192, lane);
            PP_END(2)
            const float lt = pair_sum(l); const float sc = gate[2] * __builtin_amdgcn_rcpf(lt);
            ot[0] += o[0] * sc; ot[1] += o[1] * sc;
        }
        { int tid = tid0_; asm volatile("" : "+v"(tid)); const int lane = tid & 63, r32 = lane & 31, hh = lane >> 5; (void)r32; (void)hh;
          bf16_t* op = O + (rowbase + qpos) * D + hq * 64 + hh * 4;
#pragma unroll
          for (int cc = 0; cc < 2; ++cc)
#pragma unroll
              for (int g4 = 0; g4 < 4; ++g4) { u32x2 w; w.x = cvtpk(ot[cc][g4 * 4], ot[cc][g4 * 4 + 1]); w.y = cvtpk(ot[cc][g4 * 4 + 2], ot[cc][g4 * 4 + 3]);
                  *(u32x2*)(op + cc * 32 + g4 * 8) = w; } }
    }
    __builtin_amdgcn_s_setprio(0);
}

#define XB_TMO      128
#define XB_XCNT(j)  (256  + 64 * (j))
#define XB_XSUB(j)  (1280 + 64 * (j))
#define XB_XGEN(j)  (2304 + 64 * (j))
#define XB_TOP      3328
#define XB_TOPGEN   3392
#define XCD_BAR_WORDS 3456
#define XB_SPIN_CAP (1u << 18)

__device__ __forceinline__ unsigned xb_ld(unsigned* p)              { return __hip_atomic_load(p, __ATOMIC_RELAXED, __HIP_MEMORY_SCOPE_AGENT); }
__device__ __forceinline__ unsigned xb_add(unsigned* p, unsigned v) { return __hip_atomic_fetch_add(p, v, __ATOMIC_RELAXED, __HIP_MEMORY_SCOPE_AGENT); }
__device__ __forceinline__ unsigned xb_xcc_id() { return (unsigned)__builtin_amdgcn_s_getreg((3 << 11) | 20) & 0xFu; }
#define XB_SPIN(cond, bar) do { unsigned _sp = 0; while (cond) { __builtin_amdgcn_s_sleep(1); \
    if ((++_sp & 255u) == 0u) { if (xb_ld(&(bar)[XB_TMO])) break; if (_sp > XB_SPIN_CAP) { atomicAdd(&(bar)[XB_TMO], 1u); break; } } } } while (0)

struct XcdBarrier {
    unsigned* bar; unsigned x;
    volatile LAS unsigned* st;
};

__device__ __forceinline__ XcdBarrier xcd_barrier_post(unsigned* bar, volatile LAS unsigned* st) {
    XcdBarrier b; b.bar = bar; b.x = xb_xcc_id(); b.st = st;
    if (threadIdx.x == 0) (void)xb_add(&bar[XB_XCNT(b.x)], 1u);
    return b;
}
__device__ __forceinline__ void xcd_barrier_complete(unsigned* bar, unsigned x, unsigned& nloc, unsigned& nx) {
    const unsigned G = gridDim.x * gridDim.y * gridDim.z;
    unsigned sum, cnt, mine, sp = 0u;
    for (;;) {
        sum = 0u; cnt = 0u; mine = 0u;
#pragma unroll
        for (unsigned j = 0; j < 16; ++j) { const unsigned c = xb_ld(&bar[XB_XCNT(j)]); sum += c; cnt += (c > 0u) ? 1u : 0u; mine = (j == x) ? c : mine; }
        if (sum == G) break;
        __builtin_amdgcn_s_sleep(1);
        if ((++sp & 255u) == 0u) { if (xb_ld(&bar[XB_TMO])) break; if (sp > XB_SPIN_CAP) { atomicAdd(&bar[XB_TMO], 1u); break; } }
    }
    nloc = mine > 0u ? mine : 1u; nx = cnt > 0u ? cnt : 1u;
}

__device__ __forceinline__ void xcd_barrier(const XcdBarrier& b) {
    asm volatile("s_waitcnt vmcnt(0)" ::: "memory");
    __syncthreads();
    if (threadIdx.x == 0) {
        unsigned* bar = b.bar;
        __builtin_amdgcn_s_waitcnt(0);
        unsigned nloc = b.st[0], nx = b.st[1];
        if (nloc == 0u) { xcd_barrier_complete(bar, b.x, nloc, nx); b.st[0] = nloc; b.st[1] = nx; }
        const unsigned old = xb_add(&bar[XB_XSUB(b.x)], 1u);
        const unsigned gen = old / nloc;
        if (old + 1u == (gen + 1u) * nloc) {
            __builtin_amdgcn_fence(__ATOMIC_RELEASE, "agent");
            asm volatile("s_waitcnt vmcnt(0)" ::: "memory");
            const unsigned og = xb_add(&bar[XB_TOP], 1u);
            const unsigned tg = og / nx;
            if (og + 1u == (tg + 1u) * nx) xb_add(&bar[XB_TOPGEN], 1u);
            else XB_SPIN(xb_ld(&bar[XB_TOPGEN]) == tg, bar);
            __builtin_amdgcn_fence(__ATOMIC_ACQUIRE, "agent");
            xb_add(&bar[XB_XGEN(b.x)], 1u);
            asm volatile("s_waitcnt vmcnt(0)" ::: "memory");
        } else {
            XB_SPIN(xb_ld(&bar[XB_XGEN(b.x)]) == gen, bar);
            __builtin_amdgcn_fence(__ATOMIC_ACQUIRE, "agent");
            asm volatile("s_waitcnt vmcnt(0)" ::: "memory");
        }
    }
    __syncthreads();
}

__global__ void __launch_bounds__(512, 2) mk_fwd(Params p) {
    extern __shared__ __attribute__((aligned(16))) unsigned char lds_raw[];
    LAS unsigned char* lds = (LAS unsigned char*)lds_raw;
    volatile LAS unsigned* bar_st = (volatile LAS unsigned*)(lds + LDS_BARST);
    if (threadIdx.x < 2) bar_st[threadIdx.x] = 0u;
    __syncthreads();
    (void)xcd_barrier_post((unsigned*)(p.ws + WS_BAR), bar_st);
    typedef const char __attribute__((address_space(4)))* kaptr_t;
    for (int step = p.step_lo; step < p.step_hi; ++step) {
        kaptr_t ka = (kaptr_t)__builtin_amdgcn_kernarg_segment_ptr();
        asm volatile("" : "+s"(ka));
        int tid_ = threadIdx.x; asm volatile("" : "+v"(tid_));
        int c_ = blockIdx.x; asm volatile("" : "+s"(c_));
        int G_ = gridDim.x; asm volatile("" : "+s"(G_));
        const int tid = tid_, lane = tid & 63, wave = __builtin_amdgcn_readfirstlane(tid >> 6);
        const int G = G_, c = c_;
        const int gw = c * 8 + wave, NGW = G * 8;
#define PIN(i) (*(const float* const __attribute__((address_space(4)))*)(ka + 8 * (i)))
        unsigned char* ws = *(unsigned char* const __attribute__((address_space(4)))*)(ka + 8 * 24);
        const float* x_in = PIN(0);
        float* xres = *(float* const __attribute__((address_space(4)))*)(ka + 8 * 23);
        float* mod = (float*)(ws + WS_MOD);
        float* kvmod = (float*)(ws + WS_KVMOD);
        bf16_t* XN = (bf16_t*)(ws + WS_XN);
        bf16_t* BIG = (bf16_t*)(ws + WS_BIG);
        bf16_t* HID = (bf16_t*)(ws + WS_HID);
        bf16_t* KVB = (bf16_t*)(ws + WS_KV);
        bf16_t* CMP = (bf16_t*)(ws + WS_CMP);
        int kind, layer = 0, sub = 0;
        int es = step;
#ifdef DUP_CLASS
        {
            int s = 0, e = 0;
            for (e = 0; e < 43; ++e) {
                int k2, l2 = 0, s2 = 0;
                if (e == 0) k2 = 0; else if (e <= 18) { k2 = 1; l2 = (e - 1) / 9; s2 = (e - 1) % 9; } else if (e <= 23) { k2 = 2; s2 = e - 19; } else if (e <= 41) { k2 = 1; l2 = 2 + (e - 24) / 9; s2 = (e - 24) % 9; } else k2 = 3;
                const bool d = (DUP_CLASS == 1 && k2 == 1 && s2 == 2 && l2 < 2) || (DUP_CLASS == 2 && k2 == 1 && s2 == 2 && l2 >= 2) ||
                               (DUP_CLASS == 3 && k2 == 1 && (s2 == 5 || s2 == 7)) || (DUP_CLASS == 4 && ((k2 == 1 && (s2 == 0 || s2 == 4)) || (k2 == 2 && s2 == 0))) ||
                               (DUP_CLASS == 5 && k2 == 1 && s2 == 1) || (DUP_CLASS == 6 && k2 == 0) || (DUP_CLASS == 7 && k2 == 2);
                if (s == step) break; ++s; if (d) { if (s == step) break; ++s; }
            }
            es = e;
        }
#endif
        if (es == 0) kind = 0;
        else if (es <= 18) { kind = 1; layer = (es - 1) / 9; sub = (es - 1) % 9; }
        else if (es <= 23) { kind = 2; sub = es - 19; }
        else if (es <= 41) { kind = 1; layer = 2 + (es - 24) / 9; sub = (es - 24) % 9; }
        else kind = 3;

        int gwn = gw, ngwn = NGW;
        if (G > 128) {
            if (kind == 1 && layer == 2 && sub == 0) continue;
            if (kind == 2 && sub == 3 && c >= 64) { kind = 1; layer = 2; sub = 0; gwn = (c - 64) * 8 + wave; ngwn = (G - 64) * 8; }
        }
        if (kind == 1 && sub == 7) continue;
        if (kind == 0) {
            {
                LAS float* scr = (LAS float*)(lds + wave * 16384);
                for (int it = gw;; it += NGW) {
                    int rr = it; const float* src; bf16_t* dst; int K, Ns;
                    if (rr < 2 * 1536) { const int l = rr / 1536; rr %= 1536; src = PIN(9) + (size_t)l * D * NQKV; dst = (bf16_t*)(ws + WS_WQKV) + (size_t)l * NQKV * D; K = D; Ns = NQKV; }
                    else if ((rr -= 3072) < 2 * 512) { const int l = rr / 512; rr %= 512; src = PIN(10) + (size_t)l * D * D; dst = (bf16_t*)(ws + WS_WAO) + (size_t)l * D * D; K = D; Ns = D; }
                    else if ((rr -= 1024) < 4 * 2048) { const int l = rr / 2048; rr %= 2048; src = PIN(7) + (size_t)l * D * FF; dst = (bf16_t*)(ws + WS_W1) + (size_t)l * D * FF; K = D; Ns = FF; }
                    else if ((rr -= 8192) < 4 * 2048) { const int l = rr / 2048; rr %= 2048; src = PIN(8) + (size_t)l * D * FF; dst = (bf16_t*)(ws + WS_W2) + (size_t)l * D * FF; K = FF; Ns = D; }
                    else if ((rr -= 8192) < 768) { src = PIN(16); dst = (bf16_t*)(ws + WS_WKV); K = D; Ns = NKV; }
                    else if ((rr -= 768) < 2 * 544) { const int l = rr / 544; rr %= 544; src = PIN(20) + (size_t)l * D * NBIN; dst = (bf16_t*)(ws + WS_WBIN) + (size_t)l * NBINP * D; K = D; Ns = NBIN; }
                    else if ((rr -= 1088) < 2 * 512) { const int l = rr / 512; rr %= 512; src = PIN(21) + (size_t)l * D * D; dst = (bf16_t*)(ws + WS_WBO) + (size_t)l * D * D; K = D; Ns = D; }
                    else if ((rr -= 1024) < 2 * 256) { const int l = rr / 256; rr %= 256; src = PIN(18) + (size_t)l * 2048 * 256; dst = (bf16_t*)(ws + WS_WC1) + (size_t)l * 256 * 2048; K = 2048; Ns = 256; }
                    else break;
                    transpose_item(src, K, Ns, dst, scr, rr, lane);
                }
                { unsigned z_ = 0u; asm volatile("" : "+v"(z_));
                for (int i = c * 512 + tid; i < 2 * 192 * 1024 / 8; i += G * 512) { const int l = i / (192 * 128), rem = i % (192 * 128);
                    *(u32x4*)((bf16_t*)(ws + WS_WBIN) + (size_t)l * NBINP * D + (size_t)1088 * D + (size_t)rem * 8) = (u32x4){z_, z_, z_, z_}; } }
            }
            __syncthreads();
            {
                LAS float* cact = (LAS float*)lds;
                LAS float* red = (LAS float*)(lds + 32768);
                for (int i = tid; i < 8192; i += 512) { const float v = PIN(1)[i]; cact[i] = v * __builtin_amdgcn_rcpf(1.f + __expf(-v)); }
                __syncthreads();
                for (int cgi = c; cgi < 416; cgi += G) {
                    const float* W; const float* bias; float* outp; int N, col0, ostride;
                    if (cgi < 384) { const int l = cgi / 96; col0 = (cgi % 96) * 64; W = PIN(3) + (size_t)l * D * 6144; N = 6144; bias = PIN(4) + l * 6144; outp = mod + (size_t)l * 8 * 6144; ostride = 6144; }
                    else { col0 = (cgi - 384) * 64; W = PIN(13); N = 2048; bias = PIN(14); outp = kvmod; ostride = 2048; }
                    float acc[8];
#pragma unroll
                    for (int b = 0; b < 8; ++b) acc[b] = 0.f;
                    const float* wp = W + (size_t)(wave * 128) * N + col0 + lane;
#pragma unroll 32
                    for (int k = 0; k < 128; ++k) { const float wv = wp[(size_t)k * N];
#pragma unroll
                        for (int b = 0; b < 8; ++b) acc[b] += cact[b * 1024 + wave * 128 + k] * wv; }
#pragma unroll
                    for (int b = 0; b < 8; ++b) red[(wave * 8 + b) * 64 + lane] = acc[b];
                    __syncthreads();
                    { const int b = tid >> 6; float s = 0.f;
#pragma unroll
                      for (int w = 0; w < 8; ++w) s += red[(w * 8 + b) * 64 + lane];
                      outp[(size_t)b * ostride + col0 + lane] = s + bias[col0 + lane]; }
                    __syncthreads();
                }
            }
        } else if (kind == 3 || (kind == 1 && (sub == 0 || sub == 4)) || (kind == 2 && sub == 0)) {
            const float* src = (kind == 1 && layer == 0 && sub == 0) ? x_in : xres;
            const float* gamma; const float* shift = nullptr; const float* scale = nullptr; int bstride = 0;
            if (kind == 3) gamma = PIN(22);
            else if (kind == 2) { gamma = PIN(15); shift = kvmod; scale = kvmod + 1024; bstride = 2048; }
            else if (sub == 0) { gamma = PIN(5) + layer * D; shift = mod + (size_t)layer * 8 * 6144; scale = shift + 1024; bstride = 6144; }
            else { gamma = PIN(6) + layer * D; shift = mod + (size_t)layer * 8 * 6144 + 3072; scale = shift + 1024; bstride = 6144; }
            int tid = tid_; asm volatile("" : "+v"(tid)); const int lane = tid & 63; (void)lane;
            for (int chunk = gwn; chunk < M / 16; chunk += ngwn) {
                const int row0 = chunk * 16, b = row0 / T;
                f32x4 A[4], Bv[4];
#pragma unroll
                for (int j = 0; j < 4; ++j) { const int col = 4 * lane + 256 * j; const f32x4 gm = *(const f32x4*)(gamma + col);
                    if (scale) { const f32x4 sc = *(const f32x4*)(scale + (size_t)b * bstride + col); A[j] = gm * (sc + 1.0f); Bv[j] = *(const f32x4*)(shift + (size_t)b * bstride + col); }
                    else { A[j] = gm; Bv[j] = (f32x4){0.f, 0.f, 0.f, 0.f}; } }
#pragma unroll 1
                for (int rq = 0; rq < 16; rq += 4) {
                    f32x4 v[4][4];
#pragma unroll
                    for (int r4 = 0; r4 < 4; ++r4)
#pragma unroll
                        for (int j = 0; j < 4; ++j) v[r4][j] = *(const f32x4*)(src + (size_t)(row0 + rq + r4) * D + 4 * lane + 256 * j);
#pragma unroll
                    for (int r4 = 0; r4 < 4; ++r4) {
                        const size_t ro = (size_t)(row0 + rq + r4) * D; float ss = 0.f;
#pragma unroll
                        for (int j = 0; j < 4; ++j) ss += (v[r4][j].x * v[r4][j].x + v[r4][j].y * v[r4][j].y) + (v[r4][j].z * v[r4][j].z + v[r4][j].w * v[r4][j].w);
                        const float rstd = rsqrtf(wave_sum(ss, lane) * (1.f / D) + NORM_EPS);
#pragma unroll
                        for (int j = 0; j < 4; ++j) { const f32x4 y = v[r4][j] * rstd * A[j] + Bv[j];
                            if (kind == 3) *(f32x4*)(xres + ro + 4 * lane + 256 * j) = y;
                            else { u32x2 w; w.x = cvtpk(y.x, y.y); w.y = cvtpk(y.z, y.w); *(u32x2*)(XN + ro + 4 * lane + 256 * j) = w; } }
                    }
                }
            }
        } else if (kind == 1 && sub == 2) {
#ifndef NO_DIFF
            if (layer < 2) diff_attn_phase((LAS char*)lds, BIG, XN, PIN(2), PIN(11) + layer * 256, PIN(12) + layer * 128, layer, (float*)(ws + WS_O1) + (size_t)c * 32768, G, c);
#endif
#ifndef NO_NSA
            if (layer >= 2) nsa_phase((LAS char*)lds, BIG, KVB, CMP, XN, PIN(2), G, c);
#endif
        } else if (kind == 2 && sub == 2) {
            int tid = tid_; asm volatile("" : "+v"(tid)); const int lane = tid & 63; (void)lane;
            for (size_t idx = (size_t)c * 512 + tid; idx < (size_t)16384 * 256; idx += (size_t)G * 512) {
                const int row = (int)(idx >> 8), c8 = (int)(idx & 255), l = c8 >> 3, d0 = (c8 & 7) * 8;
                const int n = row & 255, g = (row >> 8) & 3, b = (row >> 10) & 7, s = row >> 13;
                const int t = 16 * n + l;
                unsigned z_ = 0u; asm volatile("" : "+v"(z_));
                u32x4 o = {z_, z_, z_, z_};
                if (t < T) {
                    const u32x4 kv = *(const u32x4*)((const bf16_t*)(ws + WS_KV01) + ((size_t)((s * 8 + b) * 4 + g) * T + t) * 64 + d0);
                    const float* pp = PIN(17) + (s * 32 + l) * 64 + d0;
                    const f32x4 p0 = *(const f32x4*)pp, p1 = *(const f32x4*)(pp + 4);
                    o.x = cvtpk(bf2f((bf16_t)(kv.x & 0xffff)) + p0.x, bf2f((bf16_t)(kv.x >> 16)) + p0.y);
                    o.y = cvtpk(bf2f((bf16_t)(kv.y & 0xffff)) + p0.z, bf2f((bf16_t)(kv.y >> 16)) + p0.w);
                    o.z = cvtpk(bf2f((bf16_t)(kv.z & 0xffff)) + p1.x, bf2f((bf16_t)(kv.z >> 16)) + p1.y);
                    o.w = cvtpk(bf2f((bf16_t)(kv.w & 0xffff)) + p1.z, bf2f((bf16_t)(kv.w >> 16)) + p1.w);
                }
                *(u32x4*)(BIG + (size_t)row * 2048 + c8 * 8) = o;
            }
        } else if (kind == 2 && sub == 4) {
            int tid = tid_; asm volatile("" : "+v"(tid)); const int lane = tid & 63; (void)lane;
            for (int rg = gw; rg < 16384 / 8; rg += NGW) {
                const int row0 = rg * 8, s = row0 >> 13;
                const float* w2 = PIN(19) + (size_t)s * 256 * 64 + lane;
                float acc[8];
#pragma unroll
                for (int i = 0; i < 8; ++i) acc[i] = 0.f;
                for (int h = 0; h < 256; h += 2) {
                    const float wa = w2[(size_t)h * 64], wb = w2[(size_t)(h + 1) * 64];
#pragma unroll
                    for (int i = 0; i < 8; ++i) { const unsigned hv = *(const unsigned*)(HID + (size_t)(row0 + i) * 256 + h);
                        acc[i] += bf2f((bf16_t)(hv & 0xffff)) * wa + bf2f((bf16_t)(hv >> 16)) * wb; }
                }
#pragma unroll
                for (int i = 0; i < 8; ++i) CMP[(size_t)(row0 + i) * 64 + lane] = (bf16_t)f2bf(acc[i]);
            }
        } else {
            for (int rep = 0; rep < 2; ++rep) {
            int esub = sub;
            if (rep == 1) { if (kind == 1 && sub == 6) esub = 7; else break; }
            pg8::Gemm g; pg8::Sched S;
            bool resid = false; pg8::EpiStore ES{nullptr, 0, 0, 0, 0, 0, 0}; pg8::EpiResid ER{nullptr, nullptr, nullptr, 0};
            if (kind == 2 && sub == 1) { g = pg8::Gemm{XN, (const bf16_t*)(ws + WS_WKV), M, NKV, D}; S.init(M, NKV, G, c, 0); ES = pg8::EpiStore{KVB, NKV, 0, 0, 0, 2, (long)((WS_KV01 / 2)) - (long)(WS_KV / 2)}; }
            else if (kind == 2) { g = pg8::Gemm{BIG, (const bf16_t*)(ws + WS_WC1), 16384, 512, 2048}; S.init(16384, 512, G, c, 1); ES = pg8::EpiStore{HID, 256, 2, 1, 0, 0, 0}; }
            else if (esub == 1) {
                if (layer < 2) { g = pg8::Gemm{XN, (const bf16_t*)(ws + WS_WQKV) + (size_t)layer * NQKV * D, M, NQKV, D}; S.init(M, NQKV, G, c, 0); ES = pg8::EpiStore{BIG, 1024, 0, 0, 1024, 1, 0}; }
                else { g = pg8::Gemm{XN, (const bf16_t*)(ws + WS_WBIN) + (size_t)(layer - 2) * NBINP * D, M, NBINP, D}; S.init(M, NBINP, G, c, 0); ES = pg8::EpiStore{BIG, NBINP, 0, 0, 1024, 0, 0}; }
            } else if (esub == 3) {
                const bf16_t* W = layer < 2 ? (const bf16_t*)(ws + WS_WAO) + (size_t)layer * D * D : (const bf16_t*)(ws + WS_WBO) + (size_t)(layer - 2) * D * D;
                g = pg8::Gemm{XN, W, M, D, D}; S.init(M, D, G, c, 0); resid = true;
                ER = pg8::EpiResid{layer == 0 ? x_in : xres, xres, mod + (size_t)layer * 8 * 6144 + 2048, 0};
            } else if (esub == 5 || esub == 7) {
                const int half = (esub - 5) / 2;
                g = pg8::Gemm{XN + (size_t)half * 16384 * D, (const bf16_t*)(ws + WS_W1) + (size_t)layer * D * FF, 16384, FF, D}; S.init(16384, FF, G, c, 0); ES = pg8::EpiStore{BIG + (size_t)half * 16384 * FF, FF, 1, 0, 0, 0, 0};
            } else {
                const int half = (esub - 6) / 2;
                g = pg8::Gemm{BIG + (size_t)half * 16384 * FF, (const bf16_t*)(ws + WS_W2) + (size_t)layer * D * FF, 16384, D, FF}; S.init(16384, D, G, c, 0); resid = true;
                ER = pg8::EpiResid{xres, xres, mod + (size_t)layer * 8 * 6144 + 5120, half * 16384};
            }
#ifndef NO_GEMM
            if (resid) pg8::gemm_phase<pg8::EpiResid, pg8::Sched, true, true>(lds, g, S, ER);
            else pg8::gemm_phase<pg8::EpiStore, pg8::Sched, true, true>(lds, g, S, ES);
#endif
            }
        }
        if (step + 1 < p.step_hi) {
#if USE_XCD_BAR
            if (p.step_hi < 0) cg::this_grid().sync();
            else { XcdBarrier xb; xb.bar = (unsigned*)(ws + WS_BAR); xb.x = xb_xcc_id(); xb.st = (volatile LAS unsigned*)(lds + LDS_BARST); xcd_barrier(xb); }
#else
            cg::this_grid().sync();
#endif
        }
    }
}

extern "C" void kernel_launch(void* const* d_in, const int* in_sizes, int n_in, void* d_out, int out_size, void* d_ws, size_t ws_size, hipStream_t stream) {
    static int grid = 0;
    if (grid == 0) {
        if (n_in != 23 || out_size != M * D || ws_size < WS_END) { fprintf(stderr, "kernel_launch: unexpected shapes (n_in %d out %d ws %zu)\n", n_in, out_size, ws_size); grid = -1; return; }
        int dev = 0, cus = 0, per_cu = 0;
        hipGetDevice(&dev);
        hipDeviceGetAttribute(&cus, hipDeviceAttributeMultiprocessorCount, dev);
        hipFuncSetAttribute((const void*)mk_fwd, hipFuncAttributeMaxDynamicSharedMemorySize, LDS_BYTES);
        if (hipOccupancyMaxActiveBlocksPerMultiprocessor(&per_cu, (const void*)mk_fwd, 512, LDS_BYTES) != hipSuccess || per_cu < 1) { fprintf(stderr, "kernel_launch: occupancy query says %d\n", per_cu); per_cu = 1; }
        (void)hipGetLastError();
        grid = cus;
    }
    if (grid < 0) return;
    hipMemsetAsync((char*)d_ws + WS_BAR, 0, 16384, stream);
    Params p{};
    for (int i = 0; i < 23; ++i) p.in[i] = (const float*)d_in[i];
    p.out = (float*)d_out; p.ws = (unsigned char*)d_ws; p.step_lo = 0; p.step_hi = 43 + NDUP;
    void* args[] = {&p};
    hipError_t e = hipLaunchCooperativeKernel((const void*)mk_fwd, dim3(grid), dim3(512), args, LDS_BYTES, stream);
    if (e != hipSuccess) fprintf(stderr, "cooperative launch failed: %s (grid %d)\n", hipGetErrorString(e), grid);
}
```
